# Optimizing an MI355X kernel written in HIP

```python
import math
import numpy as np
import jax
import jax.numpy as jnp
from jax import lax

D_MODEL = 1024
BATCH = 32
SEQ = 2048
DEPTH = 2

N_MEM = 256
HEAD_DIM = 64
MAIN_W = 3 * D_MODEL // 4
N_HEADS = MAIN_W // HEAD_DIM
MEM_HEADS = 4
MEM_W = D_MODEL - MAIN_W
MEM_HEAD_DIM = MEM_W // MEM_HEADS
MIX_W = MAIN_W + MEM_W

NSA_KV_HEADS = 1
NSA_KV_W = NSA_KV_HEADS * HEAD_DIM
CMP_LEN = 32
CMP_STRIDE = 16
CMP_HIDDEN = 4 * HEAD_DIM
SLC_BLOCK = 64
SLC_TOPK = 16
WINDOW = 512
NSA_Q_CHUNK = 64
FORCE_SCORE = 1.0e4

MOBA_BLOCK = 256
MOBA_TOPK = 3
MOBA_Q_CHUNK = 8

REL_BUCKETS = 32
REL_MAX_DIST = 128

D_FF = 2816
CONV_W = 3

N_A = DEPTH // 2
N_B = DEPTH - N_A
ALPHA = (2.0 * DEPTH) ** 0.25
BETA = (8.0 * DEPTH) ** -0.25
LN_EPS = 1e-5
NEG_INF = -1e30
TINY = 1e-30

A_IN_SIZES = (MAIN_W, NSA_KV_W, NSA_KV_W, NSA_KV_W, NSA_KV_W, NSA_KV_W, NSA_KV_W, 3 * N_HEADS, MEM_W)
A_IN = sum(A_IN_SIZES)
B_IN_SIZES = (MAIN_W, MEM_W)
B_IN = sum(B_IN_SIZES)

kernel_name = 'yoco_nsa_moba_hybrid'


def split_cols(h, sizes):
    return jnp.split(h, np.cumsum(sizes)[:-1].tolist(), axis=-1)


def layer_norm(x, g, b):
    xf = x.astype(jnp.float32)
    mu = xf.mean(-1, keepdims=True)
    var = jnp.square(xf - mu).mean(-1, keepdims=True)
    return ((xf - mu) * lax.rsqrt(var + LN_EPS) * g + b).astype(x.dtype)


def rel_bucket(dist):
    n = jnp.maximum(dist, 0)
    max_exact = REL_BUCKETS // 2
    nf = jnp.maximum(n, 1).astype(jnp.float32)
    large = max_exact + (jnp.log(nf / max_exact) / math.log(REL_MAX_DIST / max_exact)
                         * (REL_BUCKETS - max_exact)).astype(jnp.int32)
    large = jnp.minimum(large, REL_BUCKETS - 1)
    return jnp.where(n < max_exact, n, large)


def masked_softmax(logits, mask):
    logits = jnp.where(mask, logits, NEG_INF)
    m = jnp.max(logits, -1, keepdims=True)
    p = jnp.where(mask, jnp.exp(logits - m), 0.0)
    return p / jnp.maximum(p.sum(-1, keepdims=True), TINY)


def cmp_slc_overlap(n_cmp, n_slc):
    start = np.arange(n_cmp) * CMP_STRIDE
    end = start + CMP_LEN
    bs = np.arange(n_slc) * SLC_BLOCK
    m = (start[:, None] < bs[None, :] + SLC_BLOCK) & (end[:, None] > bs[None, :])
    return m.astype(np.float32)


def nsa_compress(k, pe, w1, w2):
    B, S, G, dh = k.shape
    n_cmp = (S - CMP_LEN) // CMP_STRIDE + 1
    idx = (np.arange(n_cmp, dtype=np.int32)[:, None] * CMP_STRIDE
           + np.arange(CMP_LEN, dtype=np.int32)[None, :])
    blocks = k[:, idx] + pe[:, None, :]
    blocks = blocks.transpose(0, 1, 3, 2, 4).reshape(B, n_cmp, G, CMP_LEN * dh)
    return jax.nn.gelu(blocks @ w1) @ w2


def nsa_attention(q, k_cmp, v_cmp, k_slc, v_slc, k_win, v_win, gates, rel_bias):
    B, S, H, dh = q.shape
    G = k_slc.shape[2]
    hpg = H // G
    n_cmp = k_cmp.shape[1]
    n_slc = S // SLC_BLOCK
    top = min(SLC_TOPK, n_slc)
    n_sel = top * SLC_BLOCK
    QC = NSA_Q_CHUNK
    KW = WINDOW + QC
    scale = dh ** -0.5

    cmp_end = jnp.asarray(np.arange(n_cmp) * CMP_STRIDE + CMP_LEN - 1, jnp.int32)
    overlap = jnp.asarray(cmp_slc_overlap(n_cmp, n_slc))
    blk_ids = jnp.arange(n_slc, dtype=jnp.int32)
    offs = jnp.arange(SLC_BLOCK, dtype=jnp.int32)
    k_blk = k_slc.reshape(B, n_slc, SLC_BLOCK, G, dh).transpose(0, 3, 1, 2, 4).reshape(B, G, n_slc, SLC_BLOCK * dh)
    v_blk = v_slc.reshape(B, n_slc, SLC_BLOCK, G, dh).transpose(0, 3, 1, 2, 4).reshape(B, G, n_slc, SLC_BLOCK * dh)
    k_win_pad = jnp.pad(k_win, ((0, 0), (WINDOW, 0), (0, 0), (0, 0)))
    v_win_pad = jnp.pad(v_win, ((0, 0), (WINDOW, 0), (0, 0), (0, 0)))
    table_g = rel_bias.reshape(REL_BUCKETS, G, hpg)
    g_idx = jnp.arange(G)[None, None, :, None]

    def head_bias(bucket):
        return rel_bias[bucket].reshape(bucket.shape + (G, hpg)).transpose(0, 2, 3, 1)

    def chunk(c):
        t0 = c * QC
        t = t0 + jnp.arange(QC, dtype=jnp.int32)
        qc = lax.dynamic_slice_in_dim(q, t0, QC, axis=1).reshape(B, QC, G, hpg, dh)
        gc = lax.dynamic_slice_in_dim(gates, t0, QC, axis=1).reshape(B, QC, G, hpg, 3)

        dist_c = t[:, None] - cmp_end[None, :]
        lg = jnp.einsum('bqgjd,bngd->bqgjn', qc, k_cmp).astype(jnp.float32) * scale + head_bias(rel_bucket(dist_c))
        p_c = masked_softmax(lg, (dist_c >= 0)[None, :, None, None, :])
        o_c = jnp.einsum('bqgjn,bngd->bqgjd', p_c, v_cmp)

        imp = jnp.einsum('bqgjn,ns->bqgs', p_c, overlap)
        cur = t // SLC_BLOCK
        bid = blk_ids[None, :]
        eligible = bid <= cur[:, None]
        forced = (bid == 0) | (bid == cur[:, None]) | (bid == cur[:, None] - 1)
        score = jnp.where(eligible, jnp.where(forced, FORCE_SCORE, 0.0), NEG_INF)[None, :, None, :] + imp
        _, sel = lax.top_k(score, top)
        idx = sel.transpose(0, 2, 1, 3).reshape(B, G, QC * top, 1)
        ks = jnp.take_along_axis(k_blk, idx, axis=2).reshape(B, G, QC, n_sel, dh)
        vs = jnp.take_along_axis(v_blk, idx, axis=2).reshape(B, G, QC, n_sel, dh)
        key_pos = (sel[..., None] * SLC_BLOCK + offs).reshape(B, QC, G, n_sel)
        dist_s = t[None, :, None, None] - key_pos
        bias_s = jnp.swapaxes(table_g[rel_bucket(dist_s), g_idx], -1, -2)
        lg = jnp.einsum('bqgjd,bgqkd->bqgjk', qc, ks).astype(jnp.float32) * scale + bias_s
        p_s = masked_softmax(lg, (dist_s >= 0)[:, :, :, None, :])
        o_s = jnp.einsum('bqgjk,bgqkd->bqgjd', p_s, vs)

        kw = lax.dynamic_slice_in_dim(k_win_pad, t0, KW, axis=1)
        vw = lax.dynamic_slice_in_dim(v_win_pad, t0, KW, axis=1)
        pos_w = t0 - WINDOW + jnp.arange(KW, dtype=jnp.int32)
        dist_w = t[:, None] - pos_w[None, :]
        mask_w = (pos_w[None, :] >= 0) & (dist_w >= 0) & (dist_w < WINDOW)
        lg = jnp.einsum('bqgjd,bkgd->bqgjk', qc, kw).astype(jnp.float32) * scale + head_bias(rel_bucket(dist_w))
        p_w = masked_softmax(lg, mask_w[None, :, None, None, :])
        o_w = jnp.einsum('bqgjk,bkgd->bqgjd', p_w, vw)

        o = gc[..., 0:1] * o_c + gc[..., 1:2] * o_s + gc[..., 2:3] * o_w
        return o.reshape(B, QC, H * dh).astype(q.dtype)

    out = lax.map(chunk, jnp.arange(S // QC, dtype=jnp.int32))
    return out.transpose(1, 0, 2, 3).reshape(B, S, H * dh)


def moba_shared_kv(x, w_kv):
    B, S, _ = x.shape
    k, v = jnp.split(x @ w_kv, 2, axis=-1)
    nb = -(-S // MOBA_BLOCK)
    pad = nb * MOBA_BLOCK - S
    k = jnp.pad(k.reshape(B, S, N_HEADS, HEAD_DIM), ((0, 0), (0, pad), (0, 0), (0, 0)))
    v = jnp.pad(v.reshape(B, S, N_HEADS, HEAD_DIM), ((0, 0), (0, pad), (0, 0), (0, 0)))
    k_blocks = k.reshape(B, nb, MOBA_BLOCK, N_HEADS, HEAD_DIM)
    k_mean = k_blocks.astype(jnp.float32).mean(2).astype(k.dtype)
    k_blk = k_blocks.transpose(0, 3, 1, 2, 4).reshape(B, N_HEADS, nb, MOBA_BLOCK * HEAD_DIM)
    v_blk = v.reshape(B, nb, MOBA_BLOCK, N_HEADS, HEAD_DIM).transpose(0, 3, 1, 2, 4).reshape(B, N_HEADS, nb, MOBA_BLOCK * HEAD_DIM)
    return k_mean, k_blk, v_blk


def moba_attention(q, k_mean, k_blk, v_blk, rel_bias):
    B, S, H, dh = q.shape
    nb = k_mean.shape[1]
    top = min(MOBA_TOPK, nb - 1)
    n_p = top * MOBA_BLOCK
    QC = MOBA_Q_CHUNK
    scale = dh ** -0.5
    blk_ids = jnp.arange(nb, dtype=jnp.int32)
    offs = jnp.arange(MOBA_BLOCK, dtype=jnp.int32)
    h_idx = jnp.arange(H)[None, :, None, None]

    def chunk(c):
        t0 = c * QC
        t = t0 + jnp.arange(QC, dtype=jnp.int32)
        cb = t0 // MOBA_BLOCK
        qc = lax.dynamic_slice_in_dim(q, t0, QC, axis=1)
        ko = lax.dynamic_index_in_dim(k_blk, cb, axis=2, keepdims=False).reshape(B, H, MOBA_BLOCK, dh)
        vo = lax.dynamic_index_in_dim(v_blk, cb, axis=2, keepdims=False).reshape(B, H, MOBA_BLOCK, dh)
        dist_o = t[:, None] - (cb * MOBA_BLOCK + offs)[None, :]
        lg_o = (jnp.einsum('bqhd,bhkd->bhqk', qc, ko).astype(jnp.float32) * scale
                + rel_bias[rel_bucket(dist_o)].transpose(2, 0, 1))
        mask_o = jnp.broadcast_to(dist_o >= 0, lg_o.shape)
        if top == 0:
            p = masked_softmax(lg_o, mask_o)
            o = jnp.einsum('bhqk,bhkd->bqhd', p, vo)
        else:
            gate = jnp.einsum('bqhd,bnhd->bhqn', qc, k_mean).astype(jnp.float32)
            gate = jnp.where(blk_ids < cb, gate, NEG_INF)
            _, sel = lax.top_k(gate, top)
            idx = sel.reshape(B, H, QC * top, 1)
            kp = jnp.take_along_axis(k_blk, idx, axis=2).reshape(B, H, QC, n_p, dh)
            vp = jnp.take_along_axis(v_blk, idx, axis=2).reshape(B, H, QC, n_p, dh)
            pos_p = (sel[..., None] * MOBA_BLOCK + offs).reshape(B, H, QC, n_p)
            lg_p = (jnp.einsum('bqhd,bhqkd->bhqk', qc, kp).astype(jnp.float32) * scale
                    + rel_bias[rel_bucket(t[None, None, :, None] - pos_p), h_idx])
            mask_p = pos_p < cb * MOBA_BLOCK
            p = masked_softmax(jnp.concatenate([lg_p, lg_o], -1), jnp.concatenate([mask_p, mask_o], -1))
            o = (jnp.einsum('bhqk,bhqkd->bqhd', p[..., :n_p], vp)
                 + jnp.einsum('bhqk,bhkd->bqhd', p[..., n_p:], vo))
        return o.reshape(B, QC, H * dh).astype(q.dtype)

    out = lax.map(chunk, jnp.arange(S // QC, dtype=jnp.int32))
    return out.transpose(1, 0, 2, 3).reshape(B, S, H * dh)


def memory_attention(qm, mem, w_mem_kv):
    B, M, _ = mem.shape
    km, vm = jnp.split(mem @ w_mem_kv, 2, axis=-1)
    km = km.reshape(B, M, MEM_HEADS, MEM_HEAD_DIM)
    vm = vm.reshape(B, M, MEM_HEADS, MEM_HEAD_DIM)
    lg = jnp.einsum('bshd,bmhd->bhsm', qm, km).astype(jnp.float32) * (MEM_HEAD_DIM ** -0.5)
    p = jax.nn.softmax(lg, axis=-1)
    o = jnp.einsum('bhsm,bmhd->bshd', p, vm)
    return o.reshape(qm.shape[0], qm.shape[1], MEM_W).astype(qm.dtype)


def conv_ffn(x, w_in, conv_w, conv_b, w_out):
    S = x.shape[1]
    a, b = jnp.split(x @ w_in, 2, axis=-1)
    a_pad = jnp.pad(a, ((0, 0), (CONV_W - 1, 0), (0, 0)))
    a = sum(conv_w[k] * a_pad[:, k:k + S] for k in range(CONV_W)) + conv_b
    return (jax.nn.gelu(a) * b) @ w_out


def setup_inputs(seed: int = 0) -> dict:
    key = jax.random.key(seed)
    keys = iter(jax.random.split(key, 32))

    def nrm(shape, scale):
        return jax.random.normal(next(keys), shape, jnp.float32) * scale

    L = CMP_LEN * HEAD_DIM
    return {
        'x': nrm((BATCH, SEQ, D_MODEL), 1.0),
        'mem': nrm((BATCH, N_MEM, D_MODEL), 1.0),
        'rel_bias': nrm((REL_BUCKETS, N_HEADS), 0.5),
        'a_w_in': nrm((N_A, D_MODEL, A_IN), D_MODEL ** -0.5),
        'a_cmp_pe_k': nrm((N_A, CMP_LEN, HEAD_DIM), 0.1),
        'a_cmp_w1_k': nrm((N_A, L, CMP_HIDDEN), L ** -0.5),
        'a_cmp_w2_k': nrm((N_A, CMP_HIDDEN, HEAD_DIM), CMP_HIDDEN ** -0.5),
        'a_cmp_pe_v': nrm((N_A, CMP_LEN, HEAD_DIM), 0.1),
        'a_cmp_w1_v': nrm((N_A, L, CMP_HIDDEN), L ** -0.5),
        'a_cmp_w2_v': nrm((N_A, CMP_HIDDEN, HEAD_DIM), CMP_HIDDEN ** -0.5),
        'a_w_mem_kv': nrm((N_A, D_MODEL, 2 * MEM_W), D_MODEL ** -0.5),
        'a_w_out': nrm((N_A, MIX_W, D_MODEL), BETA * MIX_W ** -0.5),
        'shared_w_kv': nrm((D_MODEL, 2 * MAIN_W), D_MODEL ** -0.5),
        'b_w_in': nrm((N_B, D_MODEL, B_IN), D_MODEL ** -0.5),
        'b_w_mem_kv': nrm((N_B, D_MODEL, 2 * MEM_W), D_MODEL ** -0.5),
        'b_w_out': nrm((N_B, MIX_W, D_MODEL), BETA * MIX_W ** -0.5),
        'ln1_g': 1.0 + nrm((DEPTH, D_MODEL), 0.02),
        'ln1_b': nrm((DEPTH, D_MODEL), 0.02),
        'ln2_g': 1.0 + nrm((DEPTH, D_MODEL), 0.02),
        'ln2_b': nrm((DEPTH, D_MODEL), 0.02),
        'ffn_w_in': nrm((DEPTH, D_MODEL, 2 * D_FF), D_MODEL ** -0.5),
        'ffn_conv_w': nrm((DEPTH, CONV_W, D_FF), CONV_W ** -0.5),
        'ffn_conv_b': nrm((DEPTH, D_FF), 0.02),
        'ffn_w_out': nrm((DEPTH, D_FF, D_MODEL), BETA * D_FF ** -0.5),
    }


def reference(x, mem, rel_bias, a_w_in, a_cmp_pe_k, a_cmp_w1_k, a_cmp_w2_k, a_cmp_pe_v, a_cmp_w1_v,
              a_cmp_w2_v, a_w_mem_kv, a_w_out, shared_w_kv, b_w_in, b_w_mem_kv, b_w_out,
              ln1_g, ln1_b, ln2_g, ln2_b, ffn_w_in, ffn_conv_w, ffn_conv_b, ffn_w_out):
    B, S, _ = x.shape

    def heads(z):
        return z.reshape(B, S, -1, HEAD_DIM)

    k_mean = k_blk = v_blk = None
    for layer in range(DEPTH):
        if layer < N_A:
            i = layer
            q, kc, vc, ks, vs, kw, vw, g, qm = split_cols(x @ a_w_in[i], A_IN_SIZES)
            k_cmp = nsa_compress(heads(kc), a_cmp_pe_k[i], a_cmp_w1_k[i], a_cmp_w2_k[i])
            v_cmp = nsa_compress(heads(vc), a_cmp_pe_v[i], a_cmp_w1_v[i], a_cmp_w2_v[i])
            gates = jax.nn.sigmoid(g).reshape(B, S, N_HEADS, 3)
            o_main = nsa_attention(heads(q), k_cmp, v_cmp, heads(ks), heads(vs), heads(kw), heads(vw),
                                   gates, rel_bias)
            w_mem_kv, w_out = a_w_mem_kv[i], a_w_out[i]
        else:
            if layer == N_A:
                k_mean, k_blk, v_blk = moba_shared_kv(x, shared_w_kv)
            i = layer - N_A
            q, qm = split_cols(x @ b_w_in[i], B_IN_SIZES)
            o_main = moba_attention(heads(q), k_mean, k_blk, v_blk, rel_bias)
            w_mem_kv, w_out = b_w_mem_kv[i], b_w_out[i]
        o_mem = memory_attention(qm.reshape(B, S, MEM_HEADS, MEM_HEAD_DIM), mem, w_mem_kv)
        mix = jnp.concatenate([o_main, o_mem], axis=-1) @ w_out
        x = layer_norm(ALPHA * x + mix, ln1_g[layer], ln1_b[layer])
        ffn = conv_ffn(x, ffn_w_in[layer], ffn_conv_w[layer], ffn_conv_b[layer], ffn_w_out[layer])
        x = layer_norm(ALPHA * x + ffn, ln2_g[layer], ln2_b[layer])
    return x
```

```cpp
#include <hip/hip_runtime.h>
#include <hip/hip_cooperative_groups.h>
#include <cstdio>
#include <cstdint>
namespace cg = cooperative_groups;

#define LAS __attribute__((address_space(3)))
typedef unsigned short bf16_t;
typedef short bf16x8 __attribute__((ext_vector_type(8)));
typedef short s16x4 __attribute__((ext_vector_type(4)));
typedef float f32x4 __attribute__((ext_vector_type(4)));
typedef float f32x2 __attribute__((ext_vector_type(2)));
typedef float f32x16 __attribute__((ext_vector_type(16)));
typedef unsigned u32x4 __attribute__((ext_vector_type(4)));
typedef unsigned u32x2 __attribute__((ext_vector_type(2)));

__device__ __forceinline__ unsigned cvt_pk_bf16(float lo, float hi) { unsigned r; asm volatile("v_cvt_pk_bf16_f32 %0, %1, %2" : "=v"(r) : "v"(lo), "v"(hi)); return r; }
__device__ __forceinline__ float bf2f(unsigned short b) { return __uint_as_float(((unsigned)b) << 16); }
__device__ __forceinline__ float gelu_tanh(float x) {
    const float x2 = x * x;
    const float w = x * (-2.302208198f - 0.1029432397f * x2);
    return x * __builtin_amdgcn_rcpf(1.0f + __builtin_amdgcn_exp2f(w));
}

namespace pg8 {
constexpr int BM = 256, BK = 64, HALF = 128, HTB = HALF * BK * 2, STAGE_BYTES = 8 * HTB, NXCD = 8, WGM = 8;
__host__ __device__ __forceinline__ int lds_byte(int r, int c) { const int st = (r >> 4) * 2 + (c >> 5), rr = r & 15, cc = c & 31, ob = rr * 64 + cc * 2; return st * 1024 + (ob ^ (((ob >> 9) & 1) << 5)); }
__host__ __device__ __forceinline__ void stage_rc(int b, int& R, int& C) { const int st = b / 1024, sb = b % 1024, swz = sb ^ (((sb >> 9) & 1) << 5); R = (st >> 1) * 16 + swz / 64; C = (st & 1) * 32 + (swz % 64) / 2; }
__host__ __device__ __forceinline__ int perm32(int rho) { const int n = rho >> 4, i = rho & 15; return 8 * (i >> 2) + 4 * n + (i & 3); }

struct Unit { int pm, pn; };
struct Gemm { const bf16_t* A; const bf16_t* Bt; int M, N, K; int lda; int kstepA; };

struct StaticOrder {
    int nM, nN, nwg, G, c;
    __host__ __device__ void init(int M, int N, int G_, int c_) { nM = M / BM; nN = N / BM; nwg = nM * nN; G = G_; c = c_; }
    __host__ __device__ bool next(int i, Unit& u) const {
        if (c < 0) return false;
        const long L = (long)i * G + c; if (L >= nwg) return false;
        int wgid = (int)L; { const int q = nwg / NXCD, r = nwg % NXCD, xcd = wgid % NXCD, off = wgid / NXCD; wgid = (xcd < r ? xcd * (q + 1) : r * (q + 1) + (xcd - r) * q) + off; }
        const int nig = WGM * nN, gid = wgid / nig, fm = gid * WGM, gsz = (nM - fm) < WGM ? (nM - fm) : WGM;
        u.pm = fm + ((wgid % nig) % gsz); u.pn = (wgid % nig) / gsz; return true;
    }
};

struct EpiBf16 {
    static constexpr bool PERM = true;
    bf16_t* O; int ldc;
    __device__ __forceinline__ void operator()(const f32x4 (&acc)[2][2][4][2], const Unit& u, int wr, int wc, int fr, int fq) const {
        const int row0 = u.pm * BM + wr * 64 + fr; const int col0 = u.pn * BM + wc * 32 + 8 * fq;
#pragma unroll
        for (int ai = 0; ai < 2; ++ai)
#pragma unroll
            for (int m = 0; m < 4; ++m) { bf16_t* rowp = O + (size_t)(row0 + ai * HALF + m * 16) * ldc + col0;
#pragma unroll
                for (int bj = 0; bj < 2; ++bj) { const f32x4 v0 = acc[ai][bj][m][0], v1 = acc[ai][bj][m][1];
                    u32x4 w; w.x = cvt_pk_bf16(v0[0], v0[1]); w.y = cvt_pk_bf16(v0[2], v0[3]); w.z = cvt_pk_bf16(v1[0], v1[1]); w.w = cvt_pk_bf16(v1[2], v1[3]);
                    *(u32x4*)(rowp + bj * HALF) = w; } }
    }
};
struct EpiF32BiasGelu {
    static constexpr bool PERM = false;
    float* O; int ldc; const float* bias;
    __device__ __forceinline__ void operator()(const f32x4 (&acc)[2][2][4][2], const Unit& u, int wr, int wc, int fr, int fq) const {
        const int row0 = u.pm * BM + wr * 64 + fr; const int col0 = u.pn * BM + wc * 32 + 4 * fq;
#pragma unroll
        for (int bj = 0; bj < 2; ++bj)
#pragma unroll
            for (int n = 0; n < 2; ++n) { const f32x4 bv = *(const f32x4*)(bias + col0 + bj * HALF + n * 16);
#pragma unroll
                for (int ai = 0; ai < 2; ++ai)
#pragma unroll
                    for (int m = 0; m < 4; ++m) { f32x4 v = acc[ai][bj][m][n] + bv; v[0] = gelu_tanh(v[0]); v[1] = gelu_tanh(v[1]); v[2] = gelu_tanh(v[2]); v[3] = gelu_tanh(v[3]);
                        *(f32x4*)(O + (size_t)(row0 + ai * HALF + m * 16) * ldc + col0 + bj * HALF + n * 16) = v; } }
    }
};
template <int CTRL> __device__ __forceinline__ float dppf(float old, float src) {
    return __int_as_float(__builtin_amdgcn_update_dpp(__float_as_int(old), __float_as_int(src), CTRL, 0xf, 0xf, false));
}
struct EpiConvGate {
    static constexpr bool PERM = true;
    bf16_t* H; const float* cw; const float* cb; float* TAILA; float* HEADA; float* HEADB;
    __device__ __forceinline__ void operator()(const f32x4 (&acc)[2][2][4][2], const Unit& u, int wr, int wc, int fr, int fq) const {
        constexpr int DFF_ = 2816;
        const int cf0 = u.pn * 128 + wc * 32 + 8 * fq;
        f32x4 w0[2], w1[2], w2[2], cv[2];
#pragma unroll
        for (int n = 0; n < 2; ++n) { w0[n] = *(const f32x4*)(cw + cf0 + 4 * n); w1[n] = *(const f32x4*)(cw + DFF_ + cf0 + 4 * n); w2[n] = *(const f32x4*)(cw + 2 * DFF_ + cf0 + 4 * n); cv[n] = *(const f32x4*)(cb + cf0 + 4 * n); }
#pragma unroll
        for (int ai = 0; ai < 2; ++ai) {
            const int G = u.pm * 4 + ai * 2 + wr;
#pragma unroll
            for (int m = 0; m < 4; ++m) {
                const int row = u.pm * BM + ai * HALF + wr * 64 + m * 16 + fr;
                f32x4 hv[2];
#pragma unroll
                for (int n = 0; n < 2; ++n) {
                    const f32x4 a = acc[ai][0][m][n], b = acc[ai][1][m][n];
                    const f32x4 pv = acc[ai][0][m > 0 ? m - 1 : 0][n];
#pragma unroll
                    for (int j = 0; j < 4; ++j) {
                        const float am1 = dppf<0x111>(dppf<0x121>(0.f, pv[j]), a[j]);
                        const float am2 = dppf<0x112>(dppf<0x122>(0.f, pv[j]), a[j]);
                        const float pre = w0[n][j] * am2 + w1[n][j] * am1 + w2[n][j] * a[j] + cv[n][j];
                        hv[n][j] = gelu_tanh(pre) * b[j];
                    }
                }
                if (m > 0 || fr >= 2) {
                    u32x4 w; w.x = cvt_pk_bf16(hv[0][0], hv[0][1]); w.y = cvt_pk_bf16(hv[0][2], hv[0][3]); w.z = cvt_pk_bf16(hv[1][0], hv[1][1]); w.w = cvt_pk_bf16(hv[1][2], hv[1][3]);
                    *(u32x4*)(H + (size_t)row * DFF_ + cf0) = w;
                } else {
                    float* ha = HEADA + ((size_t)G * 2 + fr) * DFF_ + cf0; float* hb = HEADB + ((size_t)G * 2 + fr) * DFF_ + cf0;
                    *(f32x4*)ha = acc[ai][0][0][0]; *(f32x4*)(ha + 4) = acc[ai][0][0][1]; *(f32x4*)hb = acc[ai][1][0][0]; *(f32x4*)(hb + 4) = acc[ai][1][0][1];
                }
                if (m == 3 && fr >= 14) { float* ta = TAILA + ((size_t)G * 2 + (fr - 14)) * DFF_ + cf0; *(f32x4*)ta = acc[ai][0][3][0]; *(f32x4*)(ta + 4) = acc[ai][0][3][1]; }
            }
        }
    }
};
template <bool BASE_F32>
struct EpiResF32 {
    static constexpr bool PERM = false;
    const void* basev; float* O; int ldc; float alpha;
    __device__ __forceinline__ void operator()(const f32x4 (&acc)[2][2][4][2], const Unit& u, int wr, int wc, int fr, int fq) const {
        const int row0 = u.pm * BM + wr * 64 + fr; const int col0 = u.pn * BM + wc * 32 + 4 * fq;
#pragma unroll
        for (int ai = 0; ai < 2; ++ai)
#pragma unroll
            for (int m = 0; m < 4; ++m) { const size_t off = (size_t)(row0 + ai * HALF + m * 16) * ldc + col0;
#pragma unroll
                for (int bj = 0; bj < 2; ++bj)
#pragma unroll
                    for (int n = 0; n < 2; ++n) { f32x4 bs;
                        if (BASE_F32) bs = *(const f32x4*)((const float*)basev + off + bj * HALF + n * 16);
                        else { const u32x2 w = *(const u32x2*)((const bf16_t*)basev + off + bj * HALF + n * 16); bs[0] = __uint_as_float(w.x << 16); bs[1] = __uint_as_float(w.x & 0xffff0000u); bs[2] = __uint_as_float(w.y << 16); bs[3] = __uint_as_float(w.y & 0xffff0000u); }
                        *(f32x4*)(O + off + bj * HALF + n * 16) = bs * alpha + acc[ai][bj][m][n]; } }
    }
};

template <class Epi>
__device__ __forceinline__ void gemm_phase(LAS unsigned char* lds, const Gemm g, const StaticOrder& S, const Epi& E) {
    const int tid = threadIdx.x, wid = __builtin_amdgcn_readfirstlane(tid >> 6), lane = tid & 63, wr = wid >> 2, wc = wid & 3, fr = lane & 15, fq = lane >> 4;
    const int K = g.K, nt = K / BK;
    unsigned voffA[2], voffB[2];
#pragma unroll
    for (int i = 0; i < 2; ++i) { int R, C; stage_rc(tid * 16 + i * 8192, R, C); const int Rb = Epi::PERM ? ((R & ~31) + perm32(R & 31)) : R;
        voffA[i] = (unsigned)(R * g.lda + C) * 2u; voffB[i] = (unsigned)(Rb * K + C) * 2u; }
    const size_t kstepA = (size_t)g.kstepA, kstepB = (size_t)(BK * 2);
    const size_t hstepA = (size_t)HALF * g.lda * 2, hstepB = (size_t)HALF * K * 2;
    const size_t tstepA = 2 * hstepA, tstepB = 2 * hstepB;
    const unsigned ldsw = (unsigned)wid * 1024u;
    const int aoff = lds_byte(wr * 64 + fr, fq * 8), boff = lds_byte(wc * 32 + fr, fq * 8);
#define PG8_SA(b, h) (((b) * 2 + (h)) * HTB)
#define PG8_SB(b, h) ((4 + (b) * 2 + (h)) * HTB)
#define PG8_STAGE(bufoff, gbase, voff) do { _Pragma("unroll") for (int _i = 0; _i < 2; ++_i) \
        __builtin_amdgcn_global_load_lds((const unsigned*)((const char*)(gbase) + (voff)[_i]), (LAS unsigned*)(lds + (bufoff) + ldsw + _i * 8192), 16, 0, 0); } while (0)
#define PG8_LDA(dst, b, h) do { _Pragma("unroll") for (int m = 0; m < 4; ++m) _Pragma("unroll") for (int k = 0; k < 2; ++k) dst[m][k] = *(const LAS bf16x8*)(lds + PG8_SA(b, h) + aoff + m * 2048 + k * 1024); } while (0)
#define PG8_LDB(dst, b, h) do { _Pragma("unroll") for (int n = 0; n < 2; ++n) _Pragma("unroll") for (int k = 0; k < 2; ++k) dst[n][k] = *(const LAS bf16x8*)(lds + PG8_SB(b, h) + boff + n * 2048 + k * 1024); } while (0)
#define PG8_MMA(ai, bj, At, Bt) do { __builtin_amdgcn_s_setprio(1); _Pragma("unroll") for (int m = 0; m < 4; ++m) _Pragma("unroll") for (int n = 0; n < 2; ++n) _Pragma("unroll") for (int k = 0; k < 2; ++k) \
        acc[ai][bj][m][n] = __builtin_amdgcn_mfma_f32_16x16x32_bf16(Bt[n][k], At[m][k], acc[ai][bj][m][n], 0, 0, 0); __builtin_amdgcn_s_setprio(0); } while (0)
#define PG8_WAIT_V(n) asm volatile("s_waitcnt vmcnt(" #n ")" ::: "memory")
#define PG8_WAIT_L(n) asm volatile("s_waitcnt lgkmcnt(" #n ")" ::: "memory")
#define PG8_BAR __builtin_amdgcn_s_barrier()
#define PG8_SCHED __builtin_amdgcn_sched_barrier(0)
    Unit cur, nxt; int ui = 0;
    if (!S.next(0, cur)) return;
    f32x4 acc[2][2][4][2];
#pragma unroll
    for (int a = 0; a < 2; ++a)
#pragma unroll
        for (int b = 0; b < 2; ++b)
#pragma unroll
            for (int m = 0; m < 4; ++m)
#pragma unroll
                for (int n = 0; n < 2; ++n) acc[a][b][m][n] = (f32x4){0.f, 0.f, 0.f, 0.f};
    bf16x8 At[4][2], B0[2][2], B1[2][2];
    const char* cA = (const char*)g.A + (size_t)cur.pm * tstepA; const char* cB = (const char*)g.Bt + (size_t)cur.pn * tstepB;
    PG8_STAGE(PG8_SB(0, 0), cB, voffB); PG8_STAGE(PG8_SB(0, 1), cB + hstepB, voffB); PG8_STAGE(PG8_SA(0, 0), cA, voffA); PG8_STAGE(PG8_SA(0, 1), cA + hstepA, voffA);
    if (wr == 1) PG8_BAR;
    PG8_WAIT_V(2); PG8_BAR;
    PG8_STAGE(PG8_SB(1, 0), cB + kstepB, voffB); PG8_STAGE(PG8_SA(1, 0), cA + kstepA, voffA); PG8_STAGE(PG8_SB(1, 1), cB + hstepB + kstepB, voffB);
    PG8_WAIT_V(6); PG8_BAR;
    for (;;) {
        const bool has_next = S.next(ui + 1, nxt);
        const char* nA = has_next ? (const char*)g.A + (size_t)nxt.pm * tstepA : cA; const char* nB = has_next ? (const char*)g.Bt + (size_t)nxt.pn * tstepB : cB;
        for (int t = 0; t < nt; t += 2) {
            const bool last = (t == nt - 2);
            const char* a1 = cA + (size_t)(t + 1) * kstepA;
            const char* a2 = last ? nA : cA + (size_t)(t + 2) * kstepA; const char* b2 = last ? nB : cB + (size_t)(t + 2) * kstepB;
            const char* a3 = a2 + kstepA; const char* b3 = b2 + kstepB;
            PG8_LDB(B0, 0, 0); PG8_LDB(B1, 0, 1); PG8_SCHED; PG8_LDA(At, 0, 0); PG8_STAGE(PG8_SA(1, 1), a1 + hstepA, voffA);
            PG8_WAIT_V(8); PG8_WAIT_L(0); PG8_BAR; PG8_MMA(0, 0, At, B0); PG8_MMA(0, 1, At, B1); PG8_BAR; PG8_SCHED;
            PG8_LDA(At, 0, 1); PG8_STAGE(PG8_SB(0, 0), b2, voffB); PG8_STAGE(PG8_SB(0, 1), b2 + hstepB, voffB); PG8_STAGE(PG8_SA(0, 0), a2, voffA);
            PG8_WAIT_V(8); PG8_WAIT_L(0); PG8_BAR; PG8_MMA(1, 0, At, B0); PG8_MMA(1, 1, At, B1); PG8_BAR; PG8_SCHED;
            PG8_LDB(B0, 1, 0); PG8_LDB(B1, 1, 1); PG8_SCHED; PG8_LDA(At, 1, 0); PG8_STAGE(PG8_SA(0, 1), a2 + hstepA, voffA);
            PG8_WAIT_V(8); PG8_WAIT_L(0); PG8_BAR; PG8_MMA(0, 0, At, B0); PG8_MMA(0, 1, At, B1); PG8_BAR; PG8_SCHED;
            PG8_LDA(At, 1, 1); PG8_STAGE(PG8_SB(1, 0), b3, voffB); PG8_STAGE(PG8_SB(1, 1), b3 + hstepB, voffB); PG8_STAGE(PG8_SA(1, 0), a3, voffA);
            PG8_WAIT_V(8); PG8_WAIT_L(0); PG8_BAR; PG8_MMA(1, 0, At, B0); PG8_MMA(1, 1, At, B1); PG8_BAR; PG8_SCHED;
        }
        if (wr == 0) PG8_BAR;
        E(acc, cur, wr, wc, fr, fq);
        if (!has_next) break;
#pragma unroll
        for (int a = 0; a < 2; ++a)
#pragma unroll
            for (int b = 0; b < 2; ++b)
#pragma unroll
                for (int m = 0; m < 4; ++m)
#pragma unroll
                    for (int n = 0; n < 2; ++n) acc[a][b][m][n] = (f32x4){0.f, 0.f, 0.f, 0.f};
        cur = nxt; cA = nA; cB = nB; ++ui;
        if (wr == 1) PG8_BAR;
    }
    PG8_WAIT_V(0);
    PG8_BAR;
#undef PG8_SA
#undef PG8_SB
#undef PG8_STAGE
#undef PG8_LDA
#undef PG8_LDB
#undef PG8_MMA
#undef PG8_WAIT_V
#undef PG8_WAIT_L
#undef PG8_BAR
#undef PG8_SCHED
}
}

constexpr int BATCH = 32, SEQ = 2048, DM = 1024, NTOK = BATCH * SEQ, NMEM = 256, NH = 12, HD = 64, MAINW = 768;
constexpr int AIN = 1444, AINP = 1536, DFF = 2816, NCMP = 127;
constexpr int HALF_TOK = NTOK / 2;
constexpr float ALPHA = 1.4142135623730951f;
constexpr float LN_EPS = 1e-5f;
constexpr int P_Q = 0, P_KC = 768, P_VC = 832, P_KS = 896, P_VS = 960, P_KW = 1024, P_VW = 1088, P_QM = 1152, P_G = 1408;
constexpr size_t MiB = 1u << 20;
constexpr size_t WS_WAIN = 0 * MiB, WS_WAMKV = 3 * MiB, WS_WAOUT = 4 * MiB, WS_WSKV = 6 * MiB, WS_WBIN = 9 * MiB, WS_WBMKV = 11 * MiB, WS_WBOUT = 12 * MiB;
constexpr size_t WS_WFIN = 14 * MiB  , WS_WFOUT = 36 * MiB  , WS_WC1K = 47 * MiB, WS_WC1V = 48 * MiB, WS_WMKV = 49 * MiB  ;
constexpr size_t WS_CTL = 51 * MiB, CTL_BYTES = 16384;
constexpr size_t WS_MEMB = 52 * MiB, WS_MKV = 68 * MiB  , WS_CMPH = 84 * MiB, WS_KCMP = 92 * MiB, WS_VCMP = 93 * MiB, WS_CBIAS = 94 * MiB, WS_SEL = 94 * MiB + 65536, WS_KMEAN = 95 * MiB;
constexpr size_t WS_XB = 96 * MiB, WS_BIG = 226 * MiB;
constexpr size_t BIG_P = 0, BIG_O0 = 193 * MiB, BIG_H = 0, BIG_TAILA = 352 * MiB, BIG_HEADA = 374 * MiB, BIG_HEADB = 396 * MiB, BIG_KV = 0, BIG_Q1 = 193 * MiB, BIG_O1 = 321 * MiB;
constexpr size_t WS_NEED = WS_BIG + 449 * MiB;

constexpr int LDS_BYTES = 147456;
constexpr int NTHR = 512;

struct Params {
    const float* in[24];
    float* out;
    unsigned char* ws;
    int ph_lo, ph_hi;
};
enum { I_X = 0, I_MEM, I_RELB, I_AWIN, I_PEK, I_W1K, I_W2K, I_PEV, I_W1V, I_W2V, I_AWMKV, I_AWOUT, I_SWKV, I_BWIN, I_BWMKV, I_BWOUT, I_LN1G, I_LN1B, I_LN2G, I_LN2B, I_FWIN, I_FCW, I_FCB, I_FWOUT };

namespace att {
constexpr int ROWB = 144, TILEB = 64 * ROWB, VROWB = 192, VTILEB = 64 * VROWB;
constexpr float NEG = -1e30f;
constexpr float LOG2E = 1.4426950408889634f;
constexpr float SC2 = 0.125f * LOG2E;
typedef short v4i16_t __attribute__((ext_vector_type(4)));

__device__ __forceinline__ f32x16 zero16() { f32x16 z;
#pragma unroll
    for (int i = 0; i < 16; ++i) z[i] = 0.f; return z; }

__device__ __forceinline__ void qk_tile(f32x16& p0, f32x16& p1, const LAS unsigned char* Kt, const bf16x8 (&qr)[4], int r32, int hi, float cinit = 0.f) {
    const LAS unsigned char* kb = Kt + r32 * ROWB + hi * 16;
#pragma unroll
    for (int i = 0; i < 16; ++i) { p0[i] = cinit; p1[i] = cinit; }
#pragma unroll
    for (int d0 = 0; d0 < 4; ++d0) {
        const bf16x8 k0 = *(const LAS bf16x8*)(kb + d0 * 32);
        const bf16x8 k1 = *(const LAS bf16x8*)(kb + 32 * ROWB + d0 * 32);
        p0 = __builtin_amdgcn_mfma_f32_32x32x16_bf16(k0, qr[d0], p0, 0, 0, 0);
        p1 = __builtin_amdgcn_mfma_f32_32x32x16_bf16(k1, qr[d0], p1, 0, 0, 0);
    }
}
__device__ __forceinline__ s16x4 vtr(const LAS unsigned char* p) { return __builtin_bit_cast(s16x4, __builtin_amdgcn_ds_read_tr16_b64_v4i16((LAS v4i16_t*)p)); }
__device__ __forceinline__ void pv_tile(f32x16& o0, f32x16& o1, const LAS unsigned char* Vt, const f32x16& p0, const f32x16& p1, int lane) {
    const int hi = lane >> 5, g1 = (lane >> 4) & 1, i = lane & 15, q_ = i >> 2, p_ = i & 3;
    const LAS unsigned char* vb = Vt + (4 * hi + q_) * VROWB + (16 * g1 + 4 * p_) * 2;
#pragma unroll
    for (int s = 0; s < 4; ++s) {
        u32x4 w;
        if (s < 2) { const int b = 8 * (s & 1); w.x = cvt_pk_bf16(p0[b + 0], p0[b + 1]); w.y = cvt_pk_bf16(p0[b + 2], p0[b + 3]); w.z = cvt_pk_bf16(p0[b + 4], p0[b + 5]); w.w = cvt_pk_bf16(p0[b + 6], p0[b + 7]); }
        else       { const int b = 8 * (s & 1); w.x = cvt_pk_bf16(p1[b + 0], p1[b + 1]); w.y = cvt_pk_bf16(p1[b + 2], p1[b + 3]); w.z = cvt_pk_bf16(p1[b + 4], p1[b + 5]); w.w = cvt_pk_bf16(p1[b + 6], p1[b + 7]); }
        const bf16x8 pf = __builtin_bit_cast(bf16x8, w);
#pragma unroll
        for (int dh = 0; dh < 2; ++dh) {
            const s16x4 lo = vtr(vb + (16 * s) * VROWB + dh * 64);
            const s16x4 h4 = vtr(vb + (16 * s + 8) * VROWB + dh * 64);
            const bf16x8 vf = (bf16x8){lo[0], lo[1], lo[2], lo[3], h4[0], h4[1], h4[2], h4[3]};
            if (dh == 0) o0 = __builtin_amdgcn_mfma_f32_32x32x16_bf16(vf, pf, o0, 0, 0, 0);
            else         o1 = __builtin_amdgcn_mfma_f32_32x32x16_bf16(vf, pf, o1, 0, 0, 0);
        }
    }
}
struct Acc { float m, l; f32x16 o0, o1; };
__device__ __forceinline__ void acc_init(Acc& A) { A.m = NEG; A.l = 0.f; A.o0 = zero16(); A.o1 = zero16(); }
constexpr float THR_RAW = 8.0f / SC2;
__device__ __forceinline__ void sm_update(Acc& A, f32x16& p0, f32x16& p1) {
    float m0 = fmaxf(p0[0], p1[0]), m1 = fmaxf(p0[1], p1[1]);
#pragma unroll
    for (int r = 2; r < 16; r += 2) { m0 = fmaxf(fmaxf(m0, p0[r]), p1[r]); m1 = fmaxf(fmaxf(m1, p0[r + 1]), p1[r + 1]); }
    float mx = fmaxf(m0, m1);
    mx = fmaxf(mx, __shfl_xor(mx, 32));
    if (__any(mx > A.m + THR_RAW)) {
        const float mn = fmaxf(A.m, mx);
        const float alpha = __builtin_amdgcn_exp2f((A.m - (mn < -5e29f ? 0.f : mn)) * SC2);
        A.l *= alpha; A.m = mn;
#pragma unroll
        for (int r = 0; r < 16; ++r) { A.o0[r] *= alpha; A.o1[r] *= alpha; }
    }
    const float msc = (A.m < -5e29f ? 0.f : A.m) * SC2;
    float rs0 = 0.f, rs1 = 0.f;
#pragma unroll
    for (int r = 0; r < 16; ++r) {
        const float e0 = __builtin_amdgcn_exp2f(p0[r] * SC2 - msc);
        const float e1 = __builtin_amdgcn_exp2f(p1[r] * SC2 - msc);
        p0[r] = e0; p1[r] = e1; rs0 += e0; rs1 += e1;
    }
    A.l += rs0 + rs1;
}
__device__ __forceinline__ float rowmax32(const f32x16& p0, const f32x16& p1) {
    float m0 = fmaxf(p0[0], p1[0]), m1 = fmaxf(p0[1], p1[1]), m2 = fmaxf(p0[2], p1[2]), m3 = fmaxf(p0[3], p1[3]);
#pragma unroll
    for (int r = 4; r < 16; r += 4) { m0 = fmaxf(fmaxf(m0, p0[r]), p1[r]); m1 = fmaxf(fmaxf(m1, p0[r + 1]), p1[r + 1]); m2 = fmaxf(fmaxf(m2, p0[r + 2]), p1[r + 2]); m3 = fmaxf(fmaxf(m3, p0[r + 3]), p1[r + 3]); }
    return fmaxf(fmaxf(m0, m1), fmaxf(m2, m3));
}
__device__ __forceinline__ void sm_update2(Acc& A, Acc& B, f32x16& a0, f32x16& a1, f32x16& b0, f32x16& b1) {
    float mxa = rowmax32(a0, a1), mxb = rowmax32(b0, b1);
    mxa = fmaxf(mxa, __shfl_xor(mxa, 32)); mxb = fmaxf(mxb, __shfl_xor(mxb, 32));
    if (__any((mxa > A.m + THR_RAW) || (mxb > B.m + THR_RAW))) {
        const float mna = fmaxf(A.m, mxa), mnb = fmaxf(B.m, mxb);
        const float ala = __builtin_amdgcn_exp2f((A.m - (mna < -5e29f ? 0.f : mna)) * SC2), alb = __builtin_amdgcn_exp2f((B.m - (mnb < -5e29f ? 0.f : mnb)) * SC2);
        A.l *= ala; A.m = mna; B.l *= alb; B.m = mnb;
#pragma unroll
        for (int r = 0; r < 16; ++r) { A.o0[r] *= ala; B.o0[r] *= alb; A.o1[r] *= ala; B.o1[r] *= alb; }
    }
    const float msa = (A.m < -5e29f ? 0.f : A.m) * SC2, msb = (B.m < -5e29f ? 0.f : B.m) * SC2;
    float ra0 = 0.f, ra1 = 0.f, rb0 = 0.f, rb1 = 0.f;
#pragma unroll
    for (int r = 0; r < 16; ++r) {
        const float ea0 = __builtin_amdgcn_exp2f(a0[r] * SC2 - msa), eb0 = __builtin_amdgcn_exp2f(b0[r] * SC2 - msb);
        const float ea1 = __builtin_amdgcn_exp2f(a1[r] * SC2 - msa), eb1 = __builtin_amdgcn_exp2f(b1[r] * SC2 - msb);
        a0[r] = ea0; b0[r] = eb0; a1[r] = ea1; b1[r] = eb1; ra0 += ea0; rb0 += eb0; ra1 += ea1; rb1 += eb1;
    }
    A.l += ra0 + ra1; B.l += rb0 + rb1;
}
__device__ __forceinline__ float acc_inv(const Acc& A) { const float lt = A.l + __shfl_xor(A.l, 32); return 1.0f / fmaxf(lt, 1e-30f); }

__device__ __forceinline__ void apply_general(f32x16& p0, f32x16& p1, int dist0, const LAS float* tab, bool allow, int W) {
    const unsigned We = allow ? (unsigned)W : 0u;
#pragma unroll
    for (int r = 0; r < 16; ++r) {
        const int d_0 = dist0 - ((r & 3) + 8 * (r >> 2)), d_1 = d_0 - 32;
        const int i0 = ((unsigned)d_0 < We) ? min(d_0, 128) + 1 : 0, i1 = ((unsigned)d_1 < We) ? min(d_1, 128) + 1 : 0;
        p0[r] += tab[i0];
        p1[r] += tab[i1];
        if ((r & 3) == 3) __builtin_amdgcn_sched_barrier(0);
    }
}
__device__ __forceinline__ int rel_bucket(int n) {
    if (n < 16) return n;
    const float v = logf((float)n / 16.0f) / 2.0794415416798357f * 16.0f;
    int l = 16 + (int)v; return l < 31 ? l : 31;
}
__device__ __forceinline__ u32x4 tile_ld(const bf16_t* base, long ld, int row0, int rmin, int rmax, int tid) {
    int r = row0 + (tid >> 3); r = r < rmin ? rmin : (r > rmax ? rmax : r);
    return *(const u32x4*)(base + (long)r * ld + (tid & 7) * 8);
}
__device__ __forceinline__ void tile_st(LAS unsigned char* buf, u32x4 v, int tid) { *(LAS u32x4*)(buf + (tid >> 3) * ROWB + (tid & 7) * 16) = v; }
__device__ __forceinline__ void tile_stv(LAS unsigned char* buf, u32x4 v, int tid) { *(LAS u32x4*)(buf + (tid >> 3) * VROWB + (tid & 7) * 16) = v; }
__device__ __forceinline__ void load_q(bf16x8 (&qr)[4], const bf16_t* qrow, int hi) {
#pragma unroll
    for (int d0 = 0; d0 < 4; ++d0) qr[d0] = *(const bf16x8*)(qrow + d0 * 16 + hi * 8);
}
__device__ __forceinline__ void store_o(bf16_t* orow, const f32x16& o0, const f32x16& o1, int hi) {
#pragma unroll
    for (int g = 0; g < 4; ++g) {
        u32x2 w0, w1; w0.x = cvt_pk_bf16(o0[4 * g], o0[4 * g + 1]); w0.y = cvt_pk_bf16(o0[4 * g + 2], o0[4 * g + 3]);
        w1.x = cvt_pk_bf16(o1[4 * g], o1[4 * g + 1]); w1.y = cvt_pk_bf16(o1[4 * g + 2], o1[4 * g + 3]);
        *(u32x2*)(orow + 8 * g + 4 * hi) = w0; *(u32x2*)(orow + 32 + 8 * g + 4 * hi) = w1;
    }
}
__device__ __forceinline__ void add_prev_o(const bf16_t* orow, f32x16& o0, f32x16& o1, int hi) {
#pragma unroll
    for (int g = 0; g < 4; ++g) {
        const u32x2 w0 = *(const u32x2*)(orow + 8 * g + 4 * hi), w1 = *(const u32x2*)(orow + 32 + 8 * g + 4 * hi);
        o0[4 * g] += __uint_as_float(w0.x << 16); o0[4 * g + 1] += __uint_as_float(w0.x & 0xffff0000u); o0[4 * g + 2] += __uint_as_float(w0.y << 16); o0[4 * g + 3] += __uint_as_float(w0.y & 0xffff0000u);
        o1[4 * g] += __uint_as_float(w1.x << 16); o1[4 * g + 1] += __uint_as_float(w1.x & 0xffff0000u); o1[4 * g + 2] += __uint_as_float(w1.y << 16); o1[4 * g + 3] += __uint_as_float(w1.y & 0xffff0000u);
    }
}
__device__ __forceinline__ float sigmoidf(float x) { return 1.0f / (1.0f + __expf(-x)); }

constexpr int L_K0 = 0, L_K1 = TILEB, L_V0 = 2 * TILEB, L_V1 = 2 * TILEB + VTILEB, L_TAB = 2 * TILEB + 2 * VTILEB  , L_SIMP = 53248  , L_Q = 53248  , L_BKT = 131072  , L_MISC = 131072 + 1024  ;

__device__ __forceinline__ const LAS unsigned char* park_q(LAS unsigned char* lds, const bf16_t* q0, const bf16_t* q1, int wid, int lane, int hi) {
    LAS unsigned char* qp = lds + L_Q + wid * 8192 + lane * 16;
#pragma unroll
    for (int d0 = 0; d0 < 4; ++d0) { *(LAS bf16x8*)(qp + d0 * 1024) = *(const bf16x8*)(q0 + d0 * 16 + hi * 8); *(LAS bf16x8*)(qp + 4096 + d0 * 1024) = *(const bf16x8*)(q1 + d0 * 16 + hi * 8); }
    return qp;
}
__device__ __forceinline__ void fill_tab(LAS unsigned char* lds, const float* relb, int h0, int nh, int tid) {
    LAS float* tab = (LAS float*)(lds + L_TAB);
    const LAS int* bkt = (const LAS int*)(lds + L_BKT);
    for (int i = tid; i < nh * 130; i += NTHR) { const int hh = i / 130, d = i % 130; tab[hh * 132 + d] = d == 0 ? NEG : relb[bkt[d] * NH + h0 + hh] * 8.0f; }
}

template <int MODE>
struct TileInfo { bool want, near, allow; float cinit; };
template <int MODE>
__device__ __forceinline__ TileInfo<MODE> classify(int kt, int tw, unsigned selmask, int blkshift, int W, float b129) {
    TileInfo<MODE> ti; const int kbase = kt * 64;
    if (MODE == 0) { ti.want = true; ti.near = false; ti.allow = true; ti.cinit = 0.f; }
    else if (MODE == 1) { ti.allow = (selmask >> (kt >> blkshift)) & 1u; ti.want = (kbase <= tw + 31) && __any(ti.allow); ti.near = !(tw - (kbase + 63) >= 128); ti.cinit = ti.near ? 0.f : (ti.allow ? b129 : NEG); }
    else { ti.allow = true; ti.want = (kbase <= tw + 31) && (kbase + 63 >= tw - (W - 1)); ti.near = !((tw - (kbase + 63) >= 128) && (tw + 31 - kbase < W)); ti.cinit = ti.near ? 0.f : b129; }
    return ti;
}
template <int MODE, bool QREG>
__device__ __forceinline__ void seg2(Acc (&A)[2], LAS unsigned char* lds, const bf16_t* Kg, const bf16_t* Vg, long ld, int rmax, int lo, int hi_t,
                                     const LAS unsigned char* qp  , int t0  , int tw0, unsigned sel0, unsigned sel1, int blkshift, int W, const LAS float* tab, int tid) {
    const int lane = tid & 63, r32 = lane & 31, hi = lane >> 5;
    if (lo >= hi_t) return;
    {
        const u32x4 k0 = tile_ld(Kg, ld, lo * 64, 0, rmax, tid), v0 = tile_ld(Vg, ld, lo * 64, 0, rmax, tid);
        __syncthreads();
        tile_st(lds + L_K0, k0, tid); tile_stv(lds + L_V0, v0, tid);
        __syncthreads();
    }
    const float b129 = (MODE == 0) ? 0.f : tab[129];
    const int g1 = (lane >> 4) & 1, i16 = lane & 15, q_ = i16 >> 2, p_ = i16 & 3;
    bf16x8 qra[4], qrb[4];
    if (QREG) {
#pragma unroll
        for (int d0 = 0; d0 < 4; ++d0) { qra[d0] = *(const LAS bf16x8*)(qp + d0 * 1024); qrb[d0] = *(const LAS bf16x8*)(qp + 4096 + d0 * 1024); }
    }
    int cur = 0;
    for (int kt = lo; kt < hi_t; ++kt) {
        const bool more1 = kt + 1 < hi_t;
        u32x4 kreg, vreg;
        if (more1) { kreg = tile_ld(Kg, ld, (kt + 1) * 64, 0, rmax, tid); vreg = tile_ld(Vg, ld, (kt + 1) * 64, 0, rmax, tid); }
        TileInfo<MODE> ta = classify<MODE>(kt, tw0, sel0, blkshift, W, b129), tb = classify<MODE>(kt, tw0 + 32, sel1, blkshift, W, b129);
        if (ta.want || tb.want) {
            if (!ta.want) { ta.cinit = NEG; ta.near = false; }
            if (!tb.want) { tb.cinit = NEG; tb.near = false; }
            const LAS unsigned char* Kt = lds + (cur ? L_K1 : L_K0); const LAS unsigned char* Vt = lds + (cur ? L_V1 : L_V0);
            f32x16 a0, a1, b0, b1;
#pragma unroll
            for (int i = 0; i < 16; ++i) { a0[i] = ta.cinit; a1[i] = ta.cinit; b0[i] = tb.cinit; b1[i] = tb.cinit; }
            const LAS unsigned char* kb = Kt + r32 * ROWB + hi * 16;
#pragma unroll
            for (int d0 = 0; d0 < 4; ++d0) {
                const bf16x8 k0 = *(const LAS bf16x8*)(kb + d0 * 32);
                const bf16x8 k1 = *(const LAS bf16x8*)(kb + 32 * ROWB + d0 * 32);
                const bf16x8 qa = QREG ? qra[d0] : *(const LAS bf16x8*)(qp + d0 * 1024), qb_ = QREG ? qrb[d0] : *(const LAS bf16x8*)(qp + 4096 + d0 * 1024);
                a0 = __builtin_amdgcn_mfma_f32_32x32x16_bf16(k0, qa, a0, 0, 0, 0);
                b0 = __builtin_amdgcn_mfma_f32_32x32x16_bf16(k0, qb_, b0, 0, 0, 0);
                a1 = __builtin_amdgcn_mfma_f32_32x32x16_bf16(k1, qa, a1, 0, 0, 0);
                b1 = __builtin_amdgcn_mfma_f32_32x32x16_bf16(k1, qb_, b1, 0, 0, 0);
            }
            if (MODE != 0) {
                if (ta.near) apply_general(a0, a1, t0 - kt * 64 - 4 * hi, tab, ta.allow, W);
                if (tb.near) apply_general(b0, b1, t0 + 32 - kt * 64 - 4 * hi, tab, tb.allow, W);
            }
            sm_update2(A[0], A[1], a0, a1, b0, b1);
            const LAS unsigned char* vb = Vt + (4 * hi + q_) * VROWB + (16 * g1 + 4 * p_) * 2;
#pragma unroll
            for (int s = 0; s < 4; ++s) {
                const int bs = 8 * (s & 1);
                u32x4 wa, wb;
                if (s < 2) { wa.x = cvt_pk_bf16(a0[bs + 0], a0[bs + 1]); wa.y = cvt_pk_bf16(a0[bs + 2], a0[bs + 3]); wa.z = cvt_pk_bf16(a0[bs + 4], a0[bs + 5]); wa.w = cvt_pk_bf16(a0[bs + 6], a0[bs + 7]);
                             wb.x = cvt_pk_bf16(b0[bs + 0], b0[bs + 1]); wb.y = cvt_pk_bf16(b0[bs + 2], b0[bs + 3]); wb.z = cvt_pk_bf16(b0[bs + 4], b0[bs + 5]); wb.w = cvt_pk_bf16(b0[bs + 6], b0[bs + 7]); }
                else       { wa.x = cvt_pk_bf16(a1[bs + 0], a1[bs + 1]); wa.y = cvt_pk_bf16(a1[bs + 2], a1[bs + 3]); wa.z = cvt_pk_bf16(a1[bs + 4], a1[bs + 5]); wa.w = cvt_pk_bf16(a1[bs + 6], a1[bs + 7]);
                             wb.x = cvt_pk_bf16(b1[bs + 0], b1[bs + 1]); wb.y = cvt_pk_bf16(b1[bs + 2], b1[bs + 3]); wb.z = cvt_pk_bf16(b1[bs + 4], b1[bs + 5]); wb.w = cvt_pk_bf16(b1[bs + 6], b1[bs + 7]); }
                const bf16x8 pfa = __builtin_bit_cast(bf16x8, wa), pfb = __builtin_bit_cast(bf16x8, wb);
#pragma unroll
                for (int dh = 0; dh < 2; ++dh) {
                    const s16x4 lo4 = vtr(vb + (16 * s) * VROWB + dh * 64);
                    const s16x4 h4 = vtr(vb + (16 * s + 8) * VROWB + dh * 64);
                    const bf16x8 vf = (bf16x8){lo4[0], lo4[1], lo4[2], lo4[3], h4[0], h4[1], h4[2], h4[3]};
                    if (dh == 0) { A[0].o0 = __builtin_amdgcn_mfma_f32_32x32x16_bf16(vf, pfa, A[0].o0, 0, 0, 0); A[1].o0 = __builtin_amdgcn_mfma_f32_32x32x16_bf16(vf, pfb, A[1].o0, 0, 0, 0); }
                    else         { A[0].o1 = __builtin_amdgcn_mfma_f32_32x32x16_bf16(vf, pfa, A[0].o1, 0, 0, 0); A[1].o1 = __builtin_amdgcn_mfma_f32_32x32x16_bf16(vf, pfb, A[1].o1, 0, 0, 0); }
                }
            }
        }
        if (more1) { tile_st(lds + (cur ? L_K0 : L_K1), kreg, tid); tile_stv(lds + (cur ? L_V0 : L_V1), vreg, tid); }
        __syncthreads();
        cur ^= 1;
    }
}
}

struct Ctx { int tid, lane, wid, gtid, gsz, gw, ngw; };

template <int MAP>
__device__ __forceinline__ void xpose_w(const Ctx& c, const float* W, int K, int N, bf16_t* WT, int Ndst, int dst_off = 0) {
    const int nk = K >> 6; const long total = (long)Ndst * nk;
    for (long i = c.gtid; i < total; i += c.gsz) {
        const int n = (int)(i % Ndst), kc = (int)(i / Ndst);
        int src = n;
        if (MAP == 1) { if (n >= 1152 && n < 1408) src = 1188 + (n - 1152); else if (n >= 1408 && n < 1444) src = 1152 + (n - 1408); else if (n >= 1444) src = -1; }
        else if (MAP == 2) { const int tl = n >> 8, wi = n & 255; src = wi < 128 ? tl * 128 + wi : 2816 + tl * 128 + (wi - 128); }
        else if (n >= N) src = -1;
        bf16_t* dst = WT + (size_t)(dst_off + n) * K + kc * 64;
        if (src < 0) {
#pragma unroll
            for (int q = 0; q < 8; ++q) *(u32x4*)(dst + q * 8) = (u32x4){0u, 0u, 0u, 0u};
        } else {
            const float* s = W + (size_t)(kc * 64) * N + src;
#pragma unroll
            for (int q = 0; q < 8; ++q) {
                u32x4 w; const float* sq = s + (size_t)(q * 8) * N;
                w.x = cvt_pk_bf16(sq[0], sq[(size_t)N]); w.y = cvt_pk_bf16(sq[2 * (size_t)N], sq[3 * (size_t)N]); w.z = cvt_pk_bf16(sq[4 * (size_t)N], sq[5 * (size_t)N]); w.w = cvt_pk_bf16(sq[6 * (size_t)N], sq[7 * (size_t)N]);
                *(u32x4*)(dst + q * 8) = w;
            }
        }
    }
}
__device__ __forceinline__ void cvt_rows(const Ctx& c, const float* X, bf16_t* XB, long nelem) {
    const long n8 = nelem >> 3;
    for (long i = c.gtid; i < n8; i += c.gsz) {
        const f32x4 a = *(const f32x4*)(X + i * 8), b = *(const f32x4*)(X + i * 8 + 4);
        u32x4 w; w.x = cvt_pk_bf16(a[0], a[1]); w.y = cvt_pk_bf16(a[2], a[3]); w.z = cvt_pk_bf16(b[0], b[1]); w.w = cvt_pk_bf16(b[2], b[3]);
        *(u32x4*)(XB + i * 8) = w;
    }
}
__device__ __forceinline__ void prep_late(const Params& p, const Ctx& c) {
    unsigned char* ws = p.ws;
    xpose_w<0>(c, p.in[I_AWOUT], DM, DM, (bf16_t*)(ws + WS_WAOUT), DM);
    xpose_w<0>(c, p.in[I_SWKV], DM, 1536, (bf16_t*)(ws + WS_WSKV), 1536);
    xpose_w<0>(c, p.in[I_BWIN], DM, DM, (bf16_t*)(ws + WS_WBIN), DM);
    xpose_w<0>(c, p.in[I_BWOUT], DM, DM, (bf16_t*)(ws + WS_WBOUT), DM);
    for (int l = 0; l < 2; ++l) {
        xpose_w<2>(c, p.in[I_FWIN] + (size_t)l * DM * 2 * DFF, DM, 2 * DFF, (bf16_t*)(ws + WS_WFIN) + (size_t)l * 2 * DFF * DM, 2 * DFF);
        xpose_w<0>(c, p.in[I_FWOUT] + (size_t)l * DFF * DM, DFF, DM, (bf16_t*)(ws + WS_WFOUT) + (size_t)l * DM * DFF, DM);
    }
}
constexpr int LATE_FIRST_WG = 160;
__device__ __forceinline__ void phase_prep(const Params& p, const Ctx& c) {
    unsigned char* ws = p.ws;
    xpose_w<1>(c, p.in[I_AWIN], DM, AIN, (bf16_t*)(ws + WS_WAIN), AINP);
    xpose_w<0>(c, p.in[I_AWMKV], DM, 512, (bf16_t*)(ws + WS_WMKV), 512, 0);
    xpose_w<0>(c, p.in[I_BWMKV], DM, 512, (bf16_t*)(ws + WS_WMKV), 512, 512);
    xpose_w<0>(c, p.in[I_W1K], 2048, 256, (bf16_t*)(ws + WS_WC1K), 256);
    xpose_w<0>(c, p.in[I_W1V], 2048, 256, (bf16_t*)(ws + WS_WC1V), 256);
    if ((int)gridDim.x < LATE_FIRST_WG + 32) prep_late(p, c);
    cvt_rows(c, p.in[I_X], (bf16_t*)(ws + WS_XB), (long)NTOK * DM);
    cvt_rows(c, p.in[I_MEM], (bf16_t*)(ws + WS_MEMB), (long)BATCH * NMEM * DM);
    for (int o = c.gw; o < 512; o += c.ngw) {
        const int which = o >> 8, j = o & 255;
        const float* pe = p.in[which ? I_PEV : I_PEK]; const float* w1 = p.in[which ? I_W1V : I_W1K];
        float s = 0.f;
#pragma unroll 8
        for (int k = c.lane; k < 2048; k += 64) s += pe[k] * w1[(size_t)k * 256 + j];
#pragma unroll
        for (int sh = 1; sh < 64; sh <<= 1) s += __shfl_xor(s, sh);
        if (c.lane == 0) ((float*)(ws + WS_CBIAS))[which * 256 + j] = s;
    }
}
__device__ __forceinline__ void phase_cmp2(const Params& p, const Ctx& c) {
    unsigned char* ws = p.ws;
    for (int i = c.gtid; i < 2 * 4096 * 64; i += c.gsz) {
        const int which = i >> 18, m = (i >> 6) & 4095, d = i & 63;
        const float* hid = (const float*)(ws + WS_CMPH) + ((size_t)which * 4096 + m) * 256; const float* w2 = p.in[which ? I_W2V : I_W2K];
        float s = 0.f;
#pragma unroll 8
        for (int j = 0; j < 256; ++j) s += hid[j] * w2[j * 64 + d];
        if ((m & 127) == 127) s = 0.f;
        unsigned u = __float_as_uint(s); u = (u + 0x7fffu + ((u >> 16) & 1u)) >> 16;
        ((bf16_t*)(ws + (which ? WS_VCMP : WS_KCMP)))[(size_t)m * 64 + d] = (bf16_t)u;
    }
}
__device__ __forceinline__ void phase_ln(const Ctx& c, const float* y, const float* g, const float* bta, float* xf, bf16_t* xb) {
    for (int row = c.gw; row < NTOK; row += c.ngw) {
        const float* yr = y + (size_t)row * DM + c.lane * 4;
        f32x4 v[4]; float s = 0.f;
#pragma unroll
        for (int j = 0; j < 4; ++j) { v[j] = *(const f32x4*)(yr + 256 * j); s += (v[j][0] + v[j][1]) + (v[j][2] + v[j][3]); }
#pragma unroll
        for (int o = 1; o < 64; o <<= 1) s += __shfl_xor(s, o);
        const float mean = s * (1.0f / DM); float q = 0.f;
#pragma unroll
        for (int j = 0; j < 4; ++j) { v[j] = v[j] - mean; q += (v[j][0] * v[j][0] + v[j][1] * v[j][1]) + (v[j][2] * v[j][2] + v[j][3] * v[j][3]); }
#pragma unroll
        for (int o = 1; o < 64; o <<= 1) q += __shfl_xor(q, o);
        const float rstd = 1.0f / sqrtf(q * (1.0f / DM) + LN_EPS);
#pragma unroll
        for (int j = 0; j < 4; ++j) {
            const f32x4 gg = *(const f32x4*)(g + c.lane * 4 + 256 * j), bb = *(const f32x4*)(bta + c.lane * 4 + 256 * j);
            const f32x4 o = v[j] * rstd * gg + bb;
            if (xf) *(f32x4*)(xf + (size_t)row * DM + c.lane * 4 + 256 * j) = o;
            if (xb) { u32x2 w; w.x = cvt_pk_bf16(o[0], o[1]); w.y = cvt_pk_bf16(o[2], o[3]); *(u32x2*)(xb + (size_t)row * DM + c.lane * 4 + 256 * j) = w; }
        }
    }
}
__device__ __forceinline__ void unpack8(const u32x4 w, float (&f)[8]) {
    f[0] = __uint_as_float(w.x << 16); f[1] = __uint_as_float(w.x & 0xffff0000u); f[2] = __uint_as_float(w.y << 16); f[3] = __uint_as_float(w.y & 0xffff0000u);
    f[4] = __uint_as_float(w.z << 16); f[5] = __uint_as_float(w.z & 0xffff0000u); f[6] = __uint_as_float(w.w << 16); f[7] = __uint_as_float(w.w & 0xffff0000u);
}
__device__ __forceinline__ void ffn_fixup(const Ctx& c, unsigned char* big, const float* cw, const float* cbias, int pm) {
    const float* TAILA = (const float*)(big + BIG_TAILA); const float* HEADA = (const float*)(big + BIG_HEADA); const float* HEADB = (const float*)(big + BIG_HEADB); bf16_t* H = (bf16_t*)(big + BIG_H);
    constexpr int NCH = DFF / 8;
    for (int it = c.tid; it < 4 * 2 * NCH; it += NTHR) {
        const int ch = it % NCH, gi = it / NCH, i = gi & 1, G = pm * 4 + (gi >> 1), col = ch * 8;
        const bool first = ((G * 64) & (SEQ - 1)) == 0;
        float p0[8], p1[8], a0[8], a1[8], b[8], h[8];
#pragma unroll
        for (int j = 0; j < 8; ++j) { p0[j] = 0.f; p1[j] = 0.f; }
        if (!first) {
            const float* t0 = TAILA + ((size_t)(G - 1) * 2) * DFF + col;
#pragma unroll
            for (int j = 0; j < 8; ++j) { p0[j] = t0[j]; p1[j] = t0[DFF + j]; }
        }
        const float* ha = HEADA + ((size_t)G * 2) * DFF + col; const float* hb = HEADB + ((size_t)G * 2 + i) * DFF + col;
#pragma unroll
        for (int j = 0; j < 8; ++j) { a0[j] = ha[j]; a1[j] = ha[DFF + j]; b[j] = hb[j]; }
#pragma unroll
        for (int j = 0; j < 8; ++j) {
            const float am2 = i ? p1[j] : p0[j], am1 = i ? a0[j] : p1[j], a = i ? a1[j] : a0[j];
            const float pre = cw[col + j] * am2 + cw[DFF + col + j] * am1 + cw[2 * DFF + col + j] * a + cbias[col + j];
            h[j] = gelu_tanh(pre) * b[j];
        }
        u32x4 w; w.x = cvt_pk_bf16(h[0], h[1]); w.y = cvt_pk_bf16(h[2], h[3]); w.z = cvt_pk_bf16(h[4], h[5]); w.w = cvt_pk_bf16(h[6], h[7]);
        *(u32x4*)(H + (size_t)(G * 64 + i) * DFF + col) = w;
    }
}
__device__ __forceinline__ void phase_kmean(const Ctx& c, const bf16_t* KV, float* KM) {
    for (int it = c.gw; it < BATCH * 8 * 12; it += c.ngw) {
        const int cg_ = it % 12, bn = it / 12, ch = c.lane & 7, rs = c.lane >> 3;
        float s[8];
#pragma unroll
        for (int j = 0; j < 8; ++j) s[j] = 0.f;
        const bf16_t* src = KV + (size_t)bn * 256 * 1536 + cg_ * 64 + ch * 8;
#pragma unroll 4
        for (int r = rs; r < 256; r += 8) { float v[8]; unpack8(*(const u32x4*)(src + (size_t)r * 1536), v);
#pragma unroll
            for (int j = 0; j < 8; ++j) s[j] += v[j]; }
#pragma unroll
        for (int j = 0; j < 8; ++j) { s[j] += __shfl_xor(s[j], 8); s[j] += __shfl_xor(s[j], 16); s[j] += __shfl_xor(s[j], 32); }
        if (rs == 0) {
#pragma unroll
            for (int j = 0; j < 8; ++j) KM[(size_t)bn * 768 + cg_ * 64 + ch * 8 + j] = s[j] * (1.0f / 256.0f);
        }
    }
}

__device__ __forceinline__ void nsa1_unit(const Params& p, LAS unsigned char* lds, int b, int qb) {
    using namespace att;
    int tid_ = threadIdx.x; asm volatile("" : "+v"(tid_));
    const int tid = tid_, lane = tid & 63, r32 = lane & 31, hi = lane >> 5, wid = tid >> 6;
    unsigned char* ws = p.ws;
    const bf16_t* P = (const bf16_t*)(ws + WS_BIG + BIG_P); bf16_t* O = (bf16_t*)(ws + WS_BIG + BIG_O0);
    const bf16_t* KC = (const bf16_t*)(ws + WS_KCMP) + (size_t)b * 128 * 64; const bf16_t* VC = (const bf16_t*)(ws + WS_VCMP) + (size_t)b * 128 * 64;
    __syncthreads();
    tile_st(lds + L_K0, tile_ld(KC, 64, 0, 0, 127, tid), tid); tile_st(lds + L_K1, tile_ld(KC, 64, 64, 0, 127, tid), tid);
    tile_stv(lds + L_V0, tile_ld(VC, 64, 0, 0, 127, tid), tid); tile_stv(lds + L_V1, tile_ld(VC, 64, 64, 0, 127, tid), tid);
    fill_tab(lds, p.in[I_RELB], 0, NH, tid);
    __syncthreads();
    const int t = qb * 256 + wid * 32 + r32; const size_t row = (size_t)b * SEQ + t;
    LAS float* simp = (LAS float*)(lds + L_SIMP) + (wid * 32 + r32) * 33;
#pragma unroll
    for (int i = 0; i < 16; ++i) simp[2 * i + hi] = 0.f;
#pragma nounroll
    for (int h = 0; h < NH; ++h) {
        bf16x8 qr[4]; load_q(qr, P + row * AINP + P_Q + h * 64, hi);
        f32x16 pp[4];
        qk_tile(pp[0], pp[1], lds + L_K0, qr, r32, hi); qk_tile(pp[2], pp[3], lds + L_K1, qr, r32, hi);
        const LAS float* tab = (const LAS float*)(lds + L_TAB) + h * 132;
        float mx = NEG;
#pragma unroll
        for (int a = 0; a < 4; ++a)
#pragma unroll
            for (int r = 0; r < 16; ++r) { const int n = (r & 3) + 8 * (r >> 2) + 4 * hi + 32 * a; const int d = t - 30 - 16 * n;
                const float s = pp[a][r] + tab[min(max(d, 0), 129)]; pp[a][r] = s; mx = fmaxf(mx, s); }
        mx = fmaxf(mx, __shfl_xor(mx, 32));
        const bool dead = mx < -5e29f;
        const float msc = (dead ? 0.f : mx) * SC2;
        float sum = 0.f;
#pragma unroll
        for (int a = 0; a < 4; ++a)
#pragma unroll
            for (int r = 0; r < 16; ++r) { const float e = __builtin_amdgcn_exp2f(pp[a][r] * SC2 - msc); pp[a][r] = e; sum += e; }
        sum += __shfl_xor(sum, 32);
        const float inv = dead ? 0.f : 1.0f / fmaxf(sum, 1e-30f);
#pragma unroll
        for (int a = 0; a < 4; ++a)
#pragma unroll
            for (int r = 0; r < 16; ++r) pp[a][r] *= inv;
#pragma unroll
        for (int a = 0; a < 4; ++a)
#pragma unroll
            for (int g = 0; g < 4; ++g) {
                const float gs = (pp[a][4 * g] + pp[a][4 * g + 1]) + (pp[a][4 * g + 2] + pp[a][4 * g + 3]);
                const float lastv = pp[a][4 * g + 3];
                const float shifted = (g >= 1) ? pp[a][4 * (g - 1) + 3] : ((a >= 1) ? pp[(a >= 1) ? a - 1 : 0][15] : 0.f);
                const float snd = hi ? shifted : lastv;
                const float rcv = __shfl_xor(snd, 32);
                simp[8 * a + 2 * g + hi] += gs + rcv;
            }
        f32x16 o0 = zero16(), o1 = zero16();
        pv_tile(o0, o1, lds + L_V0, pp[0], pp[1], lane); pv_tile(o0, o1, lds + L_V1, pp[2], pp[3], lane);
        const float gate = sigmoidf(bf2f(P[row * AINP + P_G + h * 3 + 0]));
#pragma unroll
        for (int r = 0; r < 16; ++r) { o0[r] *= gate; o1[r] *= gate; }
        store_o(O + row * DM + h * 64, o0, o1, hi);
    }
    __syncthreads();
    const int cur = t >> 6; unsigned mask;
    if (cur < 16) mask = (2u << cur) - 1u;
    else {
        mask = 1u | (1u << cur) | (1u << (cur - 1));
        unsigned cand = ((1u << (cur - 1)) - 1u) & ~1u;
#pragma nounroll
        for (int k = 0; k < 13; ++k) {
            float best = -3e38f; int bi = 0;
#pragma nounroll
            for (int s = 1; s <= 29; ++s) { const float v = simp[s]; const bool take = ((cand >> s) & 1u) && (v > best); best = take ? v : best; bi = take ? s : bi; }
            mask |= 1u << bi; cand &= ~(1u << bi);
        }
    }
    if (hi == 0) ((unsigned*)(ws + WS_SEL))[row] = mask;
}
__device__ __forceinline__ void nsa2_unit(const Params& p, LAS unsigned char* lds, int b, int h0, int qb) {
    using namespace att;
    int tid_ = threadIdx.x; asm volatile("" : "+v"(tid_));
    const int tid = tid_, lane = tid & 63, r32 = lane & 31, hi = lane >> 5, wid = tid >> 6;
    unsigned char* ws = p.ws;
    const bf16_t* P = (const bf16_t*)(ws + WS_BIG + BIG_P); bf16_t* O = (bf16_t*)(ws + WS_BIG + BIG_O0);
    __syncthreads();
    fill_tab(lds, p.in[I_RELB], h0, 2, tid);
    const int h = h0 + (wid >> 2);
    const LAS float* tab = (const LAS float*)(lds + L_TAB) + (wid >> 2) * 132;
    const int tw0 = qb * 256 + (wid & 3) * 64, t0 = tw0 + r32; const size_t row0 = (size_t)b * SEQ + t0, row1 = row0 + 32;
    const LAS unsigned char* qp = park_q(lds, P + row0 * AINP + P_Q + h * 64, P + row1 * AINP + P_Q + h * 64, wid, lane, hi);
    const unsigned sel0 = ((const unsigned*)(ws + WS_SEL))[row0], sel1 = ((const unsigned*)(ws + WS_SEL))[row1];
    const bf16_t* Pb = P + (size_t)b * SEQ * AINP;
    Acc A[2]; acc_init(A[0]); acc_init(A[1]);
    seg2<1, false>(A, lds, Pb + P_KS, Pb + P_VS, AINP, SEQ - 1, 0, qb * 4 + 4, qp, t0, tw0, sel0, sel1, 0, 1 << 30, tab, tid);
#pragma unroll
    for (int s = 0; s < 2; ++s) {
        const size_t row = s ? row1 : row0;
        const float gs = sigmoidf(bf2f(P[row * AINP + P_G + h * 3 + 1])) * acc_inv(A[s]);
#pragma unroll
        for (int r = 0; r < 16; ++r) { A[s].o0[r] *= gs; A[s].o1[r] *= gs; }
        bf16_t* orow = O + row * DM + h * 64;
        add_prev_o(orow, A[s].o0, A[s].o1, hi); store_o(orow, A[s].o0, A[s].o1, hi);
        acc_init(A[s]);
    }
    const int wlo = qb * 4 - 8 < 0 ? 0 : qb * 4 - 8;
    seg2<2, false>(A, lds, Pb + P_KW, Pb + P_VW, AINP, SEQ - 1, wlo, qb * 4 + 4, qp, t0, tw0, 0u, 0u, 0, 512, tab, tid);
#pragma unroll
    for (int s = 0; s < 2; ++s) {
        const size_t row = s ? row1 : row0;
        const float gw = sigmoidf(bf2f(P[row * AINP + P_G + h * 3 + 2])) * acc_inv(A[s]);
#pragma unroll
        for (int r = 0; r < 16; ++r) { A[s].o0[r] *= gw; A[s].o1[r] *= gw; }
        bf16_t* orow = O + row * DM + h * 64;
        add_prev_o(orow, A[s].o0, A[s].o1, hi); store_o(orow, A[s].o0, A[s].o1, hi);
    }
}
__device__ __forceinline__ unsigned moba_select(const float* KM, const bf16x8 (&qr)[4], int b, int h, int qb, int hi) {
    float gt[7];
#pragma unroll
    for (int n = 0; n < 7; ++n) {
        float s = 0.f;
        if (n < qb) {
            const float* km = KM + ((size_t)(b * 8 + n) * NH + h) * 64 + hi * 8;
#pragma unroll
            for (int d0 = 0; d0 < 4; ++d0) { const f32x4 k0 = *(const f32x4*)(km + d0 * 16), k1 = *(const f32x4*)(km + d0 * 16 + 4);
                s += bf2f((unsigned short)qr[d0][0]) * k0[0] + bf2f((unsigned short)qr[d0][1]) * k0[1] + bf2f((unsigned short)qr[d0][2]) * k0[2] + bf2f((unsigned short)qr[d0][3]) * k0[3]
                   + bf2f((unsigned short)qr[d0][4]) * k1[0] + bf2f((unsigned short)qr[d0][5]) * k1[1] + bf2f((unsigned short)qr[d0][6]) * k1[2] + bf2f((unsigned short)qr[d0][7]) * k1[3]; }
        }
        s += __shfl_xor(s, 32);
        gt[n] = s;
    }
    unsigned sel = 1u << qb, cand = (1u << qb) - 1u;
#pragma nounroll
    for (int k = 0; k < 3; ++k) {
        float best = -3e38f; int bi = -1;
#pragma unroll
        for (int n = 0; n < 7; ++n) { const bool take = ((cand >> n) & 1u) && (gt[n] > best); best = take ? gt[n] : best; bi = take ? n : bi; }
        if (bi >= 0) { sel |= 1u << bi; cand &= ~(1u << bi); }
    }
    return sel;
}
__device__ __forceinline__ void moba_unit(const Params& p, LAS unsigned char* lds, int b, int h, int qp) {
    using namespace att;
    int tid_ = threadIdx.x; asm volatile("" : "+v"(tid_));
    const int tid = tid_, lane = tid & 63, r32 = lane & 31, hi = lane >> 5, wid = tid >> 6;
    unsigned char* ws = p.ws;
    const bf16_t* KV = (const bf16_t*)(ws + WS_BIG + BIG_KV); const bf16_t* Q = (const bf16_t*)(ws + WS_BIG + BIG_Q1); bf16_t* O = (bf16_t*)(ws + WS_BIG + BIG_O1);
    const float* KM = (const float*)(ws + WS_KMEAN);
    __syncthreads();
    fill_tab(lds, p.in[I_RELB], h, 1, tid);
    const LAS float* tab = (const LAS float*)(lds + L_TAB);
    const int qb = 2 * qp + (wid >> 2);
    const int tw0 = qb * 256 + (wid & 3) * 64, t0 = tw0 + r32; const size_t row0 = (size_t)b * SEQ + t0, row1 = row0 + 32;
    unsigned sel0, sel1;
    { bf16x8 qr[4]; load_q(qr, Q + row0 * DM + h * 64, hi); sel0 = moba_select(KM, qr, b, h, qb, hi); }
    { bf16x8 qr[4]; load_q(qr, Q + row1 * DM + h * 64, hi); sel1 = moba_select(KM, qr, b, h, qb, hi); }
    const LAS unsigned char* qp_ = park_q(lds, Q + row0 * DM + h * 64, Q + row1 * DM + h * 64, wid, lane, hi);
    const bf16_t* Kb = KV + (size_t)b * SEQ * 1536 + h * 64;
    Acc A[2]; acc_init(A[0]); acc_init(A[1]);
    seg2<1, true>(A, lds, Kb, Kb + MAINW, 1536, SEQ - 1, 0, qp * 8 + 8, qp_, t0, tw0, sel0, sel1, 2, 1 << 30, tab, tid);
#pragma unroll
    for (int s = 0; s < 2; ++s) {
        const float inv = acc_inv(A[s]);
#pragma unroll
        for (int r = 0; r < 16; ++r) { A[s].o0[r] *= inv; A[s].o1[r] *= inv; }
        store_o(O + (s ? row1 : row0) * DM + h * 64, A[s].o0, A[s].o1, hi);
    }
}
__device__ __forceinline__ void mem_unit(const Params& p, LAS unsigned char* lds, const bf16_t* Q, int ldq, int qcol, bf16_t* O, int kvcol, int b, int mh, int qq) {
    using namespace att;
    int tid_ = threadIdx.x; asm volatile("" : "+v"(tid_));
    const int tid = tid_, lane = tid & 63, r32 = lane & 31, hi = lane >> 5, wid = tid >> 6;
    const bf16_t* MKV = (const bf16_t*)(p.ws + WS_MKV) + (size_t)b * NMEM * 1024 + kvcol + mh * 64;
    const int tw0 = qq * 512 + wid * 64, t0 = tw0 + r32; const size_t row0 = (size_t)b * SEQ + t0, row1 = row0 + 32;
    __syncthreads();
    const LAS unsigned char* qp = park_q(lds, Q + row0 * ldq + qcol + mh * 64, Q + row1 * ldq + qcol + mh * 64, wid, lane, hi);
    Acc A[2]; acc_init(A[0]); acc_init(A[1]);
    seg2<0, true>(A, lds, MKV, MKV + 256, 1024, NMEM - 1, 0, 4, qp, t0, tw0, 0u, 0u, 0, 1 << 30, (const LAS float*)(lds + L_TAB), tid);
#pragma unroll
    for (int s = 0; s < 2; ++s) {
        const float inv = acc_inv(A[s]);
#pragma unroll
        for (int r = 0; r < 16; ++r) { A[s].o0[r] *= inv; A[s].o1[r] *= inv; }
        store_o(O + (s ? row1 : row0) * DM + MAINW + mh * 64, A[s].o0, A[s].o1, hi);
    }
}

#define XB_TMO      128
#define XB_XCNT(j)  (256  + 64 * (j))
#define XB_XSUB(j)  (1280 + 64 * (j))
#define XB_XGEN(j)  (2304 + 64 * (j))
#define XB_TOP      3328
#define XB_TOPGEN   3392
#define XCD_BAR_WORDS 3456
#define XB_SPIN_CAP (1u << 18)
__device__ __forceinline__ unsigned xb_ld(unsigned* p)              { return __hip_atomic_load(p, __ATOMIC_RELAXED, __HIP_MEMORY_SCOPE_AGENT); }
__device__ __forceinline__ unsigned xb_add(unsigned* p, unsigned v) { return __hip_atomic_fetch_add(p, v, __ATOMIC_RELAXED, __HIP_MEMORY_SCOPE_AGENT); }
__device__ __forceinline__ unsigned xb_xcc_id() { return (unsigned)__builtin_amdgcn_s_getreg((3 << 11) | 20) & 0xFu; }
#define XB_SPIN(cond, bar) do { unsigned _sp = 0; while (cond) { __builtin_amdgcn_s_sleep(1); \
    if ((++_sp & 255u) == 0u) { if (xb_ld(&(bar)[XB_TMO])) break; if (_sp > XB_SPIN_CAP) { atomicAdd(&(bar)[XB_TMO], 1u); break; } } } } while (0)
struct XcdBarrier { unsigned* bar; unsigned x; volatile LAS unsigned* st; };
__device__ __forceinline__ XcdBarrier xcd_barrier_post(unsigned* bar, volatile LAS unsigned* st) {
    XcdBarrier b; b.bar = bar; b.x = xb_xcc_id(); b.st = st;
    if (threadIdx.x == 0) (void)xb_add(&bar[XB_XCNT(b.x)], 1u);
    return b;
}
__device__ __forceinline__ void xcd_barrier_complete(unsigned* bar, unsigned x, unsigned& nloc, unsigned& nx) {
    const unsigned G = gridDim.x * gridDim.y * gridDim.z;
    unsigned sum, cnt, mine, sp = 0u;
    for (;;) {
        sum = 0u; cnt = 0u; mine = 0u;
#pragma unroll
        for (unsigned j = 0; j < 16; ++j) { const unsigned c = xb_ld(&bar[XB_XCNT(j)]); sum += c; cnt += (c > 0u) ? 1u : 0u; mine = (j == x) ? c : mine; }
        if (sum == G) break;
        __builtin_amdgcn_s_sleep(1);
        if ((++sp & 255u) == 0u) { if (xb_ld(&bar[XB_TMO])) break; if (sp > XB_SPIN_CAP) { atomicAdd(&bar[XB_TMO], 1u); break; } }
    }
    nloc = mine > 0u ? mine : 1u; nx = cnt > 0u ? cnt : 1u;
}
__device__ __forceinline__ void xcd_barrier(const XcdBarrier& b) {
    asm volatile("s_waitcnt vmcnt(0)" ::: "memory");
    __syncthreads();
    if (threadIdx.x == 0) {
        unsigned* bar = b.bar;
        __builtin_amdgcn_s_waitcnt(0);
        unsigned nloc = b.st[0], nx = b.st[1];
        if (nloc == 0u) { xcd_barrier_complete(bar, b.x, nloc, nx); b.st[0] = nloc; b.st[1] = nx; }
        const unsigned old = xb_add(&bar[XB_XSUB(b.x)], 1u);
        const unsigned gen = old / nloc;
        if (old + 1u == (gen + 1u) * nloc) {
            __builtin_amdgcn_fence(__ATOMIC_RELEASE, "agent");
            asm volatile("s_waitcnt vmcnt(0)" ::: "memory");
            const unsigned og = xb_add(&bar[XB_TOP], 1u);
            const unsigned tg = og / nx;
            if (og + 1u == (tg + 1u) * nx) xb_add(&bar[XB_TOPGEN], 1u);
            else XB_SPIN(xb_ld(&bar[XB_TOPGEN]) == tg, bar);
            __builtin_amdgcn_fence(__ATOMIC_ACQUIRE, "agent");
            xb_add(&bar[XB_XGEN(b.x)], 1u);
            asm volatile("s_waitcnt vmcnt(0)" ::: "memory");
        } else {
            XB_SPIN(xb_ld(&bar[XB_XGEN(b.x)]) == gen, bar);
            __builtin_amdgcn_fence(__ATOMIC_ACQUIRE, "agent");
            asm volatile("s_waitcnt vmcnt(0)" ::: "memory");
        }
    }
    __syncthreads();
}

enum { PH_PREP = 0, PH_A_GEMM, PH_A_CMP1, PH_A_CMP2, PH_A_NSA1, PH_A_NSA2, PH_A_OUT, PH_A_LN1, PH_A_F0, PH_A_F1, PH_A_LN2,
       PH_B_GEMM, PH_B_KMEAN, PH_B_ATT, PH_B_OUT, PH_B_LN1, PH_B_F0, PH_B_F1, PH_B_LN2, PH_COUNT };

struct GemmJob { pg8::Gemm g; int epi; void* O; const float* aux; const float* aux2; int ldc; int coff; };
__device__ __forceinline__ void set_job(GemmJob& J, const bf16_t* A, const bf16_t* Bt, int M, int N, int K, int lda, int epi, void* O, const float* aux, int ldc) {
    J.g.A = A; J.g.Bt = Bt; J.g.M = M; J.g.N = N; J.g.K = K; J.g.lda = lda; J.g.kstepA = 128; J.epi = epi; J.O = O; J.aux = aux; J.aux2 = nullptr; J.ldc = ldc; J.coff = 0;
}
__device__ __forceinline__ bool gemm_job(const Params& p, int ph, int j, GemmJob& J) {
    unsigned char* ws = p.ws;
    const bf16_t* XB = (const bf16_t*)(ws + WS_XB); const float* XF = (const float*)XB;
    unsigned char* big = ws + WS_BIG;
    const int layer = ph >= PH_B_GEMM ? 1 : 0;
    const bf16_t* Win = (const bf16_t*)(ws + WS_WFIN) + (size_t)layer * 2 * DFF * DM; const bf16_t* Wout = (const bf16_t*)(ws + WS_WFOUT) + (size_t)layer * DM * DFF;
    if (ph == PH_A_GEMM) {
        if (j == 0) { set_job(J, XB, (const bf16_t*)(ws + WS_WAIN), NTOK, AINP, DM, DM, 0, big + BIG_P, nullptr, AINP); return true; }
        return false;
    }
    if (ph == PH_A_CMP1) {
        if (j == 2) { set_job(J, (const bf16_t*)(ws + WS_MEMB), (const bf16_t*)(ws + WS_WMKV), BATCH * NMEM, 1024, DM, DM, 0, ws + WS_MKV, nullptr, 1024); J.coff = 32; return true; }
        if (j >= 3) return false;
        const bf16_t* P = (const bf16_t*)(big + BIG_P);
        set_job(J, P + (j ? P_VC : P_KC), (const bf16_t*)(ws + (j ? WS_WC1V : WS_WC1K)), 4096, 256, 2048, 16 * AINP, 1, (float*)(ws + WS_CMPH) + (size_t)j * 4096 * 256, (const float*)(ws + WS_CBIAS) + j * 256, 256);
        J.g.kstepA = AINP * 2; J.coff = j * 16; return true;
    }
    if (ph == PH_A_OUT) { if (j) return false; set_job(J, (const bf16_t*)(big + BIG_O0), (const bf16_t*)(ws + WS_WAOUT), NTOK, DM, DM, DM, 2, p.out, p.in[I_X], DM); return true; }
    if (ph == PH_B_OUT) { if (j) return false; set_job(J, (const bf16_t*)(big + BIG_O1), (const bf16_t*)(ws + WS_WBOUT), NTOK, DM, DM, DM, 4, p.out, XF, DM); return true; }
    if (ph == PH_B_GEMM) {
        if (j == 0) { set_job(J, XB, (const bf16_t*)(ws + WS_WSKV), NTOK, 1536, DM, DM, 0, big + BIG_KV, nullptr, 1536); return true; }
        if (j == 1) { set_job(J, XB, (const bf16_t*)(ws + WS_WBIN), NTOK, DM, DM, DM, 0, big + BIG_Q1, nullptr, DM); return true; }
        return false;
    }
    const int f = layer ? ph - PH_B_F0 : ph - PH_A_F0;
    if (j) return false;
    if (f == 0) { set_job(J, XB, Win, NTOK, 2 * DFF, DM, DM, 3, big + BIG_H, p.in[I_FCW] + (size_t)layer * 3 * DFF, DFF); J.aux2 = p.in[I_FCB] + (size_t)layer * DFF; return true; }
    if (f == 1) { set_job(J, (const bf16_t*)(big + BIG_H), Wout, NTOK, DM, DFF, DFF, 4, p.out, XF, DM); return true; }
    return false;
}
__device__ __forceinline__ bool is_gemm_phase(int ph) {
    return ph == PH_A_GEMM || ph == PH_A_CMP1 || ph == PH_A_OUT || ph == PH_B_OUT || ph == PH_B_GEMM || ph == PH_A_F0 || ph == PH_A_F1 || ph == PH_B_F0 || ph == PH_B_F1;
}
template <int JJ>
__device__ __forceinline__ void run_gemm_job(const Params& p, LAS unsigned char* lds, int ph) {
    GemmJob J;
    if (!gemm_job(p, ph, JJ, J)) return;
    pg8::StaticOrder S; S.init(J.g.M, J.g.N, (int)gridDim.x, (int)blockIdx.x - J.coff);
    if (J.epi == 0) { pg8::EpiBf16 E{(bf16_t*)J.O, J.ldc}; pg8::gemm_phase<pg8::EpiBf16>(lds, J.g, S, E); }
    else if (J.epi == 1) { pg8::EpiF32BiasGelu E{(float*)J.O, J.ldc, J.aux}; pg8::gemm_phase<pg8::EpiF32BiasGelu>(lds, J.g, S, E); }
    else if (J.epi == 3) { unsigned char* big = p.ws + WS_BIG; pg8::EpiConvGate E{(bf16_t*)J.O, J.aux, J.aux2, (float*)(big + BIG_TAILA), (float*)(big + BIG_HEADA), (float*)(big + BIG_HEADB)}; pg8::gemm_phase<pg8::EpiConvGate>(lds, J.g, S, E); }
    else if (J.epi == 2) { pg8::EpiResF32<true> E{J.aux, (float*)J.O, J.ldc, ALPHA}; pg8::gemm_phase<pg8::EpiResF32<true>>(lds, J.g, S, E); }
    else { pg8::EpiResF32<false> E{J.aux, (float*)J.O, J.ldc, ALPHA}; pg8::gemm_phase<pg8::EpiResF32<false>>(lds, J.g, S, E); }
}
__device__ __forceinline__ void run_gemm_phase(const Params& p, LAS unsigned char* lds, int ph) {
    run_gemm_job<0>(p, lds, ph); run_gemm_job<1>(p, lds, ph); run_gemm_job<2>(p, lds, ph);
}

__device__ __forceinline__ void run_phase(const Params& p, LAS unsigned char* lds, const Ctx& c, int ph) {
    unsigned char* ws = p.ws;
    bf16_t* XB = (bf16_t*)(ws + WS_XB);
    const int G = (int)gridDim.x, bid = (int)blockIdx.x;
    if (ph == PH_A_F1 || ph == PH_B_F1) {
        const int layer = ph == PH_B_F1 ? 1 : 0;
        pg8::StaticOrder S; S.init(NTOK, DM, G, bid); pg8::Unit u;
        for (int i = 0; S.next(i, u); ++i) ffn_fixup(c, ws + WS_BIG, p.in[I_FCW] + (size_t)layer * 3 * DFF, p.in[I_FCB] + (size_t)layer * DFF, u.pm);
        asm volatile("s_waitcnt vmcnt(0)" ::: "memory"); __syncthreads();
    }
    if (ph == PH_A_CMP1 && G >= LATE_FIRST_WG + 32 && bid >= LATE_FIRST_WG) {
        Ctx c2 = c; c2.gtid = (bid - LATE_FIRST_WG) * NTHR + c.tid; c2.gsz = (G - LATE_FIRST_WG) * NTHR;
        prep_late(p, c2);
    }
    if (is_gemm_phase(ph)) { run_gemm_phase(p, lds, ph); return; }
    switch (ph) {
    case PH_PREP: phase_prep(p, c); break;
    case PH_A_CMP2: phase_cmp2(p, c); break;
    case PH_A_NSA1: {
        for (int u = bid; u < BATCH * 8; u += G) nsa1_unit(p, lds, u >> 3, u & 7);
    } break;
    case PH_A_NSA2: {
        for (int u = bid; u < BATCH * (NH / 2) * 4; u += G) { const int b = u / 24, r = u % 24, hp = r >> 2, s = (r + u / G) & 3;
#pragma nounroll
            for (int k = 0; k < 2; ++k) nsa2_unit(p, lds, b, 2 * hp, k ? s : 7 - s); }
    } break;
    case PH_B_ATT: {
        for (int u = bid; u < BATCH * NH * 2; u += G) { const int b = u / 24, r = u % 24, h = r >> 1, s = r & 1;
#pragma nounroll
            for (int k = 0; k < 2; ++k) moba_unit(p, lds, b, h, k ? s : 3 - s); }
    } break;
    case PH_A_LN1: case PH_B_LN1: case PH_A_LN2: case PH_B_LN2: {
        const int layer = ph >= PH_B_GEMM ? 1 : 0; const bool second = (ph == PH_A_LN2 || ph == PH_B_LN2); const bool fin = (ph == PH_B_LN2);
        phase_ln(c, p.out, p.in[second ? I_LN2G : I_LN1G] + layer * DM, p.in[second ? I_LN2B : I_LN1B] + layer * DM, fin ? p.out : nullptr, fin ? nullptr : XB);
    } break;
    case PH_B_KMEAN: phase_kmean(c, (const bf16_t*)(ws + WS_BIG + BIG_KV), (float*)(ws + WS_KMEAN)); break;
    default: break;
    }
    if (ph == PH_A_NSA1 || ph == PH_B_ATT) {
        const bool la = (ph == PH_A_NSA1);
        const bf16_t* Q = (const bf16_t*)(ws + WS_BIG + (la ? BIG_P : BIG_Q1)); bf16_t* O = (bf16_t*)(ws + WS_BIG + (la ? BIG_O0 : BIG_O1));
        for (int u = bid; u < BATCH * 4 * 4; u += G) mem_unit(p, lds, Q, la ? AINP : DM, la ? P_QM : MAINW, O, la ? 0 : 512, u >> 4, (u >> 2) & 3, u & 3);
    }
}

template <int PH>
__device__ __forceinline__ void phase_seq(const Params& p, LAS unsigned char* lds, const Ctx& c, cg::grid_group& grid, const XcdBarrier& bar) {
    if constexpr (PH < PH_COUNT) {
        if (PH >= p.ph_lo && PH < p.ph_hi) {
            Ctx cc; { int t_ = threadIdx.x; asm volatile("" : "+v"(t_)); cc.tid = t_; cc.lane = t_ & 63; cc.wid = t_ >> 6; cc.gtid = blockIdx.x * NTHR + t_; cc.gsz = gridDim.x * NTHR; cc.gw = blockIdx.x * (NTHR / 64) + cc.wid; cc.ngw = gridDim.x * (NTHR / 64); }
            run_phase(p, lds, cc, PH); if (PH + 1 < p.ph_hi) { if (PH == 0) grid.sync(); else xcd_barrier(bar); } }
        phase_seq<PH + 1>(p, lds, c, grid, bar);
    }
}
__global__ void __launch_bounds__(NTHR) yoco_mega(Params p) {
    extern __shared__ __attribute__((aligned(16))) unsigned char lds_raw[];
    LAS unsigned char* lds = (LAS unsigned char*)lds_raw;
    cg::grid_group grid = cg::this_grid();
    Ctx c; c.tid = threadIdx.x; c.lane = c.tid & 63; c.wid = c.tid >> 6; c.gtid = blockIdx.x * NTHR + c.tid; c.gsz = gridDim.x * NTHR; c.gw = blockIdx.x * (NTHR / 64) + c.wid; c.ngw = gridDim.x * (NTHR / 64);
    if (c.tid < 130) ((LAS int*)(lds + att::L_BKT))[c.tid] = c.tid == 0 ? 0 : att::rel_bucket(c.tid - 1);
    if (c.tid < 2) ((LAS unsigned*)(lds + att::L_MISC))[c.tid] = 0u;
    __syncthreads();
    const XcdBarrier bar = xcd_barrier_post((unsigned*)(p.ws + WS_CTL), (volatile LAS unsigned*)(lds + att::L_MISC));
    phase_seq<0>(p, lds, c, grid, bar);
}

extern "C" void kernel_launch(void* const* d_in, const int* in_sizes, int n_in, void* d_out, int out_size, void* d_ws, size_t ws_size, hipStream_t stream) {
    static int grid = 0;
    if (grid == 0) {
        if (n_in != 24 || ws_size < WS_NEED) { fprintf(stderr, "kernel_launch: unexpected n_in %d / ws_size %zu (need %zu)\n", n_in, ws_size, (size_t)WS_NEED); grid = -1; return; }
        int dev = 0, cus = 0, per_cu = 0;
        hipGetDevice(&dev); hipDeviceGetAttribute(&cus, hipDeviceAttributeMultiprocessorCount, dev);
        if (hipFuncSetAttribute((const void*)yoco_mega, hipFuncAttributeMaxDynamicSharedMemorySize, LDS_BYTES) != hipSuccess) { fprintf(stderr, "kernel_launch: hipFuncSetAttribute failed\n"); grid = -1; return; }
        if (hipOccupancyMaxActiveBlocksPerMultiprocessor(&per_cu, (const void*)yoco_mega, NTHR, LDS_BYTES) != hipSuccess || per_cu < 1) { fprintf(stderr, "kernel_launch: occupancy query says %d\n", per_cu); per_cu = 1; }
        (void)hipGetLastError();
        grid = cus * per_cu;
        fprintf(stderr, "kernel_launch: grid %d (cus %d x %d)\n", grid, cus, per_cu);
    }
    if (grid < 0) return;
    if (hipMemsetAsync((char*)d_ws + WS_CTL, 0, CTL_BYTES, stream) != hipSuccess) { fprintf(stderr, "kernel_launch: memset failed\n"); return; }
    Params p{};
    for (int i = 0; i < 24; ++i) p.in[i] = (const float*)d_in[i];
    p.out = (float*)d_out; p.ws = (unsigned char*)d_ws; p.ph_lo = 0; p.ph_hi = PH_COUNT;
    void* args[] = {&p};
    hipError_t e = hipLaunchCooperativeKernel((const void*)yoco_mega, dim3(grid), dim3(NTHR), args, LDS_BYTES, stream);
    if (e != hipSuccess) fprintf(stderr, "kernel_launch: cooperative launch failed: %s (grid %d)\n", hipGetErrorString(e), grid);
}
```

```cpp
#include <hip/hip_runtime.h>
#include <hip/hip_cooperative_groups.h>
#include <cstdio>
#include <cstdint>
namespace cg = cooperative_groups;

#define LAS __attribute__((address_space(3)))
typedef unsigned short bf16_t;
typedef short bf16x8 __attribute__((ext_vector_type(8)));
typedef short s16x4 __attribute__((ext_vector_type(4)));
typedef float f32x4 __attribute__((ext_vector_type(4)));
typedef float f32x2 __attribute__((ext_vector_type(2)));
typedef float f32x16 __attribute__((ext_vector_type(16)));
typedef unsigned u32x4 __attribute__((ext_vector_type(4)));
typedef unsigned u32x2 __attribute__((ext_vector_type(2)));

__device__ __forceinline__ unsigned cvt_pk_bf16(float lo, float hi) { unsigned r; asm volatile("v_cvt_pk_bf16_f32 %0, %1, %2" : "=v"(r) : "v"(lo), "v"(hi)); return r; }
__device__ __forceinline__ float bf2f(unsigned short b) { return __uint_as_float(((unsigned)b) << 16); }
__device__ __forceinline__ float gelu_tanh(float x) {
    const float x2 = x * x;
    const float w = x * (-2.302208198f - 0.1029432397f * x2);
    return x * __builtin_amdgcn_rcpf(1.0f + __builtin_amdgcn_exp2f(w));
}

namespace pg8 {
constexpr int BM = 256, BK = 64, HALF = 128, HTB = HALF * BK * 2, STAGE_BYTES = 8 * HTB, NXCD = 8, WGM = 8;
__host__ __device__ __forceinline__ int lds_byte(int r, int c) { const int st = (r >> 4) * 2 + (c >> 5), rr = r & 15, cc = c & 31, ob = rr * 64 + cc * 2; return st * 1024 + (ob ^ (((ob >> 9) & 1) << 5)); }
__host__ __device__ __forceinline__ void stage_rc(int b, int& R, int& C) { const int st = b / 1024, sb = b % 1024, swz = sb ^ (((sb >> 9) & 1) << 5); R = (st >> 1) * 16 + swz / 64; C = (st & 1) * 32 + (swz % 64) / 2; }
__host__ __device__ __forceinline__ int perm32(int rho) { const int n = rho >> 4, i = rho & 15; return 8 * (i >> 2) + 4 * n + (i & 3); }

struct Unit { int pm, pn; };
struct Gemm { const bf16_t* A; const bf16_t* Bt; int M, N, K; int lda; int kstepA; };

struct StaticOrder {
    int nM, nN, nwg, G, c;
    __host__ __device__ void init(int M, int N, int G_, int c_) { nM = M / BM; nN = N / BM; nwg = nM * nN; G = G_; c = c_; }
    __host__ __device__ bool next(int i, Unit& u) const {
        if (c < 0) return false;
        const long L = (long)i * G + c; if (L >= nwg) return false;
        int wgid = (int)L; { const int q = nwg / NXCD, r = nwg % NXCD, xcd = wgid % NXCD, off = wgid / NXCD; wgid = (xcd < r ? xcd * (q + 1) : r * (q + 1) + (xcd - r) * q) + off; }
        const int nig = WGM * nN, gid = wgid / nig, fm = gid * WGM, gsz = (nM - fm) < WGM ? (nM - fm) : WGM;
        u.pm = fm + ((wgid % nig) % gsz); u.pn = (wgid % nig) / gsz; return true;
    }
};

struct EpiBf16 {
    static constexpr bool PERM = true;
    bf16_t* O; int ldc;
    __device__ __forceinline__ void operator()(const f32x4 (&acc)[2][2][4][2], const Unit& u, int wr, int wc, int fr, int fq) const {
        const int row0 = u.pm * BM + wr * 64 + fr; const int col0 = u.pn * BM + wc * 32 + 8 * fq;
#pragma unroll
        for (int ai = 0; ai < 2; ++ai)
#pragma unroll
            for (int m = 0; m < 4; ++m) { bf16_t* rowp = O + (size_t)(row0 + ai * HALF + m * 16) * ldc + col0;
#pragma unroll
                for (int bj = 0; bj < 2; ++bj) { const f32x4 v0 = acc[ai][bj][m][0], v1 = acc[ai][bj][m][1];
                    u32x4 w; w.x = cvt_pk_bf16(v0[0], v0[1]); w.y = cvt_pk_bf16(v0[2], v0[3]); w.z = cvt_pk_bf16(v1[0], v1[1]); w.w = cvt_pk_bf16(v1[2], v1[3]);
                    *(u32x4*)(rowp + bj * HALF) = w; } }
    }
};
struct EpiF32BiasGelu {
    static constexpr bool PERM = false;
    float* O; int ldc; const float* bias;
    __device__ __forceinline__ void operator()(const f32x4 (&acc)[2][2][4][2], const Unit& u, int wr, int wc, int fr, int fq) const {
        const int row0 = u.pm * BM + wr * 64 + fr; const int col0 = u.pn * BM + wc * 32 + 4 * fq;
#pragma unroll
        for (int bj = 0; bj < 2; ++bj)
#pragma unroll
            for (int n = 0; n < 2; ++n) { const f32x4 bv = *(const f32x4*)(bias + col0 + bj * HALF + n * 16);
#pragma unroll
                for (int ai = 0; ai < 2; ++ai)
#pragma unroll
                    for (int m = 0; m < 4; ++m) { f32x4 v = acc[ai][bj][m][n] + bv; v[0] = gelu_tanh(v[0]); v[1] = gelu_tanh(v[1]); v[2] = gelu_tanh(v[2]); v[3] = gelu_tanh(v[3]);
                        *(f32x4*)(O + (size_t)(row0 + ai * HALF + m * 16) * ldc + col0 + bj * HALF + n * 16) = v; } }
    }
};
template <int CTRL> __device__ __forceinline__ float dppf(float old, float src) {
    return __int_as_float(__builtin_amdgcn_update_dpp(__float_as_int(old), __float_as_int(src), CTRL, 0xf, 0xf, false));
}
struct EpiConvGate {
    static constexpr bool PERM = true;
    bf16_t* H; const float* cw; const float* cb; float* TAILA; float* HEADA; float* HEADB;
    __device__ __forceinline__ void operator()(const f32x4 (&acc)[2][2][4][2], const Unit& u, int wr, int wc, int fr, int fq) const {
        constexpr int DFF_ = 2816;
        const int cf0 = u.pn * 128 + wc * 32 + 8 * fq;
        f32x4 w0[2], w1[2], w2[2], cv[2];
#pragma unroll
        for (int n = 0; n < 2; ++n) { w0[n] = *(const f32x4*)(cw + cf0 + 4 * n); w1[n] = *(const f32x4*)(cw + DFF_ + cf0 + 4 * n); w2[n] = *(const f32x4*)(cw + 2 * DFF_ + cf0 + 4 * n); cv[n] = *(const f32x4*)(cb + cf0 + 4 * n); }
#pragma unroll
        for (int ai = 0; ai < 2; ++ai) {
            const int G = u.pm * 4 + ai * 2 + wr;
#pragma unroll
            for (int m = 0; m < 4; ++m) {
                const int row = u.pm * BM + ai * HALF + wr * 64 + m * 16 + fr;
                f32x4 hv[2];
#pragma unroll
                for (int n = 0; n < 2; ++n) {
                    const f32x4 a = acc[ai][0][m][n], b = acc[ai][1][m][n];
                    const f32x4 pv = acc[ai][0][m > 0 ? m - 1 : 0][n];
#pragma unroll
                    for (int j = 0; j < 4; ++j) {
                        const float am1 = dppf<0x111>(dppf<0x121>(0.f, pv[j]), a[j]);
                        const float am2 = dppf<0x112>(dppf<0x122>(0.f, pv[j]), a[j]);
                        const float pre = w0[n][j] * am2 + w1[n][j] * am1 + w2[n][j] * a[j] + cv[n][j];
                        hv[n][j] = gelu_tanh(pre) * b[j];
                    }
                }
                if (m > 0 || fr >= 2) {
                    u32x4 w; w.x = cvt_pk_bf16(hv[0][0], hv[0][1]); w.y = cvt_pk_bf16(hv[0][2], hv[0][3]); w.z = cvt_pk_bf16(hv[1][0], hv[1][1]); w.w = cvt_pk_bf16(hv[1][2], hv[1][3]);
                    *(u32x4*)(H + (size_t)row * DFF_ + cf0) = w;
                } else {
                    float* ha = HEADA + ((size_t)G * 2 + fr) * DFF_ + cf0; float* hb = HEADB + ((size_t)G * 2 + fr) * DFF_ + cf0;
                    *(f32x4*)ha = acc[ai][0][0][0]; *(f32x4*)(ha + 4) = acc[ai][0][0][1]; *(f32x4*)hb = acc[ai][1][0][0]; *(f32x4*)(hb + 4) = acc[ai][1][0][1];
                }
                if (m == 3 && fr >= 14) { float* ta = TAILA + ((size_t)G * 2 + (fr - 14)) * DFF_ + cf0; *(f32x4*)ta = acc[ai][0][3][0]; *(f32x4*)(ta + 4) = acc[ai][0][3][1]; }
            }
        }
    }
};
template <bool BASE_F32>
struct EpiResF32 {
    static constexpr bool PERM = false;
    const void* basev; float* O; int ldc; float alpha;
    __device__ __forceinline__ void operator()(const f32x4 (&acc)[2][2][4][2], const Unit& u, int wr, int wc, int fr, int fq) const {
        const int row0 = u.pm * BM + wr * 64 + fr; const int col0 = u.pn * BM + wc * 32 + 4 * fq;
#pragma unroll
        for (int ai = 0; ai < 2; ++ai)
#pragma unroll
            for (int m = 0; m < 4; ++m) { const size_t off = (size_t)(row0 + ai * HALF + m * 16) * ldc + col0;
#pragma unroll
                for (int bj = 0; bj < 2; ++bj)
#pragma unroll
                    for (int n = 0; n < 2; ++n) { f32x4 bs;
                        if (BASE_F32) bs = *(const f32x4*)((const float*)basev + off + bj * HALF + n * 16);
                        else { const u32x2 w = *(const u32x2*)((const bf16_t*)basev + off + bj * HALF + n * 16); bs[0] = __uint_as_float(w.x << 16); bs[1] = __uint_as_float(w.x & 0xffff0000u); bs[2] = __uint_as_float(w.y << 16); bs[3] = __uint_as_float(w.y & 0xffff0000u); }
                        *(f32x4*)(O + off + bj * HALF + n * 16) = bs * alpha + acc[ai][bj][m][n]; } }
    }
};

template <class Epi>
__device__ __forceinline__ void gemm_phase(LAS unsigned char* lds, const Gemm g, const StaticOrder& S, const Epi& E) {
    const int tid = threadIdx.x, wid = __builtin_amdgcn_readfirstlane(tid >> 6), lane = tid & 63, wr = wid >> 2, wc = wid & 3, fr = lane & 15, fq = lane >> 4;
    const int K = g.K, nt = K / BK;
    unsigned voffA[2], voffB[2];
#pragma unroll
    for (int i = 0; i < 2; ++i) { int R, C; stage_rc(tid * 16 + i * 8192, R, C); const int Rb = Epi::PERM ? ((R & ~31) + perm32(R & 31)) : R;
        voffA[i] = (unsigned)(R * g.lda + C) * 2u; voffB[i] = (unsigned)(Rb * K + C) * 2u; }
    const size_t kstepA = (size_t)g.kstepA, kstepB = (size_t)(BK * 2);
    const size_t hstepA = (size_t)HALF * g.lda * 2, hstepB = (size_t)HALF * K * 2;
    const size_t tstepA = 2 * hstepA, tstepB = 2 * hstepB;
    const unsigned ldsw = (unsigned)wid * 1024u;
    const int aoff = lds_byte(wr * 64 + fr, fq * 8), boff = lds_byte(wc * 32 + fr, fq * 8);
#define PG8_SA(b, h) (((b) * 2 + (h)) * HTB)
#define PG8_SB(b, h) ((4 + (b) * 2 + (h)) * HTB)
#define PG8_STAGE(bufoff, gbase, voff) do { _Pragma("unroll") for (int _i = 0; _i < 2; ++_i) \
        __builtin_amdgcn_global_load_lds((const unsigned*)((const char*)(gbase) + (voff)[_i]), (LAS unsigned*)(lds + (bufoff) + ldsw + _i * 8192), 16, 0, 0); } while (0)
#define PG8_LDA(dst, b, h) do { _Pragma("unroll") for (int m = 0; m < 4; ++m) _Pragma("unroll") for (int k = 0; k < 2; ++k) dst[m][k] = *(const LAS bf16x8*)(lds + PG8_SA(b, h) + aoff + m * 2048 + k * 1024); } while (0)
#define PG8_LDB(dst, b, h) do { _Pragma("unroll") for (int n = 0; n < 2; ++n) _Pragma("unroll") for (int k = 0; k < 2; ++k) dst[n][k] = *(const LAS bf16x8*)(lds + PG8_SB(b, h) + boff + n * 2048 + k * 1024); } while (0)
#define PG8_MMA(ai, bj, At, Bt) do { __builtin_amdgcn_s_setprio(1); _Pragma("unroll") for (int m = 0; m < 4; ++m) _Pragma("unroll") for (int n = 0; n < 2; ++n) _Pragma("unroll") for (int k = 0; k < 2; ++k) \
        acc[ai][bj][m][n] = __builtin_amdgcn_mfma_f32_16x16x32_bf16(Bt[n][k], At[m][k], acc[ai][bj][m][n], 0, 0, 0); __builtin_amdgcn_s_setprio(0); } while (0)
#define PG8_WAIT_V(n) asm volatile("s_waitcnt vmcnt(" #n ")" ::: "memory")
#define PG8_WAIT_L(n) asm volatile("s_waitcnt lgkmcnt(" #n ")" ::: "memory")
#define PG8_BAR __builtin_amdgcn_s_barrier()
#define PG8_SCHED __builtin_amdgcn_sched_barrier(0)
    Unit cur, nxt; int ui = 0;
    if (!S.next(0, cur)) return;
    f32x4 acc[2][2][4][2];
#pragma unroll
    for (int a = 0; a < 2; ++a)
#pragma unroll
        for (int b = 0; b < 2; ++b)
#pragma unroll
            for (int m = 0; m < 4; ++m)
#pragma unroll
                for (int n = 0; n < 2; ++n) acc[a][b][m][n] = (f32x4){0.f, 0.f, 0.f, 0.f};
    bf16x8 At[4][2], B0[2][2], B1[2][2];
    const char* cA = (const char*)g.A + (size_t)cur.pm * tstepA; const char* cB = (const char*)g.Bt + (size_t)cur.pn * tstepB;
    PG8_STAGE(PG8_SB(0, 0), cB, voffB); PG8_STAGE(PG8_SB(0, 1), cB + hstepB, voffB); PG8_STAGE(PG8_SA(0, 0), cA, voffA); PG8_STAGE(PG8_SA(0, 1), cA + hstepA, voffA);
    if (wr == 1) PG8_BAR;
    PG8_WAIT_V(2); PG8_BAR;
    PG8_STAGE(PG8_SB(1, 0), cB + kstepB, voffB); PG8_STAGE(PG8_SA(1, 0), cA + kstepA, voffA); PG8_STAGE(PG8_SB(1, 1), cB + hstepB + kstepB, voffB);
    PG8_WAIT_V(6); PG8_BAR;
    for (;;) {
        const bool has_next = S.next(ui + 1, nxt);
        const char* nA = has_next ? (const char*)g.A + (size_t)nxt.pm * tstepA : cA; const char* nB = has_next ? (const char*)g.Bt + (size_t)nxt.pn * tstepB : cB;
        for (int t = 0; t < nt; t += 2) {
            const bool last = (t == nt - 2);
            const char* a1 = cA + (size_t)(t + 1) * kstepA;
            const char* a2 = last ? nA : cA + (size_t)(t + 2) * kstepA; const char* b2 = last ? nB : cB + (size_t)(t + 2) * kstepB;
            const char* a3 = a2 + kstepA; const char* b3 = b2 + kstepB;
            PG8_LDB(B0, 0, 0); PG8_LDB(B1, 0, 1); PG8_SCHED; PG8_LDA(At, 0, 0); PG8_STAGE(PG8_SA(1, 1), a1 + hstepA, voffA);
            PG8_WAIT_V(8); PG8_WAIT_L(0); PG8_BAR; PG8_MMA(0, 0, At, B0); PG8_MMA(0, 1, At, B1); PG8_BAR; PG8_SCHED;
            PG8_LDA(At, 0, 1); PG8_STAGE(PG8_SB(0, 0), b2, voffB); PG8_STAGE(PG8_SB(0, 1), b2 + hstepB, voffB); PG8_STAGE(PG8_SA(0, 0), a2, voffA);
            PG8_WAIT_V(8); PG8_WAIT_L(0); PG8_BAR; PG8_MMA(1, 0, At, B0); PG8_MMA(1, 1, At, B1); PG8_BAR; PG8_SCHED;
            PG8_LDB(B0, 1, 0); PG8_LDB(B1, 1, 1); PG8_SCHED; PG8_LDA(At, 1, 0); PG8_STAGE(PG8_SA(0, 1), a2 + hstepA, voffA);
            PG8_WAIT_V(8); PG8_WAIT_L(0); PG8_BAR; PG8_MMA(0, 0, At, B0); PG8_MMA(0, 1, At, B1); PG8_BAR; PG8_SCHED;
            PG8_LDA(At, 1, 1); PG8_STAGE(PG8_SB(1, 0), b3, voffB); PG8_STAGE(PG8_SB(1, 1), b3 + hstepB, voffB); PG8_STAGE(PG8_SA(1, 0), a3, voffA);
            PG8_WAIT_V(8); PG8_WAIT_L(0); PG8_BAR; PG8_MMA(1, 0, At, B0); PG8_MMA(1, 1, At, B1); PG8_BAR; PG8_SCHED;
        }
        if (wr == 0) PG8_BAR;
        E(acc, cur, wr, wc, fr, fq);
        if (!has_next) break;
#pragma unroll
        for (int a = 0; a < 2; ++a)
#pragma unroll
            for (int b = 0; b < 2; ++b)
#pragma unroll
                for (int m = 0; m < 4; ++m)
#pragma unroll
                    for (int n = 0; n < 2; ++n) acc[a][b][m][n] = (f32x4){0.f, 0.f, 0.f, 0.f};
        cur = nxt; cA = nA; cB = nB; ++ui;
        if (wr == 1) PG8_BAR;
    }
    PG8_WAIT_V(0);
    PG8_BAR;
#undef PG8_SA
#undef PG8_SB
#undef PG8_STAGE
#undef PG8_LDA
#undef PG8_LDB
#undef PG8_MMA
#undef PG8_WAIT_V
#undef PG8_WAIT_L
#undef PG8_BAR
#undef PG8_SCHED
}
}

constexpr int BATCH = 32, SEQ = 2048, DM = 1024, NTOK = BATCH * SEQ, NMEM = 256, NH = 12, HD = 64, MAINW = 768;
constexpr int AIN = 1444, AINP = 1536, DFF = 2816, NCMP = 127;
constexpr int HALF_TOK = NTOK / 2;
constexpr float ALPHA = 1.4142135623730951f;
constexpr float LN_EPS = 1e-5f;
constexpr int P_Q = 0, P_KC = 768, P_VC = 832, P_KS = 896, P_VS = 960, P_KW = 1024, P_VW = 1088, P_QM = 1152, P_G = 1408;
constexpr size_t MiB = 1u << 20;
constexpr size_t WS_WAIN = 0 * MiB, WS_WAMKV = 3 * MiB, WS_WAOUT = 4 * MiB, WS_WSKV = 6 * MiB, WS_WBIN = 9 * MiB, WS_WBMKV = 11 * MiB, WS_WBOUT = 12 * MiB;
constexpr size_t WS_WFIN = 14 * MiB  , WS_WFOUT = 36 * MiB  , WS_WC1K = 47 * MiB, WS_WC1V = 48 * MiB, WS_WMKV = 49 * MiB  ;
constexpr size_t WS_CTL = 51 * MiB, CTL_BYTES = 16384;
constexpr size_t WS_MEMB = 52 * MiB, WS_MKV = 68 * MiB  , WS_CMPH = 84 * MiB, WS_KCMP = 92 * MiB, WS_VCMP = 93 * MiB, WS_CBIAS = 94 * MiB, WS_SEL = 94 * MiB + 65536, WS_KMEAN = 95 * MiB;
constexpr size_t WS_XB = 96 * MiB, WS_BIG = 226 * MiB;
constexpr size_t BIG_P = 0, BIG_O0 = 193 * MiB, BIG_H = 0, BIG_TAILA = 352 * MiB, BIG_HEADA = 374 * MiB, BIG_HEADB = 396 * MiB, BIG_KV = 0, BIG_Q1 = 193 * MiB, BIG_O1 = 321 * MiB;
constexpr size_t WS_NEED = WS_BIG + 449 * MiB;

constexpr int LDS_BYTES = 147456;
constexpr int NTHR = 512;

struct Params {
    const float* in[24];
    float* out;
    unsigned char* ws;
    int ph_lo, ph_hi;
};
enum { I_X = 0, I_MEM, I_RELB, I_AWIN, I_PEK, I_W1K, I_W2K, I_PEV, I_W1V, I_W2V, I_AWMKV, I_AWOUT, I_SWKV, I_BWIN, I_BWMKV, I_BWOUT, I_LN1G, I_LN1B, I_LN2G, I_LN2B, I_FWIN, I_FCW, I_FCB, I_FWOUT };

namespace att {
constexpr int ROWB = 144, TILEB = 64 * ROWB, VROWB = 192, VTILEB = 64 * VROWB;
constexpr float NEG = -1e30f;
constexpr float LOG2E = 1.4426950408889634f;
constexpr float SC2 = 0.125f * LOG2E;
typedef short v4i16_t __attribute__((ext_vector_type(4)));

__device__ __forceinline__ f32x16 zero16() { f32x16 z;
#pragma unroll
    for (int i = 0; i < 16; ++i) z[i] = 0.f; return z; }

__device__ __forceinline__ void qk_tile(f32x16& p0, f32x16& p1, const LAS unsigned char* Kt, const bf16x8 (&qr)[4], int r32, int hi, float cinit = 0.f) {
    const LAS unsigned char* kb = Kt + r32 * ROWB + hi * 16;
#pragma unroll
    for (int i = 0; i < 16; ++i) { p0[i] = cinit; p1[i] = cinit; }
#pragma unroll
    for (int d0 = 0; d0 < 4; ++d0) {
        const bf16x8 k0 = *(const LAS bf16x8*)(kb + d0 * 32);
        const bf16x8 k1 = *(const LAS bf16x8*)(kb + 32 * ROWB + d0 * 32);
        p0 = __builtin_amdgcn_mfma_f32_32x32x16_bf16(k0, qr[d0], p0, 0, 0, 0);
        p1 = __builtin_amdgcn_mfma_f32_32x32x16_bf16(k1, qr[d0], p1, 0, 0, 0);
    }
}
__device__ __forceinline__ s16x4 vtr(const LAS unsigned char* p) { return __builtin_bit_cast(s16x4, __builtin_amdgcn_ds_read_tr16_b64_v4i16((LAS v4i16_t*)p)); }
__device__ __forceinline__ void pv_tile(f32x16& o0, f32x16& o1, const LAS unsigned char* Vt, const f32x16& p0, const f32x16& p1, int lane) {
    const int hi = lane >> 5, g1 = (lane >> 4) & 1, i = lane & 15, q_ = i >> 2, p_ = i & 3;
    const LAS unsigned char* vb = Vt + (4 * hi + q_) * VROWB + (16 * g1 + 4 * p_) * 2;
#pragma unroll
    for (int s = 0; s < 4; ++s) {
        u32x4 w;
        if (s < 2) { const int b = 8 * (s & 1); w.x = cvt_pk_bf16(p0[b + 0], p0[b + 1]); w.y = cvt_pk_bf16(p0[b + 2], p0[b + 3]); w.z = cvt_pk_bf16(p0[b + 4], p0[b + 5]); w.w = cvt_pk_bf16(p0[b + 6], p0[b + 7]); }
        else       { const int b = 8 * (s & 1); w.x = cvt_pk_bf16(p1[b + 0], p1[b + 1]); w.y = cvt_pk_bf16(p1[b + 2], p1[b + 3]); w.z = cvt_pk_bf16(p1[b + 4], p1[b + 5]); w.w = cvt_pk_bf16(p1[b + 6], p1[b + 7]); }
        const bf16x8 pf = __builtin_bit_cast(bf16x8, w);
#pragma unroll
        for (int dh = 0; dh < 2; ++dh) {
            const s16x4 lo = vtr(vb + (16 * s) * VROWB + dh * 64);
            const s16x4 h4 = vtr(vb + (16 * s + 8) * VROWB + dh * 64);
            const bf16x8 vf = (bf16x8){lo[0], lo[1], lo[2], lo[3], h4[0], h4[1], h4[2], h4[3]};
            if (dh == 0) o0 = __builtin_amdgcn_mfma_f32_32x32x16_bf16(vf, pf, o0, 0, 0, 0);
            else         o1 = __builtin_amdgcn_mfma_f32_32x32x16_bf16(vf, pf, o1, 0, 0, 0);
        }
    }
}
struct Acc { float m, l; f32x16 o0, o1; };
__device__ __forceinline__ void acc_init(Acc& A) { A.m = NEG; A.l = 0.f; A.o0 = zero16(); A.o1 = zero16(); }
constexpr float THR_RAW = 8.0f / SC2;
__device__ __forceinline__ void sm_update(Acc& A, f32x16& p0, f32x16& p1) {
    float m0 = fmaxf(p0[0], p1[0]), m1 = fmaxf(p0[1], p1[1]);
#pragma unroll
    for (int r = 2; r < 16; r += 2) { m0 = fmaxf(fmaxf(m0, p0[r]), p1[r]); m1 = fmaxf(fmaxf(m1, p0[r + 1]), p1[r + 1]); }
    float mx = fmaxf(m0, m1);
    mx = fmaxf(mx, __shfl_xor(mx, 32));
    if (__any(mx > A.m + THR_RAW)) {
        const float mn = fmaxf(A.m, mx);
        const float alpha = __builtin_amdgcn_exp2f((A.m - (mn < -5e29f ? 0.f : mn)) * SC2);
        A.l *= alpha; A.m = mn;
#pragma unroll
        for (int r = 0; r < 16; ++r) { A.o0[r] *= alpha; A.o1[r] *= alpha; }
    }
    const float msc = (A.m < -5e29f ? 0.f : A.m) * SC2;
    float rs0 = 0.f, rs1 = 0.f;
#pragma unroll
    for (int r = 0; r < 16; ++r) {
        const float e0 = __builtin_amdgcn_exp2f(p0[r] * SC2 - msc);
        const float e1 = __builtin_amdgcn_exp2f(p1[r] * SC2 - msc);
        p0[r] = e0; p1[r] = e1; rs0 += e0; rs1 += e1;
    }
    A.l += rs0 + rs1;
}
__device__ __forceinline__ float rowmax32(const f32x16& p0, const f32x16& p1) {
    float m0 = fmaxf(p0[0], p1[0]), m1 = fmaxf(p0[1], p1[1]), m2 = fmaxf(p0[2], p1[2]), m3 = fmaxf(p0[3], p1[3]);
#pragma unroll
    for (int r = 4; r < 16; r += 4) { m0 = fmaxf(fmaxf(m0, p0[r]), p1[r]); m1 = fmaxf(fmaxf(m1, p0[r + 1]), p1[r + 1]); m2 = fmaxf(fmaxf(m2, p0[r + 2]), p1[r + 2]); m3 = fmaxf(fmaxf(m3, p0[r + 3]), p1[r + 3]); }
    return fmaxf(fmaxf(m0, m1), fmaxf(m2, m3));
}
__device__ __forceinline__ void sm_update2(Acc& A, Acc& B, f32x16& a0, f32x16& a1, f32x16& b0, f32x16& b1) {
    float mxa = rowmax32(a0, a1), mxb = rowmax32(b0, b1);
    mxa = fmaxf(mxa, __shfl_xor(mxa, 32)); mxb = fmaxf(mxb, __shfl_xor(mxb, 32));
    if (__any((mxa > A.m + THR_RAW) || (mxb > B.m + THR_RAW))) {
        const float mna = fmaxf(A.m, mxa), mnb = fmaxf(B.m, mxb);
        const float ala = __builtin_amdgcn_exp2f((A.m - (mna < -5e29f ? 0.f : mna)) * SC2), alb = __builtin_amdgcn_exp2f((B.m - (mnb < -5e29f ? 0.f : mnb)) * SC2);
        A.l *= ala; A.m = mna; B.l *= alb; B.m = mnb;
#pragma unroll
        for (int r = 0; r < 16; ++r) { A.o0[r] *= ala; B.o0[r] *= alb; A.o1[r] *= ala; B.o1[r] *= alb; }
    }
    const float msa = (A.m < -5e29f ? 0.f : A.m) * SC2, msb = (B.m < -5e29f ? 0.f : B.m) * SC2;
    float ra0 = 0.f, ra1 = 0.f, rb0 = 0.f, rb1 = 0.f;
#pragma unroll
    for (int r = 0; r < 16; ++r) {
        const float ea0 = __builtin_amdgcn_exp2f(a0[r] * SC2 - msa), eb0 = __builtin_amdgcn_exp2f(b0[r] * SC2 - msb);
        const float ea1 = __builtin_amdgcn_exp2f(a1[r] * SC2 - msa), eb1 = __builtin_amdgcn_exp2f(b1[r] * SC2 - msb);
        a0[r] = ea0; b0[r] = eb0; a1[r] = ea1; b1[r] = eb1; ra0 += ea0; rb0 += eb0; ra1 += ea1; rb1 += eb1;
    }
    A.l += ra0 + ra1; B.l += rb0 + rb1;
}
__device__ __forceinline__ float acc_inv(const Acc& A) { const float lt = A.l + __shfl_xor(A.l, 32); return 1.0f / fmaxf(lt, 1e-30f); }

__device__ __forceinline__ void apply_general(f32x16& p0, f32x16& p1, int dist0, const LAS float* tab, bool allow, int W) {
    const unsigned We = allow ? (unsigned)W : 0u;
#pragma unroll
    for (int r = 0; r < 16; ++r) {
        const int d_0 = dist0 - ((r & 3) + 8 * (r >> 2)), d_1 = d_0 - 32;
        const int i0 = ((unsigned)d_0 < We) ? min(d_0, 128) + 1 : 0, i1 = ((unsigned)d_1 < We) ? min(d_1, 128) + 1 : 0;
        p0[r] += tab[i0];
        p1[r] += tab[i1];
        if ((r & 3) == 3) __builtin_amdgcn_sched_barrier(0);
    }
}
__device__ __forceinline__ int rel_bucket(int n) {
    if (n < 16) return n;
    const float v = logf((float)n / 16.0f) / 2.0794415416798357f * 16.0f;
    int l = 16 + (int)v; return l < 31 ? l : 31;
}
__device__ __forceinline__ u32x4 tile_ld(const bf16_t* base, long ld, int row0, int rmin, int rmax, int tid) {
    int r = row0 + (tid >> 3); r = r < rmin ? rmin : (r > rmax ? rmax : r);
    return *(const u32x4*)(base + (long)r * ld + (tid & 7) * 8);
}
__device__ __forceinline__ void tile_st(LAS unsigned char* buf, u32x4 v, int tid) { *(LAS u32x4*)(buf + (tid >> 3) * ROWB + (tid & 7) * 16) = v; }
__device__ __forceinline__ void tile_stv(LAS unsigned char* buf, u32x4 v, int tid) { *(LAS u32x4*)(buf + (tid >> 3) * VROWB + (tid & 7) * 16) = v; }
__device__ __forceinline__ void load_q(bf16x8 (&qr)[4], const bf16_t* qrow, int hi) {
#pragma unroll
    for (int d0 = 0; d0 < 4; ++d0) qr[d0] = *(const bf16x8*)(qrow + d0 * 16 + hi * 8);
}
__device__ __forceinline__ void store_o(bf16_t* orow, const f32x16& o0, const f32x16& o1, int hi) {
#pragma unroll
    for (int g = 0; g < 4; ++g) {
        u32x2 w0, w1; w0.x = cvt_pk_bf16(o0[4 * g], o0[4 * g + 1]); w0.y = cvt_pk_bf16(o0[4 * g + 2], o0[4 * g + 3]);
        w1.x = cvt_pk_bf16(o1[4 * g], o1[4 * g + 1]); w1.y = cvt_pk_bf16(o1[4 * g + 2], o1[4 * g + 3]);
        *(u32x2*)(orow + 8 * g + 4 * hi) = w0; *(u32x2*)(orow + 32 + 8 * g + 4 * hi) = w1;
    }
}
__device__ __forceinline__ void add_prev_o(const bf16_t* orow, f32x16& o0, f32x16& o1, int hi) {
#pragma unroll
    for (int g = 0; g < 4; ++g) {
        const u32x2 w0 = *(const u32x2*)(orow + 8 * g + 4 * hi), w1 = *(const u32x2*)(orow + 32 + 8 * g + 4 * hi);
        o0[4 * g] += __uint_as_float(w0.x << 16); o0[4 * g + 1] += __uint_as_float(w0.x & 0xffff0000u); o0[4 * g + 2] += __uint_as_float(w0.y << 16); o0[4 * g + 3] += __uint_as_float(w0.y & 0xffff0000u);
        o1[4 * g] += __uint_as_float(w1.x << 16); o1[4 * g + 1] += __uint_as_float(w1.x & 0xffff0000u); o1[4 * g + 2] += __uint_as_float(w1.y << 16); o1[4 * g + 3] += __uint_as_float(w1.y & 0xffff0000u);
    }
}
__device__ __forceinline__ float sigmoidf(float x) { return 1.0f / (1.0f + __expf(-x)); }

constexpr int L_K0 = 0, L_K1 = TILEB, L_V0 = 2 * TILEB, L_V1 = 2 * TILEB + VTILEB, L_TAB = 2 * TILEB + 2 * VTILEB  , L_SIMP = 53248  , L_Q = 53248  , L_BKT = 131072  , L_MISC = 131072 + 1024  ;

__device__ __forceinline__ const LAS unsigned char* park_q(LAS unsigned char* lds, const bf16_t* q0, const bf16_t* q1, int wid, int lane, int hi) {
    LAS unsigned char* qp = lds + L_Q + wid * 8192 + lane * 16;
#pragma unroll
    for (int d0 = 0; d0 < 4; ++d0) { *(LAS bf16x8*)(qp + d0 * 1024) = *(const bf16x8*)(q0 + d0 * 16 + hi * 8); *(LAS bf16x8*)(qp + 4096 + d0 * 1024) = *(const bf16x8*)(q1 + d0 * 16 + hi * 8); }
    return qp;
}
__device__ __forceinline__ void fill_tab(LAS unsigned char* lds, const float* relb, int h0, int nh, int tid) {
    LAS float* tab = (LAS float*)(lds + L_TAB);
    const LAS int* bkt = (const LAS int*)(lds + L_BKT);
    for (int i = tid; i < nh * 130; i += NTHR) { const int hh = i / 130, d = i % 130; tab[hh * 132 + d] = d == 0 ? NEG : relb[bkt[d] * NH + h0 + hh] * 8.0f; }
}

template <int MODE>
struct TileInfo { bool want, near, allow; float cinit; };
template <int MODE>
__device__ __forceinline__ TileInfo<MODE> classify(int kt, int tw, unsigned selmask, int blkshift, int W, float b129) {
    TileInfo<MODE> ti; const int kbase = kt * 64;
    if (MODE == 0) { ti.want = true; ti.near = false; ti.allow = true; ti.cinit = 0.f; }
    else if (MODE == 1) { ti.allow = (selmask >> (kt >> blkshift)) & 1u; ti.want = (kbase <= tw + 31) && __any(ti.allow); ti.near = !(tw - (kbase + 63) >= 128); ti.cinit = ti.near ? 0.f : (ti.allow ? b129 : NEG); }
    else { ti.allow = true; ti.want = (kbase <= tw + 31) && (kbase + 63 >= tw - (W - 1)); ti.near = !((tw - (kbase + 63) >= 128) && (tw + 31 - kbase < W)); ti.cinit = ti.near ? 0.f : b129; }
    return ti;
}
template <int MODE, bool QREG>
__device__ __forceinline__ void seg2(Acc (&A)[2], LAS unsigned char* lds, const bf16_t* Kg, const bf16_t* Vg, long ld, int rmax, int lo, int hi_t,
                                     const LAS unsigned char* qp  , int t0  , int tw0, unsigned sel0, unsigned sel1, int blkshift, int W, const LAS float* tab, int tid) {
    const int lane = tid & 63, r32 = lane & 31, hi = lane >> 5;
    if (lo >= hi_t) return;
    {
        const u32x4 k0 = tile_ld(Kg, ld, lo * 64, 0, rmax, tid), v0 = tile_ld(Vg, ld, lo * 64, 0, rmax, tid);
        __syncthreads();
        tile_st(lds + L_K0, k0, tid); tile_stv(lds + L_V0, v0, tid);
        __syncthreads();
    }
    const float b129 = (MODE == 0) ? 0.f : tab[129];
    const int g1 = (lane >> 4) & 1, i16 = lane & 15, q_ = i16 >> 2, p_ = i16 & 3;
    bf16x8 qra[4], qrb[4];
    if (QREG) {
#pragma unroll
        for (int d0 = 0; d0 < 4; ++d0) { qra[d0] = *(const LAS bf16x8*)(qp + d0 * 1024); qrb[d0] = *(const LAS bf16x8*)(qp + 4096 + d0 * 1024); }
    }
    int cur = 0;
    for (int kt = lo; kt < hi_t; ++kt) {
        const bool more1 = kt + 1 < hi_t;
        u32x4 kreg, vreg;
        if (more1) { kreg = tile_ld(Kg, ld, (kt + 1) * 64, 0, rmax, tid); vreg = tile_ld(Vg, ld, (kt + 1) * 64, 0, rmax, tid); }
        TileInfo<MODE> ta = classify<MODE>(kt, tw0, sel0, blkshift, W, b129), tb = classify<MODE>(kt, tw0 + 32, sel1, blkshift, W, b129);
        if (ta.want || tb.want) {
            if (!ta.want) { ta.cinit = NEG; ta.near = false; }
            if (!tb.want) { tb.cinit = NEG; tb.near = false; }
            const LAS unsigned char* Kt = lds + (cur ? L_K1 : L_K0); const LAS unsigned char* Vt = lds + (cur ? L_V1 : L_V0);
            f32x16 a0, a1, b0, b1;
#pragma unroll
            for (int i = 0; i < 16; ++i) { a0[i] = ta.cinit; a1[i] = ta.cinit; b0[i] = tb.cinit; b1[i] = tb.cinit; }
            const LAS unsigned char* kb = Kt + r32 * ROWB + hi * 16;
#pragma unroll
            for (int d0 = 0; d0 < 4; ++d0) {
                const bf16x8 k0 = *(const LAS bf16x8*)(kb + d0 * 32);
                const bf16x8 k1 = *(const LAS bf16x8*)(kb + 32 * ROWB + d0 * 32);
                const bf16x8 qa = QREG ? qra[d0] : *(const LAS bf16x8*)(qp + d0 * 1024), qb_ = QREG ? qrb[d0] : *(const LAS bf16x8*)(qp + 4096 + d0 * 1024);
                a0 = __builtin_amdgcn_mfma_f32_32x32x16_bf16(k0, qa, a0, 0, 0, 0);
                b0 = __builtin_amdgcn_mfma_f32_32x32x16_bf16(k0, qb_, b0, 0, 0, 0);
                a1 = __builtin_amdgcn_mfma_f32_32x32x16_bf16(k1, qa, a1, 0, 0, 0);
                b1 = __builtin_amdgcn_mfma_f32_32x32x16_bf16(k1, qb_, b1, 0, 0, 0);
            }
            if (MODE != 0) {
                if (ta.near) apply_general(a0, a1, t0 - kt * 64 - 4 * hi, tab, ta.allow, W);
                if (tb.near) apply_general(b0, b1, t0 + 32 - kt * 64 - 4 * hi, tab, tb.allow, W);
            }
            sm_update2(A[0], A[1], a0, a1, b0, b1);
            const LAS unsigned char* vb = Vt + (4 * hi + q_) * VROWB + (16 * g1 + 4 * p_) * 2;
#pragma unroll
            for (int s = 0; s < 4; ++s) {
                const int bs = 8 * (s & 1);
                u32x4 wa, wb;
                if (s < 2) { wa.x = cvt_pk_bf16(a0[bs + 0], a0[bs + 1]); wa.y = cvt_pk_bf16(a0[bs + 2], a0[bs + 3]); wa.z = cvt_pk_bf16(a0[bs + 4], a0[bs + 5]); wa.w = cvt_pk_bf16(a0[bs + 6], a0[bs + 7]);
                             wb.x = cvt_pk_bf16(b0[bs + 0], b0[bs + 1]); wb.y = cvt_pk_bf16(b0[bs + 2], b0[bs + 3]); wb.z = cvt_pk_bf16(b0[bs + 4], b0[bs + 5]); wb.w = cvt_pk_bf16(b0[bs + 6], b0[bs + 7]); }
                else       { wa.x = cvt_pk_bf16(a1[bs + 0], a1[bs + 1]); wa.y = cvt_pk_bf16(a1[bs + 2], a1[bs + 3]); wa.z = cvt_pk_bf16(a1[bs + 4], a1[bs + 5]); wa.w = cvt_pk_bf16(a1[bs + 6], a1[bs + 7]);
                             wb.x = cvt_pk_bf16(b1[bs + 0], b1[bs + 1]); wb.y = cvt_pk_bf16(b1[bs + 2], b1[bs + 3]); wb.z = cvt_pk_bf16(b1[bs + 4], b1[bs + 5]); wb.w = cvt_pk_bf16(b1[bs + 6], b1[bs + 7]); }
                const bf16x8 pfa = __builtin_bit_cast(bf16x8, wa), pfb = __builtin_bit_cast(bf16x8, wb);
#pragma unroll
                for (int dh = 0; dh < 2; ++dh) {
                    const s16x4 lo4 = vtr(vb + (16 * s) * VROWB + dh * 64);
                    const s16x4 h4 = vtr(vb + (16 * s + 8) * VROWB + dh * 64);
                    const bf16x8 vf = (bf16x8){lo4[0], lo4[1], lo4[2], lo4[3], h4[0], h4[1], h4[2], h4[3]};
                    if (dh == 0) { A[0].o0 = __builtin_amdgcn_mfma_f32_32x32x16_bf16(vf, pfa, A[0].o0, 0, 0, 0); A[1].o0 = __builtin_amdgcn_mfma_f32_32x32x16_bf16(vf, pfb, A[1].o0, 0, 0, 0); }
                    else         { A[0].o1 = __builtin_amdgcn_mfma_f32_32x32x16_bf16(vf, pfa, A[0].o1, 0, 0, 0); A[1].o1 = __builtin_amdgcn_mfma_f32_32x32x16_bf16(vf, pfb, A[1].o1, 0, 0, 0); }
                }
            }
        }
        if (more1) { tile_st(lds + (cur ? L_K0 : L_K1), kreg, tid); tile_stv(lds + (cur ? L_V0 : L_V1), vreg, tid); }
        __syncthreads();
        cur ^= 1;
    }
}
}

struct Ctx { int tid, lane, wid, gtid, gsz, gw, ngw; };

template <int MAP>
__device__ __forceinline__ void xpose_w(const Ctx& c, const float* W, int K, int N, bf16_t* WT, int Ndst, int dst_off = 0) {
    const int nk = K >> 6; const long total = (long)Ndst * nk;
    for (long i = c.gtid; i < total; i += c.gsz) {
        const int n = (int)(i % Ndst), kc = (int)(i / Ndst);
        int src = n;
        if (MAP == 1) { if (n >= 1152 && n < 1408) src = 1188 + (n - 1152); else if (n >= 1408 && n < 1444) src = 1152 + (n - 1408); else if (n >= 1444) src = -1; }
        else if (MAP == 2) { const int tl = n >> 8, wi = n & 255; src = wi < 128 ? tl * 128 + wi : 2816 + tl * 128 + (wi - 128); }
        else if (n >= N) src = -1;
        bf16_t* dst = WT + (size_t)(dst_off + n) * K + kc * 64;
        if (src < 0) {
#pragma unroll
            for (int q = 0; q < 8; ++q) *(u32x4*)(dst + q * 8) = (u32x4){0u, 0u, 0u, 0u};
        } else {
            const float* s = W + (size_t)(kc * 64) * N + src;
#pragma unroll
            for (int q = 0; q < 8; ++q) {
                u32x4 w; const float* sq = s + (size_t)(q * 8) * N;
                w.x = cvt_pk_bf16(sq[0], sq[(size_t)N]); w.y = cvt_pk_bf16(sq[2 * (size_t)N], sq[3 * (size_t)N]); w.z = cvt_pk_bf16(sq[4 * (size_t)N], sq[5 * (size_t)N]); w.w = cvt_pk_bf16(sq[6 * (size_t)N], sq[7 * (size_t)N]);
                *(u32x4*)(dst + q * 8) = w;
            }
        }
    }
}
__device__ __forceinline__ void cvt_rows(const Ctx& c, const float* X, bf16_t* XB, long nelem) {
    const long n8 = nelem >> 3;
    for (long i = c.gtid; i < n8; i += c.gsz) {
        const f32x4 a = *(const f32x4*)(X + i * 8), b = *(const f32x4*)(X + i * 8 + 4);
        u32x4 w; w.x = cvt_pk_bf16(a[0], a[1]); w.y = cvt_pk_bf16(a[2], a[3]); w.z = cvt_pk_bf16(b[0], b[1]); w.w = cvt_pk_bf16(b[2], b[3]);
        *(u32x4*)(XB + i * 8) = w;
    }
}
__device__ __forceinline__ void prep_late(const Params& p, const Ctx& c) {
    unsigned char* ws = p.ws;
    xpose_w<0>(c, p.in[I_AWOUT], DM, DM, (bf16_t*)(ws + WS_WAOUT), DM);
    xpose_w<0>(c, p.in[I_SWKV], DM, 1536, (bf16_t*)(ws + WS_WSKV), 1536);
    xpose_w<0>(c, p.in[I_BWIN], DM, DM, (bf16_t*)(ws + WS_WBIN), DM);
    xpose_w<0>(c, p.in[I_BWOUT], DM, DM, (bf16_t*)(ws + WS_WBOUT), DM);
    for (int l = 0; l < 2; ++l) {
        xpose_w<2>(c, p.in[I_FWIN] + (size_t)l * DM * 2 * DFF, DM, 2 * DFF, (bf16_t*)(ws + WS_WFIN) + (size_t)l * 2 * DFF * DM, 2 * DFF);
        xpose_w<0>(c, p.in[I_FWOUT] + (size_t)l * DFF * DM, DFF, DM, (bf16_t*)(ws + WS_WFOUT) + (size_t)l * DM * DFF, DM);
    }
}
constexpr int LATE_FIRST_WG = 160;
__device__ __forceinline__ void phase_prep(const Params& p, const Ctx& c) {
    unsigned char* ws = p.ws;
    xpose_w<1>(c, p.in[I_AWIN], DM, AIN, (bf16_t*)(ws + WS_WAIN), AINP);
    xpose_w<0>(c, p.in[I_AWMKV], DM, 512, (bf16_t*)(ws + WS_WMKV), 512, 0);
    xpose_w<0>(c, p.in[I_BWMKV], DM, 512, (bf16_t*)(ws + WS_WMKV), 512, 512);
    xpose_w<0>(c, p.in[I_W1K], 2048, 256, (bf16_t*)(ws + WS_WC1K), 256);
    xpose_w<0>(c, p.in[I_W1V], 2048, 256, (bf16_t*)(ws + WS_WC1V), 256);
    if ((int)gridDim.x < LATE_FIRST_WG + 32) prep_late(p, c);
    cvt_rows(c, p.in[I_X], (bf16_t*)(ws + WS_XB), (long)NTOK * DM);
    cvt_rows(c, p.in[I_MEM], (bf16_t*)(ws + WS_MEMB), (long)BATCH * NMEM * DM);
    for (int o = c.gw; o < 512; o += c.ngw) {
        const int which = o >> 8, j = o & 255;
        const float* pe = p.in[which ? I_PEV : I_PEK]; const float* w1 = p.in[which ? I_W1V : I_W1K];
        float s = 0.f;
#pragma unroll 8
        for (int k = c.lane; k < 2048; k += 64) s += pe[k] * w1[(size_t)k * 256 + j];
#pragma unroll
        for (int sh = 1; sh < 64; sh <<= 1) s += __shfl_xor(s, sh);
        if (c.lane == 0) ((float*)(ws + WS_CBIAS))[which * 256 + j] = s;
    }
}
__device__ __forceinline__ void phase_cmp2(const Params& p, const Ctx& c) {
    unsigned char* ws = p.ws;
    for (int i = c.gtid; i < 2 * 4096 * 64; i += c.gsz) {
        const int which = i >> 18, m = (i >> 6) & 4095, d = i & 63;
        const float* hid = (const float*)(ws + WS_CMPH) + ((size_t)which * 4096 + m) * 256; const float* w2 = p.in[which ? I_W2V : I_W2K];
        float s = 0.f;
#pragma unroll 8
        for (int j = 0; j < 256; ++j) s += hid[j] * w2[j * 64 + d];
        if ((m & 127) == 127) s = 0.f;
        unsigned u = __float_as_uint(s); u = (u + 0x7fffu + ((u >> 16) & 1u)) >> 16;
        ((bf16_t*)(ws + (which ? WS_VCMP : WS_KCMP)))[(size_t)m * 64 + d] = (bf16_t)u;
    }
}
__device__ __forceinline__ void phase_ln(const Ctx& c, const float* y, const float* g, const float* bta, float* xf, bf16_t* xb) {
    for (int row = c.gw; row < NTOK; row += c.ngw) {
        const float* yr = y + (size_t)row * DM + c.lane * 4;
        f32x4 v[4]; float s = 0.f;
#pragma unroll
        for (int j = 0; j < 4; ++j) { v[j] = *(const f32x4*)(yr + 256 * j); s += (v[j][0] + v[j][1]) + (v[j][2] + v[j][3]); }
#pragma unroll
        for (int o = 1; o < 64; o <<= 1) s += __shfl_xor(s, o);
        const float mean = s * (1.0f / DM); float q = 0.f;
#pragma unroll
        for (int j = 0; j < 4; ++j) { v[j] = v[j] - mean; q += (v[j][0] * v[j][0] + v[j][1] * v[j][1]) + (v[j][2] * v[j][2] + v[j][3] * v[j][3]); }
#pragma unroll
        for (int o = 1; o < 64; o <<= 1) q += __shfl_xor(q, o);
        const float rstd = 1.0f / sqrtf(q * (1.0f / DM) + LN_EPS);
#pragma unroll
        for (int j = 0; j < 4; ++j) {
            const f32x4 gg = *(const f32x4*)(g + c.lane * 4 + 256 * j), bb = *(const f32x4*)(bta + c.lane * 4 + 256 * j);
            const f32x4 o = v[j] * rstd * gg + bb;
            if (xf) *(f32x4*)(xf + (size_t)row * DM + c.lane * 4 + 256 * j) = o;
            if (xb) { u32x2 w; w.x = cvt_pk_bf16(o[0], o[1]); w.y = cvt_pk_bf16(o[2], o[3]); *(u32x2*)(xb + (size_t)row * DM + c.lane * 4 + 256 * j) = w; }
        }
    }
}
__device__ __forceinline__ void unpack8(const u32x4 w, float (&f)[8]) {
    f[0] = __uint_as_float(w.x << 16); f[1] = __uint_as_float(w.x & 0xffff0000u); f[2] = __uint_as_float(w.y << 16); f[3] = __uint_as_float(w.y & 0xffff0000u);
    f[4] = __uint_as_float(w.z << 16); f[5] = __uint_as_float(w.z & 0xffff0000u); f[6] = __uint_as_float(w.w << 16); f[7] = __uint_as_float(w.w & 0xffff0000u);
}
__device__ __forceinline__ void ffn_fixup(const Ctx& c, unsigned char* big, const float* cw, const float* cbias, int pm) {
    const float* TAILA = (const float*)(big + BIG_TAILA); const float* HEADA = (const float*)(big + BIG_HEADA); const float* HEADB = (const float*)(big + BIG_HEADB); bf16_t* H = (bf16_t*)(big + BIG_H);
    constexpr int NCH = DFF / 8;
    for (int it = c.tid; it < 4 * 2 * NCH; it += NTHR) {
        const int ch = it % NCH, gi = it / NCH, i = gi & 1, G = pm * 4 + (gi >> 1), col = ch * 8;
        const bool first = ((G * 64) & (SEQ - 1)) == 0;
        float p0[8], p1[8], a0[8], a1[8], b[8], h[8];
#pragma unroll
        for (int j = 0; j < 8; ++j) { p0[j] = 0.f; p1[j] = 0.f; }
        if (!first) {
            const float* t0 = TAILA + ((size_t)(G - 1) * 2) * DFF + col;
#pragma unroll
            for (int j = 0; j < 8; ++j) { p0[j] = t0[j]; p1[j] = t0[DFF + j]; }
        }
        const float* ha = HEADA + ((size_t)G * 2) * DFF + col; const float* hb = HEADB + ((size_t)G * 2 + i) * DFF + col;
#pragma unroll
        for (int j = 0; j < 8; ++j) { a0[j] = ha[j]; a1[j] = ha[DFF + j]; b[j] = hb[j]; }
#pragma unroll
        for (int j = 0; j < 8; ++j) {
            const float am2 = i ? p1[j] : p0[j], am1 = i ? a0[j] : p1[j], a = i ? a1[j] : a0[j];
            const float pre = cw[col + j] * am2 + cw[DFF + col + j] * am1 + cw[2 * DFF + col + j] * a + cbias[col + j];
            h[j] = gelu_tanh(pre) * b[j];
        }
        u32x4 w; w.x = cvt_pk_bf16(h[0], h[1]); w.y = cvt_pk_bf16(h[2], h[3]); w.z = cvt_pk_bf16(h[4], h[5]); w.w = cvt_pk_bf16(h[6], h[7]);
        *(u32x4*)(H + (size_t)(G * 64 + i) * DFF + col) = w;
    }
}
__device__ __forceinline__ void phase_kmean(const Ctx& c, const bf16_t* KV, float* KM) {
    for (int it = c.gw; it < BATCH * 8 * 12; it += c.ngw) {
        const int cg_ = it % 12, bn = it / 12, ch = c.lane & 7, rs = c.lane >> 3;
        float s[8];
#pragma unroll
        for (int j = 0; j < 8; ++j) s[j] = 0.f;
        const bf16_t* src = KV + (size_t)bn * 256 * 1536 + cg_ * 64 + ch * 8;
#pragma unroll 4
        for (int r = rs; r < 256; r += 8) { float v[8]; unpack8(*(const u32x4*)(src + (size_t)r * 1536), v);
#pragma unroll
            for (int j = 0; j < 8; ++j) s[j] += v[j]; }
#pragma unroll
        for (int j = 0; j < 8; ++j) { s[j] += __shfl_xor(s[j], 8); s[j] += __shfl_xor(s[j], 16); s[j] += __shfl_xor(s[j], 32); }
        if (rs == 0) {
#pragma unroll
            for (int j = 0; j < 8; ++j) KM[(size_t)bn * 768 + cg_ * 64 + ch * 8 + j] = s[j] * (1.0f / 256.0f);
        }
    }
}

__device__ __forceinline__ void nsa1_unit(const Params& p, LAS unsigned char* lds, int b, int qb) {
    using namespace att;
    int tid_ = threadIdx.x; asm volatile("" : "+v"(tid_));
    const int tid = tid_, lane = tid & 63, r32 = lane & 31, hi = lane >> 5, wid = tid >> 6;
    unsigned char* ws = p.ws;
    const bf16_t* P = (const bf16_t*)(ws + WS_BIG + BIG_P); bf16_t* O = (bf16_t*)(ws + WS_BIG + BIG_O0);
    const bf16_t* KC = (const bf16_t*)(ws + WS_KCMP) + (size_t)b * 128 * 64; const bf16_t* VC = (const bf16_t*)(ws + WS_VCMP) + (size_t)b * 128 * 64;
    __syncthreads();
    tile_st(lds + L_K0, tile_ld(KC, 64, 0, 0, 127, tid), tid); tile_st(lds + L_K1, tile_ld(KC, 64, 64, 0, 127, tid), tid);
    tile_stv(lds + L_V0, tile_ld(VC, 64, 0, 0, 127, tid), tid); tile_stv(lds + L_V1, tile_ld(VC, 64, 64, 0, 127, tid), tid);
    fill_tab(lds, p.in[I_RELB], 0, NH, tid);
    __syncthreads();
    const int t = qb * 256 + wid * 32 + r32; const size_t row = (size_t)b * SEQ + t;
    LAS float* simp = (LAS float*)(lds + L_SIMP) + (wid * 32 + r32) * 33;
#pragma unroll
    for (int i = 0; i < 16; ++i) simp[2 * i + hi] = 0.f;
#pragma nounroll
    for (int h = 0; h < NH; ++h) {
        bf16x8 qr[4]; load_q(qr, P + row * AINP + P_Q + h * 64, hi);
        f32x16 pp[4];
        qk_tile(pp[0], pp[1], lds + L_K0, qr, r32, hi); qk_tile(pp[2], pp[3], lds + L_K1, qr, r32, hi);
        const LAS float* tab = (const LAS float*)(lds + L_TAB) + h * 132;
        float mx = NEG;
        const int tws = __builtin_amdgcn_readfirstlane(t - r32);
#pragma unroll
        for (int a = 0; a < 4; ++a) {
            if (tws >= 512 * a + 655) { const float bb = tab[129];
#pragma unroll
                for (int r = 0; r < 16; ++r) { const float s = pp[a][r] + bb; pp[a][r] = s; mx = fmaxf(mx, s); } }
            else if (tws < 512 * a) {
#pragma unroll
                for (int r = 0; r < 16; ++r) pp[a][r] = NEG; }
            else {
#pragma unroll
                for (int r = 0; r < 16; ++r) { const int n = (r & 3) + 8 * (r >> 2) + 4 * hi + 32 * a; const int d = t - 30 - 16 * n;
                    const float s = pp[a][r] + tab[min(max(d, 0), 129)]; pp[a][r] = s; mx = fmaxf(mx, s); } }
        }
        mx = fmaxf(mx, __shfl_xor(mx, 32));
        const bool dead = mx < -5e29f;
        const float msc = (dead ? 0.f : mx) * SC2;
        float sum = 0.f;
#pragma unroll
        for (int a = 0; a < 4; ++a)
#pragma unroll
            for (int r = 0; r < 16; ++r) { const float e = __builtin_amdgcn_exp2f(pp[a][r] * SC2 - msc); pp[a][r] = e; sum += e; }
        sum += __shfl_xor(sum, 32);
        const float inv = dead ? 0.f : 1.0f / fmaxf(sum, 1e-30f);
#pragma unroll
        for (int a = 0; a < 4; ++a)
#pragma unroll
            for (int r = 0; r < 16; ++r) pp[a][r] *= inv;
#pragma unroll
        for (int a = 0; a < 4; ++a)
#pragma unroll
            for (int g = 0; g < 4; ++g) {
                const float gs = (pp[a][4 * g] + pp[a][4 * g + 1]) + (pp[a][4 * g + 2] + pp[a][4 * g + 3]);
                const float lastv = pp[a][4 * g + 3];
                const float shifted = (g >= 1) ? pp[a][4 * (g - 1) + 3] : ((a >= 1) ? pp[(a >= 1) ? a - 1 : 0][15] : 0.f);
                const float snd = hi ? shifted : lastv;
                const float rcv = __shfl_xor(snd, 32);
                simp[8 * a + 2 * g + hi] += gs + rcv;
            }
        f32x16 o0 = zero16(), o1 = zero16();
        pv_tile(o0, o1, lds + L_V0, pp[0], pp[1], lane); pv_tile(o0, o1, lds + L_V1, pp[2], pp[3], lane);
        const float gate = sigmoidf(bf2f(P[row * AINP + P_G + h * 3 + 0]));
#pragma unroll
        for (int r = 0; r < 16; ++r) { o0[r] *= gate; o1[r] *= gate; }
        store_o(O + row * DM + h * 64, o0, o1, hi);
    }
    __syncthreads();
    const int cur = t >> 6; unsigned mask;
    if (cur < 16) mask = (2u << cur) - 1u;
    else {
        mask = 1u | (1u << cur) | (1u << (cur - 1));
        unsigned cand = ((1u << (cur - 1)) - 1u) & ~1u;
#pragma nounroll
        for (int k = 0; k < 13; ++k) {
            float best = -3e38f; int bi = 0;
#pragma nounroll
            for (int s = 1; s <= 29; ++s) { const float v = simp[s]; const bool take = ((cand >> s) & 1u) && (v > best); best = take ? v : best; bi = take ? s : bi; }
            mask |= 1u << bi; cand &= ~(1u << bi);
        }
    }
    if (hi == 0) ((unsigned*)(ws + WS_SEL))[row] = mask;
}
__device__ __forceinline__ void nsa2_unit(const Params& p, LAS unsigned char* lds, int b, int h0, int qb) {
    using namespace att;
    int tid_ = threadIdx.x; asm volatile("" : "+v"(tid_));
    const int tid = tid_, lane = tid & 63, r32 = lane & 31, hi = lane >> 5, wid = tid >> 6;
    unsigned char* ws = p.ws;
    const bf16_t* P = (const bf16_t*)(ws + WS_BIG + BIG_P); bf16_t* O = (bf16_t*)(ws + WS_BIG + BIG_O0);
    __syncthreads();
    fill_tab(lds, p.in[I_RELB], h0, 2, tid);
    const int h = h0 + (wid >> 2);
    const LAS float* tab = (const LAS float*)(lds + L_TAB) + (wid >> 2) * 132;
    const int tw0 = qb * 256 + (wid & 3) * 64, t0 = tw0 + r32; const size_t row0 = (size_t)b * SEQ + t0, row1 = row0 + 32;
    const LAS unsigned char* qp = park_q(lds, P + row0 * AINP + P_Q + h * 64, P + row1 * AINP + P_Q + h * 64, wid, lane, hi);
    const unsigned sel0 = ((const unsigned*)(ws + WS_SEL))[row0], sel1 = ((const unsigned*)(ws + WS_SEL))[row1];
    const bf16_t* Pb = P + (size_t)b * SEQ * AINP;
    Acc A[2]; acc_init(A[0]); acc_init(A[1]);
    seg2<1, false>(A, lds, Pb + P_KS, Pb + P_VS, AINP, SEQ - 1, 0, qb * 4 + 4, qp, t0, tw0, sel0, sel1, 0, 1 << 30, tab, tid);
#pragma unroll
    for (int s = 0; s < 2; ++s) {
        const size_t row = s ? row1 : row0;
        const float gs = sigmoidf(bf2f(P[row * AINP + P_G + h * 3 + 1])) * acc_inv(A[s]);
#pragma unroll
        for (int r = 0; r < 16; ++r) { A[s].o0[r] *= gs; A[s].o1[r] *= gs; }
        bf16_t* orow = O + row * DM + h * 64;
        add_prev_o(orow, A[s].o0, A[s].o1, hi); store_o(orow, A[s].o0, A[s].o1, hi);
        acc_init(A[s]);
    }
    const int wlo = qb * 4 - 8 < 0 ? 0 : qb * 4 - 8;
    seg2<2, false>(A, lds, Pb + P_KW, Pb + P_VW, AINP, SEQ - 1, wlo, qb * 4 + 4, qp, t0, tw0, 0u, 0u, 0, 512, tab, tid);
#pragma unroll
    for (int s = 0; s < 2; ++s) {
        const size_t row = s ? row1 : row0;
        const float gw = sigmoidf(bf2f(P[row * AINP + P_G + h * 3 + 2])) * acc_inv(A[s]);
#pragma unroll
        for (int r = 0; r < 16; ++r) { A[s].o0[r] *= gw; A[s].o1[r] *= gw; }
        bf16_t* orow = O + row * DM + h * 64;
        add_prev_o(orow, A[s].o0, A[s].o1, hi); store_o(orow, A[s].o0, A[s].o1, hi);
    }
}
__device__ __forceinline__ unsigned moba_select(const float* KM, const bf16x8 (&qr)[4], int b, int h, int qb, int hi) {
    float gt[7];
#pragma unroll
    for (int n = 0; n < 7; ++n) {
        float s = 0.f;
        if (n < qb) {
            const float* km = KM + ((size_t)(b * 8 + n) * NH + h) * 64 + hi * 8;
#pragma unroll
            for (int d0 = 0; d0 < 4; ++d0) { const f32x4 k0 = *(const f32x4*)(km + d0 * 16), k1 = *(const f32x4*)(km + d0 * 16 + 4);
                s += bf2f((unsigned short)qr[d0][0]) * k0[0] + bf2f((unsigned short)qr[d0][1]) * k0[1] + bf2f((unsigned short)qr[d0][2]) * k0[2] + bf2f((unsigned short)qr[d0][3]) * k0[3]
                   + bf2f((unsigned short)qr[d0][4]) * k1[0] + bf2f((unsigned short)qr[d0][5]) * k1[1] + bf2f((unsigned short)qr[d0][6]) * k1[2] + bf2f((unsigned short)qr[d0][7]) * k1[3]; }
        }
        s += __shfl_xor(s, 32);
        gt[n] = s;
    }
    unsigned sel = 1u << qb, cand = (1u << qb) - 1u;
#pragma nounroll
    for (int k = 0; k < 3; ++k) {
        float best = -3e38f; int bi = -1;
#pragma unroll
        for (int n = 0; n < 7; ++n) { const bool take = ((cand >> n) & 1u) && (gt[n] > best); best = take ? gt[n] : best; bi = take ? n : bi; }
        if (bi >= 0) { sel |= 1u << bi; cand &= ~(1u << bi); }
    }
    return sel;
}
__device__ __forceinline__ void moba_unit(const Params& p, LAS unsigned char* lds, int b, int h, int qp) {
    using namespace att;
    int tid_ = threadIdx.x; asm volatile("" : "+v"(tid_));
    const int tid = tid_, lane = tid & 63, r32 = lane & 31, hi = lane >> 5, wid = tid >> 6;
    unsigned char* ws = p.ws;
    const bf16_t* KV = (const bf16_t*)(ws + WS_BIG + BIG_KV); const bf16_t* Q = (const bf16_t*)(ws + WS_BIG + BIG_Q1); bf16_t* O = (bf16_t*)(ws + WS_BIG + BIG_O1);
    const float* KM = (const float*)(ws + WS_KMEAN);
    __syncthreads();
    fill_tab(lds, p.in[I_RELB], h, 1, tid);
    const LAS float* tab = (const LAS float*)(lds + L_TAB);
    const int qb = 2 * qp + (wid >> 2);
    const int tw0 = qb * 256 + (wid & 3) * 64, t0 = tw0 + r32; const size_t row0 = (size_t)b * SEQ + t0, row1 = row0 + 32;
    unsigned sel0, sel1;
    { bf16x8 qr[4]; load_q(qr, Q + row0 * DM + h * 64, hi); sel0 = moba_select(KM, qr, b, h, qb, hi); }
    { bf16x8 qr[4]; load_q(qr, Q + row1 * DM + h * 64, hi); sel1 = moba_select(KM, qr, b, h, qb, hi); }
    const LAS unsigned char* qp_ = park_q(lds, Q + row0 * DM + h * 64, Q + row1 * DM + h * 64, wid, lane, hi);
    const bf16_t* Kb = KV + (size_t)b * SEQ * 1536 + h * 64;
    Acc A[2]; acc_init(A[0]); acc_init(A[1]);
    seg2<1, true>(A, lds, Kb, Kb + MAINW, 1536, SEQ - 1, 0, qp * 8 + 8, qp_, t0, tw0, sel0, sel1, 2, 1 << 30, tab, tid);
#pragma unroll
    for (int s = 0; s < 2; ++s) {
        const float inv = acc_inv(A[s]);
#pragma unroll
        for (int r = 0; r < 16; ++r) { A[s].o0[r] *= inv; A[s].o1[r] *= inv; }
        store_o(O + (s ? row1 : row0) * DM + h * 64, A[s].o0, A[s].o1, hi);
    }
}
__device__ __forceinline__ void mem_unit(const Params& p, LAS unsigned char* lds, const bf16_t* Q, int ldq, int qcol, bf16_t* O, int kvcol, int b, int mh, int qq) {
    using namespace att;
    int tid_ = threadIdx.x; asm volatile("" : "+v"(tid_));
    const int tid = tid_, lane = tid & 63, r32 = lane & 31, hi = lane >> 5, wid = tid >> 6;
    const bf16_t* MKV = (const bf16_t*)(p.ws + WS_MKV) + (size_t)b * NMEM * 1024 + kvcol + mh * 64;
    const int tw0 = qq * 512 + wid * 64, t0 = tw0 + r32; const size_t row0 = (size_t)b * SEQ + t0, row1 = row0 + 32;
    __syncthreads();
    const LAS unsigned char* qp = park_q(lds, Q + row0 * ldq + qcol + mh * 64, Q + row1 * ldq + qcol + mh * 64, wid, lane, hi);
    Acc A[2]; acc_init(A[0]); acc_init(A[1]);
    seg2<0, true>(A, lds, MKV, MKV + 256, 1024, NMEM - 1, 0, 4, qp, t0, tw0, 0u, 0u, 0, 1 << 30, (const LAS float*)(lds + L_TAB), tid);
#pragma unroll
    for (int s = 0; s < 2; ++s) {
        const float inv = acc_inv(A[s]);
#pragma unroll
        for (int r = 0; r < 16; ++r) { A[s].o0[r] *= inv; A[s].o1[r] *= inv; }
        store_o(O + (s ? row1 : row0) * DM + MAINW + mh * 64, A[s].o0, A[s].o1, hi);
    }
}

#define XB_TMO      128
#define XB_XCNT(j)  (256  + 64 * (j))
#define XB_XSUB(j)  (1280 + 64 * (j))
#define XB_XGEN(j)  (2304 + 64 * (j))
#define XB_TOP      3328
#define XB_TOPGEN   3392
#define XCD_BAR_WORDS 3456
#define XB_SPIN_CAP (1u << 18)
__device__ __forceinline__ unsigned xb_ld(unsigned* p)              { return __hip_atomic_load(p, __ATOMIC_RELAXED, __HIP_MEMORY_SCOPE_AGENT); }
__device__ __forceinline__ unsigned xb_add(unsigned* p, unsigned v) { return __hip_atomic_fetch_add(p, v, __ATOMIC_RELAXED, __HIP_MEMORY_SCOPE_AGENT); }
__device__ __forceinline__ unsigned xb_xcc_id() { return (unsigned)__builtin_amdgcn_s_getreg((3 << 11) | 20) & 0xFu; }
#define XB_SPIN(cond, bar) do { unsigned _sp = 0; while (cond) { __builtin_amdgcn_s_sleep(1); \
    if ((++_sp & 255u) == 0u) { if (xb_ld(&(bar)[XB_TMO])) break; if (_sp > XB_SPIN_CAP) { atomicAdd(&(bar)[XB_TMO], 1u); break; } } } } while (0)
struct XcdBarrier { unsigned* bar; unsigned x; volatile LAS unsigned* st; };
__device__ __forceinline__ XcdBarrier xcd_barrier_post(unsigned* bar, volatile LAS unsigned* st) {
    XcdBarrier b; b.bar = bar; b.x = xb_xcc_id(); b.st = st;
    if (threadIdx.x == 0) (void)xb_add(&bar[XB_XCNT(b.x)], 1u);
    return b;
}
__device__ __forceinline__ void xcd_barrier_complete(unsigned* bar, unsigned x, unsigned& nloc, unsigned& nx) {
    const unsigned G = gridDim.x * gridDim.y * gridDim.z;
    unsigned sum, cnt, mine, sp = 0u;
    for (;;) {
        sum = 0u; cnt = 0u; mine = 0u;
#pragma unroll
        for (unsigned j = 0; j < 16; ++j) { const unsigned c = xb_ld(&bar[XB_XCNT(j)]); sum += c; cnt += (c > 0u) ? 1u : 0u; mine = (j == x) ? c : mine; }
        if (sum == G) break;
        __builtin_amdgcn_s_sleep(1);
        if ((++sp & 255u) == 0u) { if (xb_ld(&bar[XB_TMO])) break; if (sp > XB_SPIN_CAP) { atomicAdd(&bar[XB_TMO], 1u); break; } }
    }
    nloc = mine > 0u ? mine : 1u; nx = cnt > 0u ? cnt : 1u;
}
__device__ __forceinline__ void xcd_barrier(const XcdBarrier& b) {
    asm volatile("s_waitcnt vmcnt(0)" ::: "memory");
    __syncthreads();
    if (threadIdx.x == 0) {
        unsigned* bar = b.bar;
        __builtin_amdgcn_s_waitcnt(0);
        unsigned nloc = b.st[0], nx = b.st[1];
        if (nloc == 0u) { xcd_barrier_complete(bar, b.x, nloc, nx); b.st[0] = nloc; b.st[1] = nx; }
        const unsigned old = xb_add(&bar[XB_XSUB(b.x)], 1u);
        const unsigned gen = old / nloc;
        if (old + 1u == (gen + 1u) * nloc) {
            __builtin_amdgcn_fence(__ATOMIC_RELEASE, "agent");
            asm volatile("s_waitcnt vmcnt(0)" ::: "memory");
            const unsigned og = xb_add(&bar[XB_TOP], 1u);
            const unsigned tg = og / nx;
            if (og + 1u == (tg + 1u) * nx) xb_add(&bar[XB_TOPGEN], 1u);
            else XB_SPIN(xb_ld(&bar[XB_TOPGEN]) == tg, bar);
            __builtin_amdgcn_fence(__ATOMIC_ACQUIRE, "agent");
            xb_add(&bar[XB_XGEN(b.x)], 1u);
            asm volatile("s_waitcnt vmcnt(0)" ::: "memory");
        } else {
            XB_SPIN(xb_ld(&bar[XB_XGEN(b.x)]) == gen, bar);
            __builtin_amdgcn_fence(__ATOMIC_ACQUIRE, "agent");
            asm volatile("s_waitcnt vmcnt(0)" ::: "memory");
        }
    }
    __syncthreads();
}

enum { PH_PREP = 0, PH_A_GEMM, PH_A_CMP1, PH_A_CMP2, PH_A_NSA1, PH_A_NSA2, PH_A_OUT, PH_A_LN1, PH_A_F0, PH_A_F1, PH_A_LN2,
       PH_B_GEMM, PH_B_KMEAN, PH_B_ATT, PH_B_OUT, PH_B_LN1, PH_B_F0, PH_B_F1, PH_B_LN2, PH_COUNT };

struct GemmJob { pg8::Gemm g; int epi; void* O; const float* aux; const float* aux2; int ldc; int coff; };
__device__ __forceinline__ void set_job(GemmJob& J, const bf16_t* A, const bf16_t* Bt, int M, int N, int K, int lda, int epi, void* O, const float* aux, int ldc) {
    J.g.A = A; J.g.Bt = Bt; J.g.M = M; J.g.N = N; J.g.K = K; J.g.lda = lda; J.g.kstepA = 128; J.epi = epi; J.O = O; J.aux = aux; J.aux2 = nullptr; J.ldc = ldc; J.coff = 0;
}
__device__ __forceinline__ bool gemm_job(const Params& p, int ph, int j, GemmJob& J) {
    unsigned char* ws = p.ws;
    const bf16_t* XB = (const bf16_t*)(ws + WS_XB); const float* XF = (const float*)XB;
    unsigned char* big = ws + WS_BIG;
    const int layer = ph >= PH_B_GEMM ? 1 : 0;
    const bf16_t* Win = (const bf16_t*)(ws + WS_WFIN) + (size_t)layer * 2 * DFF * DM; const bf16_t* Wout = (const bf16_t*)(ws + WS_WFOUT) + (size_t)layer * DM * DFF;
    if (ph == PH_A_GEMM) {
        if (j == 0) { set_job(J, XB, (const bf16_t*)(ws + WS_WAIN), NTOK, AINP, DM, DM, 0, big + BIG_P, nullptr, AINP); return true; }
        return false;
    }
    if (ph == PH_A_CMP1) {
        if (j == 2) { set_job(J, (const bf16_t*)(ws + WS_MEMB), (const bf16_t*)(ws + WS_WMKV), BATCH * NMEM, 1024, DM, DM, 0, ws + WS_MKV, nullptr, 1024); J.coff = 32; return true; }
        if (j >= 3) return false;
        const bf16_t* P = (const bf16_t*)(big + BIG_P);
        set_job(J, P + (j ? P_VC : P_KC), (const bf16_t*)(ws + (j ? WS_WC1V : WS_WC1K)), 4096, 256, 2048, 16 * AINP, 1, (float*)(ws + WS_CMPH) + (size_t)j * 4096 * 256, (const float*)(ws + WS_CBIAS) + j * 256, 256);
        J.g.kstepA = AINP * 2; J.coff = j * 16; return true;
    }
    if (ph == PH_A_OUT) { if (j) return false; set_job(J, (const bf16_t*)(big + BIG_O0), (const bf16_t*)(ws + WS_WAOUT), NTOK, DM, DM, DM, 2, p.out, p.in[I_X], DM); return true; }
    if (ph == PH_B_OUT) { if (j) return false; set_job(J, (const bf16_t*)(big + BIG_O1), (const bf16_t*)(ws + WS_WBOUT), NTOK, DM, DM, DM, 4, p.out, XF, DM); return true; }
    if (ph == PH_B_GEMM) {
        if (j == 0) { set_job(J, XB, (const bf16_t*)(ws + WS_WSKV), NTOK, 1536, DM, DM, 0, big + BIG_KV, nullptr, 1536); return true; }
        if (j == 1) { set_job(J, XB, (const bf16_t*)(ws + WS_WBIN), NTOK, DM, DM, DM, 0, big + BIG_Q1, nullptr, DM); return true; }
        return false;
    }
    const int f = layer ? ph - PH_B_F0 : ph - PH_A_F0;
    if (j) return false;
    if (f == 0) { set_job(J, XB, Win, NTOK, 2 * DFF, DM, DM, 3, big + BIG_H, p.in[I_FCW] + (size_t)layer * 3 * DFF, DFF); J.aux2 = p.in[I_FCB] + (size_t)layer * DFF; return true; }
    if (f == 1) { set_job(J, (const bf16_t*)(big + BIG_H), Wout, NTOK, DM, DFF, DFF, 4, p.out, XF, DM); return true; }
    return false;
}
__device__ __forceinline__ bool is_gemm_phase(int ph) {
    return ph == PH_A_GEMM || ph == PH_A_CMP1 || ph == PH_A_OUT || ph == PH_B_OUT || ph == PH_B_GEMM || ph == PH_A_F0 || ph == PH_A_F1 || ph == PH_B_F0 || ph == PH_B_F1;
}
template <int JJ>
__device__ __forceinline__ void run_gemm_job(const Params& p, LAS unsigned char* lds, int ph) {
    GemmJob J;
    if (!gemm_job(p, ph, JJ, J)) return;
    pg8::StaticOrder S; S.init(J.g.M, J.g.N, (int)gridDim.x, (int)blockIdx.x - J.coff);
    if (J.epi == 0) { pg8::EpiBf16 E{(bf16_t*)J.O, J.ldc}; pg8::gemm_phase<pg8::EpiBf16>(lds, J.g, S, E); }
    else if (J.epi == 1) { pg8::EpiF32BiasGelu E{(float*)J.O, J.ldc, J.aux}; pg8::gemm_phase<pg8::EpiF32BiasGelu>(lds, J.g, S, E); }
    else if (J.epi == 3) { unsigned char* big = p.ws + WS_BIG; pg8::EpiConvGate E{(bf16_t*)J.O, J.aux, J.aux2, (float*)(big + BIG_TAILA), (float*)(big + BIG_HEADA), (float*)(big + BIG_HEADB)}; pg8::gemm_phase<pg8::EpiConvGate>(lds, J.g, S, E); }
    else if (J.epi == 2) { pg8::EpiResF32<true> E{J.aux, (float*)J.O, J.ldc, ALPHA}; pg8::gemm_phase<pg8::EpiResF32<true>>(lds, J.g, S, E); }
    else { pg8::EpiResF32<false> E{J.aux, (float*)J.O, J.ldc, ALPHA}; pg8::gemm_phase<pg8::EpiResF32<false>>(lds, J.g, S, E); }
}
__device__ __forceinline__ void run_gemm_phase(const Params& p, LAS unsigned char* lds, int ph) {
    run_gemm_job<0>(p, lds, ph); run_gemm_job<1>(p, lds, ph); run_gemm_job<2>(p, lds, ph);
}

__device__ __forceinline__ void run_phase(const Params& p, LAS unsigned char* lds, const Ctx& c, int ph) {
    unsigned char* ws = p.ws;
    bf16_t* XB = (bf16_t*)(ws + WS_XB);
    const int G = (int)gridDim.x, bid = (int)blockIdx.x;
    if (ph == PH_A_F1 || ph == PH_B_F1) {
        const int layer = ph == PH_B_F1 ? 1 : 0;
        pg8::StaticOrder S; S.init(NTOK, DM, G, bid); pg8::Unit u;
        for (int i = 0; S.next(i, u); ++i) ffn_fixup(c, ws + WS_BIG, p.in[I_FCW] + (size_t)layer * 3 * DFF, p.in[I_FCB] + (size_t)layer * DFF, u.pm);
        asm volatile("s_waitcnt vmcnt(0)" ::: "memory"); __syncthreads();
    }
    if (ph == PH_A_CMP1 && G >= LATE_FIRST_WG + 32 && bid >= LATE_FIRST_WG) {
        Ctx c2 = c; c2.gtid = (bid - LATE_FIRST_WG) * NTHR + c.tid; c2.gsz = (G - LATE_FIRST_WG) * NTHR;
        prep_late(p, c2);
    }
    if (is_gemm_phase(ph)) { run_gemm_phase(p, lds, ph); return; }
    switch (ph) {
    case PH_PREP: phase_prep(p, c); break;
    case PH_A_CMP2: phase_cmp2(p, c); break;
    case PH_A_NSA1: {
        for (int u = bid; u < BATCH * 8; u += G) nsa1_unit(p, lds, u >> 3, u & 7);
    } break;
    case PH_A_NSA2: {
        for (int u = bid; u < BATCH * (NH / 2) * 4; u += G) { const int b = u / 24, r = u % 24, hp = r >> 2, s = (r + u / G) & 3;
#pragma nounroll
            for (int k = 0; k < 2; ++k) nsa2_unit(p, lds, b, 2 * hp, k ? s : 7 - s); }
    } break;
    case PH_B_ATT: {
        for (int u = bid; u < BATCH * NH * 2; u += G) { const int b = u / 24, r = u % 24, h = r >> 1, s = r & 1;
#pragma nounroll
            for (int k = 0; k < 2; ++k) moba_unit(p, lds, b, h, k ? s : 3 - s); }
    } break;
    case PH_A_LN1: case PH_B_LN1: case PH_A_LN2: case PH_B_LN2: {
        const int layer = ph >= PH_B_GEMM ? 1 : 0; const bool second = (ph == PH_A_LN2 || ph == PH_B_LN2); const bool fin = (ph == PH_B_LN2);
        phase_ln(c, p.out, p.in[second ? I_LN2G : I_LN1G] + layer * DM, p.in[second ? I_LN2B : I_LN1B] + layer * DM, fin ? p.out : nullptr, fin ? nullptr : XB);
    } break;
    case PH_B_KMEAN: phase_kmean(c, (const bf16_t*)(ws + WS_BIG + BIG_KV), (float*)(ws + WS_KMEAN)); break;
    default: break;
    }
    if (ph == PH_A_NSA1 || ph == PH_B_ATT) {
        const bool la = (ph == PH_A_NSA1);
        const bf16_t* Q = (const bf16_t*)(ws + WS_BIG + (la ? BIG_P : BIG_Q1)); bf16_t* O = (bf16_t*)(ws + WS_BIG + (la ? BIG_O0 : BIG_O1));
        for (int u = bid; u < BATCH * 4 * 4; u += G) mem_unit(p, lds, Q, la ? AINP : DM, la ? P_QM : MAINW, O, la ? 0 : 512, u >> 4, (u >> 2) & 3, u & 3);
    }
}

template <int PH>
__device__ __forceinline__ void phase_seq(const Params& p, LAS unsigned char* lds, const Ctx& c, cg::grid_group& grid, const XcdBarrier& bar) {
    if constexpr (PH < PH_COUNT) {
        if (PH >= p.ph_lo && PH < p.ph_hi) {
            Ctx cc; { int t_ = threadIdx.x; asm volatile("" : "+v"(t_)); cc.tid = t_; cc.lane = t_ & 63; cc.wid = t_ >> 6; cc.gtid = blockIdx.x * NTHR + t_; cc.gsz = gridDim.x * NTHR; cc.gw = blockIdx.x * (NTHR / 64) + cc.wid; cc.ngw = gridDim.x * (NTHR / 64); }
            run_phase(p, lds, cc, PH); if (PH + 1 < p.ph_hi) { if (PH == 0) grid.sync(); else xcd_barrier(bar); } }
        phase_seq<PH + 1>(p, lds, c, grid, bar);
    }
}
__global__ void __launch_bounds__(NTHR) yoco_mega(Params p) {
    extern __shared__ __attribute__((aligned(16))) unsigned char lds_raw[];
    LAS unsigned char* lds = (LAS unsigned char*)lds_raw;
    cg::grid_group grid = cg::this_grid();
    Ctx c; c.tid = threadIdx.x; c.lane = c.tid & 63; c.wid = c.tid >> 6; c.gtid = blockIdx.x * NTHR + c.tid; c.gsz = gridDim.x * NTHR; c.gw = blockIdx.x * (NTHR / 64) + c.wid; c.ngw = gridDim.x * (NTHR / 64);
    if (c.tid < 130) ((LAS int*)(lds + att::L_BKT))[c.tid] = c.tid == 0 ? 0 : att::rel_bucket(c.tid - 1);
    if (c.tid < 2) ((LAS unsigned*)(lds + att::L_MISC))[c.tid] = 0u;
    __syncthreads();
    const XcdBarrier bar = xcd_barrier_post((unsigned*)(p.ws + WS_CTL), (volatile LAS unsigned*)(lds + att::L_MISC));
    phase_seq<0>(p, lds, c, grid, bar);
}

extern "C" void kernel_launch(void* const* d_in, const int* in_sizes, int n_in, void* d_out, int out_size, void* d_ws, size_t ws_size, hipStream_t stream) {
    static int grid = 0;
    if (grid == 0) {
        if (n_in != 24 || ws_size < WS_NEED) { fprintf(stderr, "kernel_launch: unexpected n_in %d / ws_size %zu (need %zu)\n", n_in, ws_size, (size_t)WS_NEED); grid = -1; return; }
        int dev = 0, cus = 0, per_cu = 0;
        hipGetDevice(&dev); hipDeviceGetAttribute(&cus, hipDeviceAttributeMultiprocessorCount, dev);
        if (hipFuncSetAttribute((const void*)yoco_mega, hipFuncAttributeMaxDynamicSharedMemorySize, LDS_BYTES) != hipSuccess) { fprintf(stderr, "kernel_launch: hipFuncSetAttribute failed\n"); grid = -1; return; }
        if (hipOccupancyMaxActiveBlocksPerMultiprocessor(&per_cu, (const void*)yoco_mega, NTHR, LDS_BYTES) != hipSuccess || per_cu < 1) { fprintf(stderr, "kernel_launch: occupancy query says %d\n", per_cu); per_cu = 1; }
        (void)hipGetLastError();
        grid = cus * per_cu;
        fprintf(stderr, "kernel_launch: grid %d (cus %d x %d)\n", grid, cus, per_cu);
    }
    if (grid < 0) return;
    if (hipMemsetAsync((char*)d_ws + WS_CTL, 0, CTL_BYTES, stream) != hipSuccess) { fprintf(stderr, "kernel_launch: memset failed\n"); return; }
    Params p{};
    for (int i = 0; i < 24; ++i) p.in[i] = (const float*)d_in[i];
    p.out = (float*)d_out; p.ws = (unsigned char*)d_ws; p.ph_lo = 0; p.ph_hi = PH_COUNT;
    void* args[] = {&p};
    hipError_t e = hipLaunchCooperativeKernel((const void*)yoco_mega, dim3(grid), dim3(NTHR), args, LDS_BYTES, stream);
    if (e != hipSuccess) fprintf(stderr, "kernel_launch: cooperative launch failed: %s (grid %d)\n", hipGetErrorString(e), grid);
}
```

```cpp
#include <hip/hip_runtime.h>
#include <hip/hip_cooperative_groups.h>
#include <cstdio>
#include <cstdint>
namespace cg = cooperative_groups;

#define LAS __attribute__((address_space(3)))
typedef unsigned short bf16_t;
typedef short bf16x8 __attribute__((ext_vector_type(8)));
typedef short s16x4 __attribute__((ext_vector_type(4)));
typedef float f32x4 __attribute__((ext_vector_type(4)));
typedef float f32x2 __attribute__((ext_vector_type(2)));
typedef float f32x16 __attribute__((ext_vector_type(16)));
typedef unsigned u32x4 __attribute__((ext_vector_type(4)));
typedef unsigned u32x2 __attribute__((ext_vector_type(2)));

__device__ __forceinline__ unsigned cvt_pk_bf16(float lo, float hi) { unsigned r; asm volatile("v_cvt_pk_bf16_f32 %0, %1, %2" : "=v"(r) : "v"(lo), "v"(hi)); return r; }
__device__ __forceinline__ float bf2f(unsigned short b) { return __uint_as_float(((unsigned)b) << 16); }
__device__ __forceinline__ float gelu_tanh(float x) {
    const float x2 = x * x;
    const float w = x * (-2.302208198f - 0.1029432397f * x2);
    return x * __builtin_amdgcn_rcpf(1.0f + __builtin_amdgcn_exp2f(w));
}

namespace pg8 {
constexpr int BM = 256, BK = 64, HALF = 128, HTB = HALF * BK * 2, STAGE_BYTES = 8 * HTB, NXCD = 8, WGM = 8;
__host__ __device__ __forceinline__ int lds_byte(int r, int c) { const int st = (r >> 4) * 2 + (c >> 5), rr = r & 15, cc = c & 31, ob = rr * 64 + cc * 2; return st * 1024 + (ob ^ (((ob >> 9) & 1) << 5)); }
__host__ __device__ __forceinline__ void stage_rc(int b, int& R, int& C) { const int st = b / 1024, sb = b % 1024, swz = sb ^ (((sb >> 9) & 1) << 5); R = (st >> 1) * 16 + swz / 64; C = (st & 1) * 32 + (swz % 64) / 2; }
__host__ __device__ __forceinline__ int perm32(int rho) { const int n = rho >> 4, i = rho & 15; return 8 * (i >> 2) + 4 * n + (i & 3); }

struct Unit { int pm, pn; };
struct Gemm { const bf16_t* A; const bf16_t* Bt; int M, N, K; int lda; int kstepA; };

struct StaticOrder {
    int nM, nN, nwg, G, c;
    __host__ __device__ void init(int M, int N, int G_, int c_) { nM = M / BM; nN = N / BM; nwg = nM * nN; G = G_; c = c_; }
    __host__ __device__ bool next(int i, Unit& u) const {
        if (c < 0) return false;
        const long L = (long)i * G + c; if (L >= nwg) return false;
        int wgid = (int)L; { const int q = nwg / NXCD, r = nwg % NXCD, xcd = wgid % NXCD, off = wgid / NXCD; wgid = (xcd < r ? xcd * (q + 1) : r * (q + 1) + (xcd - r) * q) + off; }
        const int nig = WGM * nN, gid = wgid / nig, fm = gid * WGM, gsz = (nM - fm) < WGM ? (nM - fm) : WGM;
        u.pm = fm + ((wgid % nig) % gsz); u.pn = (wgid % nig) / gsz; return true;
    }
};

struct EpiBf16 {
    static constexpr bool PERM = true;
    bf16_t* O; int ldc;
    __device__ __forceinline__ void operator()(const f32x4 (&acc)[2][2][4][2], const Unit& u, int wr, int wc, int fr, int fq) const {
        const int row0 = u.pm * BM + wr * 64 + fr; const int col0 = u.pn * BM + wc * 32 + 8 * fq;
#pragma unroll
        for (int ai = 0; ai < 2; ++ai)
#pragma unroll
            for (int m = 0; m < 4; ++m) { bf16_t* rowp = O + (size_t)(row0 + ai * HALF + m * 16) * ldc + col0;
#pragma unroll
                for (int bj = 0; bj < 2; ++bj) { const f32x4 v0 = acc[ai][bj][m][0], v1 = acc[ai][bj][m][1];
                    u32x4 w; w.x = cvt_pk_bf16(v0[0], v0[1]); w.y = cvt_pk_bf16(v0[2], v0[3]); w.z = cvt_pk_bf16(v1[0], v1[1]); w.w = cvt_pk_bf16(v1[2], v1[3]);
                    *(u32x4*)(rowp + bj * HALF) = w; } }
    }
};
struct EpiF32BiasGelu {
    static constexpr bool PERM = false;
    float* O; int ldc; const float* bias;
    __device__ __forceinline__ void operator()(const f32x4 (&acc)[2][2][4][2], const Unit& u, int wr, int wc, int fr, int fq) const {
        const int row0 = u.pm * BM + wr * 64 + fr; const int col0 = u.pn * BM + wc * 32 + 4 * fq;
#pragma unroll
        for (int bj = 0; bj < 2; ++bj)
#pragma unroll
            for (int n = 0; n < 2; ++n) { const f32x4 bv = *(const f32x4*)(bias + col0 + bj * HALF + n * 16);
#pragma unroll
                for (int ai = 0; ai < 2; ++ai)
#pragma unroll
                    for (int m = 0; m < 4; ++m) { f32x4 v = acc[ai][bj][m][n] + bv; v[0] = gelu_tanh(v[0]); v[1] = gelu_tanh(v[1]); v[2] = gelu_tanh(v[2]); v[3] = gelu_tanh(v[3]);
                        *(f32x4*)(O + (size_t)(row0 + ai * HALF + m * 16) * ldc + col0 + bj * HALF + n * 16) = v; } }
    }
};
template <int CTRL> __device__ __forceinline__ float dppf(float old, float src) {
    return __int_as_float(__builtin_amdgcn_update_dpp(__float_as_int(old), __float_as_int(src), CTRL, 0xf, 0xf, false));
}
struct EpiConvGate {
    static constexpr bool PERM = true;
    bf16_t* H; const float* cw; const float* cb; float* TAILA; float* HEADA; float* HEADB;
    __device__ __forceinline__ void operator()(const f32x4 (&acc)[2][2][4][2], const Unit& u, int wr, int wc, int fr, int fq) const {
        constexpr int DFF_ = 2816;
        const int cf0 = u.pn * 128 + wc * 32 + 8 * fq;
        f32x4 w0[2], w1[2], w2[2], cv[2];
#pragma unroll
        for (int n = 0; n < 2; ++n) { w0[n] = *(const f32x4*)(cw + cf0 + 4 * n); w1[n] = *(const f32x4*)(cw + DFF_ + cf0 + 4 * n); w2[n] = *(const f32x4*)(cw + 2 * DFF_ + cf0 + 4 * n); cv[n] = *(const f32x4*)(cb + cf0 + 4 * n); }
#pragma unroll
        for (int ai = 0; ai < 2; ++ai) {
            const int G = u.pm * 4 + ai * 2 + wr;
#pragma unroll
            for (int m = 0; m < 4; ++m) {
                const int row = u.pm * BM + ai * HALF + wr * 64 + m * 16 + fr;
                f32x4 hv[2];
#pragma unroll
                for (int n = 0; n < 2; ++n) {
                    const f32x4 a = acc[ai][0][m][n], b = acc[ai][1][m][n];
                    const f32x4 pv = acc[ai][0][m > 0 ? m - 1 : 0][n];
#pragma unroll
                    for (int j = 0; j < 4; ++j) {
                        const float am1 = dppf<0x111>(dppf<0x121>(0.f, pv[j]), a[j]);
                        const float am2 = dppf<0x112>(dppf<0x122>(0.f, pv[j]), a[j]);
                        const float pre = w0[n][j] * am2 + w1[n][j] * am1 + w2[n][j] * a[j] + cv[n][j];
                        hv[n][j] = gelu_tanh(pre) * b[j];
                    }
                }
                if (m > 0 || fr >= 2) {
                    u32x4 w; w.x = cvt_pk_bf16(hv[0][0], hv[0][1]); w.y = cvt_pk_bf16(hv[0][2], hv[0][3]); w.z = cvt_pk_bf16(hv[1][0], hv[1][1]); w.w = cvt_pk_bf16(hv[1][2], hv[1][3]);
                    *(u32x4*)(H + (size_t)row * DFF_ + cf0) = w;
                } else {
                    float* ha = HEADA + ((size_t)G * 2 + fr) * DFF_ + cf0; float* hb = HEADB + ((size_t)G * 2 + fr) * DFF_ + cf0;
                    *(f32x4*)ha = acc[ai][0][0][0]; *(f32x4*)(ha + 4) = acc[ai][0][0][1]; *(f32x4*)hb = acc[ai][1][0][0]; *(f32x4*)(hb + 4) = acc[ai][1][0][1];
                }
                if (m == 3 && fr >= 14) { float* ta = TAILA + ((size_t)G * 2 + (fr - 14)) * DFF_ + cf0; *(f32x4*)ta = acc[ai][0][3][0]; *(f32x4*)(ta + 4) = acc[ai][0][3][1]; }
            }
        }
    }
};
template <bool BASE_F32>
struct EpiResF32 {
    static constexpr bool PERM = false;
    const void* basev; float* O; int ldc; float alpha;
    __device__ __forceinline__ void operator()(const f32x4 (&acc)[2][2][4][2], const Unit& u, int wr, int wc, int fr, int fq) const {
        const int row0 = u.pm * BM + wr * 64 + fr; const int col0 = u.pn * BM + wc * 32 + 4 * fq;
#pragma unroll
        for (int ai = 0; ai < 2; ++ai)
#pragma unroll
            for (int m = 0; m < 4; ++m) { const size_t off = (size_t)(row0 + ai * HALF + m * 16) * ldc + col0;
#pragma unroll
                for (int bj = 0; bj < 2; ++bj)
#pragma unroll
                    for (int n = 0; n < 2; ++n) { f32x4 bs;
                        if (BASE_F32) bs = *(const f32x4*)((const float*)basev + off + bj * HALF + n * 16);
                        else { const u32x2 w = *(const u32x2*)((const bf16_t*)basev + off + bj * HALF + n * 16); bs[0] = __uint_as_float(w.x << 16); bs[1] = __uint_as_float(w.x & 0xffff0000u); bs[2] = __uint_as_float(w.y << 16); bs[3] = __uint_as_float(w.y & 0xffff0000u); }
                        *(f32x4*)(O + off + bj * HALF + n * 16) = bs * alpha + acc[ai][bj][m][n]; } }
    }
};

template <class Epi>
__device__ __forceinline__ void gemm_phase(LAS unsigned char* lds, const Gemm g, const StaticOrder& S, const Epi& E) {
    const int tid = threadIdx.x, wid = __builtin_amdgcn_readfirstlane(tid >> 6), lane = tid & 63, wr = wid >> 2, wc = wid & 3, fr = lane & 15, fq = lane >> 4;
    const int K = g.K, nt = K / BK;
    unsigned voffA[2], voffB[2];
#pragma unroll
    for (int i = 0; i < 2; ++i) { int R, C; stage_rc(tid * 16 + i * 8192, R, C); const int Rb = Epi::PERM ? ((R & ~31) + perm32(R & 31)) : R;
        voffA[i] = (unsigned)(R * g.lda + C) * 2u; voffB[i] = (unsigned)(Rb * K + C) * 2u; }
    const size_t kstepA = (size_t)g.kstepA, kstepB = (size_t)(BK * 2);
    const size_t hstepA = (size_t)HALF * g.lda * 2, hstepB = (size_t)HALF * K * 2;
    const size_t tstepA = 2 * hstepA, tstepB = 2 * hstepB;
    const unsigned ldsw = (unsigned)wid * 1024u;
    const int aoff = lds_byte(wr * 64 + fr, fq * 8), boff = lds_byte(wc * 32 + fr, fq * 8);
#define PG8_SA(b, h) (((b) * 2 + (h)) * HTB)
#define PG8_SB(b, h) ((4 + (b) * 2 + (h)) * HTB)
#define PG8_STAGE(bufoff, gbase, voff) do { _Pragma("unroll") for (int _i = 0; _i < 2; ++_i) \
        __builtin_amdgcn_global_load_lds((const unsigned*)((const char*)(gbase) + (voff)[_i]), (LAS unsigned*)(lds + (bufoff) + ldsw + _i * 8192), 16, 0, 0); } while (0)
#define PG8_LDA(dst, b, h) do { _Pragma("unroll") for (int m = 0; m < 4; ++m) _Pragma("unroll") for (int k = 0; k < 2; ++k) dst[m][k] = *(const LAS bf16x8*)(lds + PG8_SA(b, h) + aoff + m * 2048 + k * 1024); } while (0)
#define PG8_LDB(dst, b, h) do { _Pragma("unroll") for (int n = 0; n < 2; ++n) _Pragma("unroll") for (int k = 0; k < 2; ++k) dst[n][k] = *(const LAS bf16x8*)(lds + PG8_SB(b, h) + boff + n * 2048 + k * 1024); } while (0)
#define PG8_MMA(ai, bj, At, Bt) do { __builtin_amdgcn_s_setprio(1); _Pragma("unroll") for (int m = 0; m < 4; ++m) _Pragma("unroll") for (int n = 0; n < 2; ++n) _Pragma("unroll") for (int k = 0; k < 2; ++k) \
        acc[ai][bj][m][n] = __builtin_amdgcn_mfma_f32_16x16x32_bf16(Bt[n][k], At[m][k], acc[ai][bj][m][n], 0, 0, 0); __builtin_amdgcn_s_setprio(0); } while (0)
#define PG8_WAIT_V(n) asm volatile("s_waitcnt vmcnt(" #n ")" ::: "memory")
#define PG8_WAIT_L(n) asm volatile("s_waitcnt lgkmcnt(" #n ")" ::: "memory")
#define PG8_BAR __builtin_amdgcn_s_barrier()
#define PG8_SCHED __builtin_amdgcn_sched_barrier(0)
    Unit cur, nxt; int ui = 0;
    if (!S.next(0, cur)) return;
    f32x4 acc[2][2][4][2];
#pragma unroll
    for (int a = 0; a < 2; ++a)
#pragma unroll
        for (int b = 0; b < 2; ++b)
#pragma unroll
            for (int m = 0; m < 4; ++m)
#pragma unroll
                for (int n = 0; n < 2; ++n) acc[a][b][m][n] = (f32x4){0.f, 0.f, 0.f, 0.f};
    bf16x8 At[4][2], B0[2][2], B1[2][2];
    const char* cA = (const char*)g.A + (size_t)cur.pm * tstepA; const char* cB = (const char*)g.Bt + (size_t)cur.pn * tstepB;
    PG8_STAGE(PG8_SB(0, 0), cB, voffB); PG8_STAGE(PG8_SB(0, 1), cB + hstepB, voffB); PG8_STAGE(PG8_SA(0, 0), cA, voffA); PG8_STAGE(PG8_SA(0, 1), cA + hstepA, voffA);
    if (wr == 1) PG8_BAR;
    PG8_WAIT_V(2); PG8_BAR;
    PG8_STAGE(PG8_SB(1, 0), cB + kstepB, voffB); PG8_STAGE(PG8_SA(1, 0), cA + kstepA, voffA); PG8_STAGE(PG8_SB(1, 1), cB + hstepB + kstepB, voffB);
    PG8_WAIT_V(6); PG8_BAR;
    for (;;) {
        const bool has_next = S.next(ui + 1, nxt);
        const char* nA = has_next ? (const char*)g.A + (size_t)nxt.pm * tstepA : cA; const char* nB = has_next ? (const char*)g.Bt + (size_t)nxt.pn * tstepB : cB;
        for (int t = 0; t < nt; t += 2) {
            const bool last = (t == nt - 2);
            const char* a1 = cA + (size_t)(t + 1) * kstepA;
            const char* a2 = last ? nA : cA + (size_t)(t + 2) * kstepA; const char* b2 = last ? nB : cB + (size_t)(t + 2) * kstepB;
            const char* a3 = a2 + kstepA; const char* b3 = b2 + kstepB;
            PG8_LDB(B0, 0, 0); PG8_LDB(B1, 0, 1); PG8_SCHED; PG8_LDA(At, 0, 0); PG8_STAGE(PG8_SA(1, 1), a1 + hstepA, voffA);
            PG8_WAIT_V(8); PG8_WAIT_L(0); PG8_BAR; PG8_MMA(0, 0, At, B0); PG8_MMA(0, 1, At, B1); PG8_BAR; PG8_SCHED;
            PG8_LDA(At, 0, 1); PG8_STAGE(PG8_SB(0, 0), b2, voffB); PG8_STAGE(PG8_SB(0, 1), b2 + hstepB, voffB); PG8_STAGE(PG8_SA(0, 0), a2, voffA);
            PG8_WAIT_V(8); PG8_WAIT_L(0); PG8_BAR; PG8_MMA(1, 0, At, B0); PG8_MMA(1, 1, At, B1); PG8_BAR; PG8_SCHED;
            PG8_LDB(B0, 1, 0); PG8_LDB(B1, 1, 1); PG8_SCHED; PG8_LDA(At, 1, 0); PG8_STAGE(PG8_SA(0, 1), a2 + hstepA, voffA);
            PG8_WAIT_V(8); PG8_WAIT_L(0); PG8_BAR; PG8_MMA(0, 0, At, B0); PG8_MMA(0, 1, At, B1); PG8_BAR; PG8_SCHED;
            PG8_LDA(At, 1, 1); PG8_STAGE(PG8_SB(1, 0), b3, voffB); PG8_STAGE(PG8_SB(1, 1), b3 + hstepB, voffB); PG8_STAGE(PG8_SA(1, 0), a3, voffA);
            PG8_WAIT_V(8); PG8_WAIT_L(0); PG8_BAR; PG8_MMA(1, 0, At, B0); PG8_MMA(1, 1, At, B1); PG8_BAR; PG8_SCHED;
        }
        if (wr == 0) PG8_BAR;
        E(acc, cur, wr, wc, fr, fq);
        if (!has_next) break;
#pragma unroll
        for (int a = 0; a < 2; ++a)
#pragma unroll
            for (int b = 0; b < 2; ++b)
#pragma unroll
                for (int m = 0; m < 4; ++m)
#pragma unroll
                    for (int n = 0; n < 2; ++n) acc[a][b][m][n] = (f32x4){0.f, 0.f, 0.f, 0.f};
        cur = nxt; cA = nA; cB = nB; ++ui;
        if (wr == 1) PG8_BAR;
    }
    PG8_WAIT_V(0);
    PG8_BAR;
#undef PG8_SA
#undef PG8_SB
#undef PG8_STAGE
#undef PG8_LDA
#undef PG8_LDB
#undef PG8_MMA
#undef PG8_WAIT_V
#undef PG8_WAIT_L
#undef PG8_BAR
#undef PG8_SCHED
}
}

constexpr int BATCH = 32, SEQ = 2048, DM = 1024, NTOK = BATCH * SEQ, NMEM = 256, NH = 12, HD = 64, MAINW = 768;
constexpr int AIN = 1444, AINP = 1536, DFF = 2816, NCMP = 127;
constexpr int HALF_TOK = NTOK / 2;
constexpr float ALPHA = 1.4142135623730951f;
constexpr float LN_EPS = 1e-5f;
constexpr int P_Q = 0, P_KC = 768, P_VC = 832, P_KS = 896, P_VS = 960, P_KW = 1024, P_VW = 1088, P_QM = 1152, P_G = 1408;
constexpr size_t MiB = 1u << 20;
constexpr size_t WS_WAIN = 0 * MiB, WS_WAMKV = 3 * MiB, WS_WAOUT = 4 * MiB, WS_WSKV = 6 * MiB, WS_WBIN = 9 * MiB, WS_WBMKV = 11 * MiB, WS_WBOUT = 12 * MiB;
constexpr size_t WS_WFIN = 14 * MiB  , WS_WFOUT = 36 * MiB  , WS_WC1K = 47 * MiB, WS_WC1V = 48 * MiB, WS_WMKV = 49 * MiB  ;
constexpr size_t WS_CTL = 51 * MiB, CTL_BYTES = 16384;
constexpr size_t WS_MEMB = 52 * MiB, WS_MKV = 68 * MiB  , WS_CMPH = 84 * MiB, WS_KCMP = 92 * MiB, WS_VCMP = 93 * MiB, WS_CBIAS = 94 * MiB, WS_SEL = 94 * MiB + 65536, WS_KMEAN = 95 * MiB;
constexpr size_t WS_XB = 96 * MiB, WS_BIG = 226 * MiB;
constexpr size_t BIG_P = 0, BIG_O0 = 193 * MiB, BIG_H = 0, BIG_TAILA = 352 * MiB, BIG_HEADA = 374 * MiB, BIG_HEADB = 396 * MiB, BIG_KV = 0, BIG_Q1 = 193 * MiB, BIG_O1 = 321 * MiB;
constexpr size_t WS_NEED = WS_BIG + 449 * MiB;

constexpr int LDS_BYTES = 147456;
constexpr int NTHR = 512;

struct Params {
    const float* in[24];
    float* out;
    unsigned char* ws;
    int ph_lo, ph_hi;
};
enum { I_X = 0, I_MEM, I_RELB, I_AWIN, I_PEK, I_W1K, I_W2K, I_PEV, I_W1V, I_W2V, I_AWMKV, I_AWOUT, I_SWKV, I_BWIN, I_BWMKV, I_BWOUT, I_LN1G, I_LN1B, I_LN2G, I_LN2B, I_FWIN, I_FCW, I_FCB, I_FWOUT };

namespace att {
constexpr int ROWB = 144, TILEB = 64 * ROWB, VROWB = 192, VTILEB = 64 * VROWB;
constexpr float NEG = -1e30f;
constexpr float LOG2E = 1.4426950408889634f;
constexpr float SC2 = 0.125f * LOG2E;
typedef short v4i16_t __attribute__((ext_vector_type(4)));

__device__ __forceinline__ f32x16 zero16() { f32x16 z;
#pragma unroll
    for (int i = 0; i < 16; ++i) z[i] = 0.f; return z; }

__device__ __forceinline__ void qk_tile(f32x16& p0, f32x16& p1, const LAS unsigned char* Kt, const bf16x8 (&qr)[4], int r32, int hi, float cinit = 0.f) {
    const LAS unsigned char* kb = Kt + r32 * ROWB + hi * 16;
#pragma unroll
    for (int i = 0; i < 16; ++i) { p0[i] = cinit; p1[i] = cinit; }
#pragma unroll
    for (int d0 = 0; d0 < 4; ++d0) {
        const bf16x8 k0 = *(const LAS bf16x8*)(kb + d0 * 32);
        const bf16x8 k1 = *(const LAS bf16x8*)(kb + 32 * ROWB + d0 * 32);
        p0 = __builtin_amdgcn_mfma_f32_32x32x16_bf16(k0, qr[d0], p0, 0, 0, 0);
        p1 = __builtin_amdgcn_mfma_f32_32x32x16_bf16(k1, qr[d0], p1, 0, 0, 0);
    }
}
__device__ __forceinline__ s16x4 vtr(const LAS unsigned char* p) { return __builtin_bit_cast(s16x4, __builtin_amdgcn_ds_read_tr16_b64_v4i16((LAS v4i16_t*)p)); }
__device__ __forceinline__ void pv_tile(f32x16& o0, f32x16& o1, const LAS unsigned char* Vt, const f32x16& p0, const f32x16& p1, int lane) {
    const int hi = lane >> 5, g1 = (lane >> 4) & 1, i = lane & 15, q_ = i >> 2, p_ = i & 3;
    const LAS unsigned char* vb = Vt + (4 * hi + q_) * VROWB + (16 * g1 + 4 * p_) * 2;
#pragma unroll
    for (int s = 0; s < 4; ++s) {
        u32x4 w;
        if (s < 2) { const int b = 8 * (s & 1); w.x = cvt_pk_bf16(p0[b + 0], p0[b + 1]); w.y = cvt_pk_bf16(p0[b + 2], p0[b + 3]); w.z = cvt_pk_bf16(p0[b + 4], p0[b + 5]); w.w = cvt_pk_bf16(p0[b + 6], p0[b + 7]); }
        else       { const int b = 8 * (s & 1); w.x = cvt_pk_bf16(p1[b + 0], p1[b + 1]); w.y = cvt_pk_bf16(p1[b + 2], p1[b + 3]); w.z = cvt_pk_bf16(p1[b + 4], p1[b + 5]); w.w = cvt_pk_bf16(p1[b + 6], p1[b + 7]); }
        const bf16x8 pf = __builtin_bit_cast(bf16x8, w);
#pragma unroll
        for (int dh = 0; dh < 2; ++dh) {
            const s16x4 lo = vtr(vb + (16 * s) * VROWB + dh * 64);
            const s16x4 h4 = vtr(vb + (16 * s + 8) * VROWB + dh * 64);
            const bf16x8 vf = (bf16x8){lo[0], lo[1], lo[2], lo[3], h4[0], h4[1], h4[2], h4[3]};
            if (dh == 0) o0 = __builtin_amdgcn_mfma_f32_32x32x16_bf16(vf, pf, o0, 0, 0, 0);
            else         o1 = __builtin_amdgcn_mfma_f32_32x32x16_bf16(vf, pf, o1, 0, 0, 0);
        }
    }
}
struct Acc { float m, l; f32x16 o0, o1; };
__device__ __forceinline__ void acc_init(Acc& A) { A.m = NEG; A.l = 0.f; A.o0 = zero16(); A.o1 = zero16(); }
constexpr float THR_RAW = 8.0f / SC2;
__device__ __forceinline__ void sm_update(Acc& A, f32x16& p0, f32x16& p1) {
    float m0 = fmaxf(p0[0], p1[0]), m1 = fmaxf(p0[1], p1[1]);
#pragma unroll
    for (int r = 2; r < 16; r += 2) { m0 = fmaxf(fmaxf(m0, p0[r]), p1[r]); m1 = fmaxf(fmaxf(m1, p0[r + 1]), p1[r + 1]); }
    float mx = fmaxf(m0, m1);
    mx = fmaxf(mx, __shfl_xor(mx, 32));
    if (__any(mx > A.m + THR_RAW)) {
        const float mn = fmaxf(A.m, mx);
        const float alpha = __builtin_amdgcn_exp2f((A.m - (mn < -5e29f ? 0.f : mn)) * SC2);
        A.l *= alpha; A.m = mn;
#pragma unroll
        for (int r = 0; r < 16; ++r) { A.o0[r] *= alpha; A.o1[r] *= alpha; }
    }
    const float msc = (A.m < -5e29f ? 0.f : A.m) * SC2;
    float rs0 = 0.f, rs1 = 0.f;
#pragma unroll
    for (int r = 0; r < 16; ++r) {
        const float e0 = __builtin_amdgcn_exp2f(p0[r] * SC2 - msc);
        const float e1 = __builtin_amdgcn_exp2f(p1[r] * SC2 - msc);
        p0[r] = e0; p1[r] = e1; rs0 += e0; rs1 += e1;
    }
    A.l += rs0 + rs1;
}
__device__ __forceinline__ float rowmax32(const f32x16& p0, const f32x16& p1) {
    float m0 = fmaxf(p0[0], p1[0]), m1 = fmaxf(p0[1], p1[1]), m2 = fmaxf(p0[2], p1[2]), m3 = fmaxf(p0[3], p1[3]);
#pragma unroll
    for (int r = 4; r < 16; r += 4) { m0 = fmaxf(fmaxf(m0, p0[r]), p1[r]); m1 = fmaxf(fmaxf(m1, p0[r + 1]), p1[r + 1]); m2 = fmaxf(fmaxf(m2, p0[r + 2]), p1[r + 2]); m3 = fmaxf(fmaxf(m3, p0[r + 3]), p1[r + 3]); }
    return fmaxf(fmaxf(m0, m1), fmaxf(m2, m3));
}
__device__ __forceinline__ void sm_update2(Acc& A, Acc& B, f32x16& a0, f32x16& a1, f32x16& b0, f32x16& b1) {
    float mxa = rowmax32(a0, a1), mxb = rowmax32(b0, b1);
    mxa = fmaxf(mxa, __shfl_xor(mxa, 32)); mxb = fmaxf(mxb, __shfl_xor(mxb, 32));
    if (__any((mxa > A.m + THR_RAW) || (mxb > B.m + THR_RAW))) {
        const float mna = fmaxf(A.m, mxa), mnb = fmaxf(B.m, mxb);
        const float ala = __builtin_amdgcn_exp2f((A.m - (mna < -5e29f ? 0.f : mna)) * SC2), alb = __builtin_amdgcn_exp2f((B.m - (mnb < -5e29f ? 0.f : mnb)) * SC2);
        A.l *= ala; A.m = mna; B.l *= alb; B.m = mnb;
#pragma unroll
        for (int r = 0; r < 16; ++r) { A.o0[r] *= ala; B.o0[r] *= alb; A.o1[r] *= ala; B.o1[r] *= alb; }
    }
    const float msa = (A.m < -5e29f ? 0.f : A.m) * SC2, msb = (B.m < -5e29f ? 0.f : B.m) * SC2;
    float ra0 = 0.f, ra1 = 0.f, rb0 = 0.f, rb1 = 0.f;
#pragma unroll
    for (int r = 0; r < 16; ++r) {
        const float ea0 = __builtin_amdgcn_exp2f(a0[r] * SC2 - msa), eb0 = __builtin_amdgcn_exp2f(b0[r] * SC2 - msb);
        const float ea1 = __builtin_amdgcn_exp2f(a1[r] * SC2 - msa), eb1 = __builtin_amdgcn_exp2f(b1[r] * SC2 - msb);
        a0[r] = ea0; b0[r] = eb0; a1[r] = ea1; b1[r] = eb1; ra0 += ea0; rb0 += eb0; ra1 += ea1; rb1 += eb1;
    }
    A.l += ra0 + ra1; B.l += rb0 + rb1;
}
__device__ __forceinline__ float acc_inv(const Acc& A) { const float lt = A.l + __shfl_xor(A.l, 32); return 1.0f / fmaxf(lt, 1e-30f); }

__device__ __forceinline__ void apply_general(f32x16& p0, f32x16& p1, int dist0, const LAS float* tab, bool allow, int W) {
    const unsigned We = allow ? (unsigned)W : 0u;
#pragma unroll
    for (int r = 0; r < 16; ++r) {
        const int d_0 = dist0 - ((r & 3) + 8 * (r >> 2)), d_1 = d_0 - 32;
        const int i0 = ((unsigned)d_0 < We) ? min(d_0, 128) + 1 : 0, i1 = ((unsigned)d_1 < We) ? min(d_1, 128) + 1 : 0;
        p0[r] += tab[i0];
        p1[r] += tab[i1];
        if ((r & 3) == 3) __builtin_amdgcn_sched_barrier(0);
    }
}
__device__ __forceinline__ int rel_bucket(int n) {
    if (n < 16) return n;
    const float v = logf((float)n / 16.0f) / 2.0794415416798357f * 16.0f;
    int l = 16 + (int)v; return l < 31 ? l : 31;
}
__device__ __forceinline__ u32x4 tile_ld(const bf16_t* base, long ld, int row0, int rmin, int rmax, int tid) {
    int r = row0 + (tid >> 3); r = r < rmin ? rmin : (r > rmax ? rmax : r);
    return *(const u32x4*)(base + (long)r * ld + (tid & 7) * 8);
}
__device__ __forceinline__ void tile_st(LAS unsigned char* buf, u32x4 v, int tid) { *(LAS u32x4*)(buf + (tid >> 3) * ROWB + (tid & 7) * 16) = v; }
__device__ __forceinline__ void tile_stv(LAS unsigned char* buf, u32x4 v, int tid) { *(LAS u32x4*)(buf + (tid >> 3) * VROWB + (tid & 7) * 16) = v; }
__device__ __forceinline__ void load_q(bf16x8 (&qr)[4], const bf16_t* qrow, int hi) {
#pragma unroll
    for (int d0 = 0; d0 < 4; ++d0) qr[d0] = *(const bf16x8*)(qrow + d0 * 16 + hi * 8);
}
__device__ __forceinline__ void store_o(bf16_t* orow, const f32x16& o0, const f32x16& o1, int hi) {
#pragma unroll
    for (int g = 0; g < 4; ++g) {
        u32x2 w0, w1; w0.x = cvt_pk_bf16(o0[4 * g], o0[4 * g + 1]); w0.y = cvt_pk_bf16(o0[4 * g + 2], o0[4 * g + 3]);
        w1.x = cvt_pk_bf16(o1[4 * g], o1[4 * g + 1]); w1.y = cvt_pk_bf16(o1[4 * g + 2], o1[4 * g + 3]);
        *(u32x2*)(orow + 8 * g + 4 * hi) = w0; *(u32x2*)(orow + 32 + 8 * g + 4 * hi) = w1;
    }
}
__device__ __forceinline__ void add_prev_o(const bf16_t* orow, f32x16& o0, f32x16& o1, int hi) {
#pragma unroll
    for (int g = 0; g < 4; ++g) {
        const u32x2 w0 = *(const u32x2*)(orow + 8 * g + 4 * hi), w1 = *(const u32x2*)(orow + 32 + 8 * g + 4 * hi);
        o0[4 * g] += __uint_as_float(w0.x << 16); o0[4 * g + 1] += __uint_as_float(w0.x & 0xffff0000u); o0[4 * g + 2] += __uint_as_float(w0.y << 16); o0[4 * g + 3] += __uint_as_float(w0.y & 0xffff0000u);
        o1[4 * g] += __uint_as_float(w1.x << 16); o1[4 * g + 1] += __uint_as_float(w1.x & 0xffff0000u); o1[4 * g + 2] += __uint_as_float(w1.y << 16); o1[4 * g + 3] += __uint_as_float(w1.y & 0xffff0000u);
    }
}
__device__ __forceinline__ float sigmoidf(float x) { return 1.0f / (1.0f + __expf(-x)); }

constexpr int L_K0 = 0, L_K1 = TILEB, L_V0 = 2 * TILEB, L_V1 = 2 * TILEB + VTILEB, L_TAB = 2 * TILEB + 2 * VTILEB  , L_SIMP = 53248  , L_Q = 53248  , L_BKT = 131072  , L_MISC = 131072 + 1024  ;

__device__ __forceinline__ const LAS unsigned char* park_q(LAS unsigned char* lds, const bf16_t* q0, const bf16_t* q1, int wid, int lane, int hi) {
    LAS unsigned char* qp = lds + L_Q + wid * 8192 + lane * 16;
#pragma unroll
    for (int d0 = 0; d0 < 4; ++d0) { *(LAS bf16x8*)(qp + d0 * 1024) = *(const bf16x8*)(q0 + d0 * 16 + hi * 8); *(LAS bf16x8*)(qp + 4096 + d0 * 1024) = *(const bf16x8*)(q1 + d0 * 16 + hi * 8); }
    return qp;
}
__device__ __forceinline__ void fill_tab(LAS unsigned char* lds, const float* relb, int h0, int nh, int tid) {
    LAS float* tab = (LAS float*)(lds + L_TAB);
    const LAS int* bkt = (const LAS int*)(lds + L_BKT);
    for (int i = tid; i < nh * 130; i += NTHR) { const int hh = i / 130, d = i % 130; tab[hh * 132 + d] = d == 0 ? NEG : relb[bkt[d] * NH + h0 + hh] * 8.0f; }
}

template <int MODE>
struct TileInfo { bool want, near, allow; float cinit; };
template <int MODE>
__device__ __forceinline__ TileInfo<MODE> classify(int kt, int tw, unsigned selmask, int blkshift, int W, float b129) {
    TileInfo<MODE> ti; const int kbase = kt * 64;
    if (MODE == 0) { ti.want = true; ti.near = false; ti.allow = true; ti.cinit = 0.f; }
    else if (MODE == 1) { ti.allow = (selmask >> (kt >> blkshift)) & 1u; ti.want = (kbase <= tw + 31) && __any(ti.allow); ti.near = !(tw - (kbase + 63) >= 128); ti.cinit = ti.near ? 0.f : (ti.allow ? b129 : NEG); }
    else { ti.allow = true; ti.want = (kbase <= tw + 31) && (kbase + 63 >= tw - (W - 1)); ti.near = !((tw - (kbase + 63) >= 128) && (tw + 31 - kbase < W)); ti.cinit = ti.near ? 0.f : b129; }
    return ti;
}
template <int MODE, bool QREG>
__device__ __forceinline__ void seg2(Acc (&A)[2], LAS unsigned char* lds, const bf16_t* Kg, const bf16_t* Vg, long ld, int rmax, int lo, int hi_t,
                                     const LAS unsigned char* qp  , int t0  , int tw0, unsigned sel0, unsigned sel1, int blkshift, int W, const LAS float* tab, int tid) {
    const int lane = tid & 63, r32 = lane & 31, hi = lane >> 5;
    if (lo >= hi_t) return;
    {
        const u32x4 k0 = tile_ld(Kg, ld, lo * 64, 0, rmax, tid), v0 = tile_ld(Vg, ld, lo * 64, 0, rmax, tid);
        __syncthreads();
        tile_st(lds + L_K0, k0, tid); tile_stv(lds + L_V0, v0, tid);
        __syncthreads();
    }
    const float b129 = (MODE == 0) ? 0.f : tab[129];
    const int g1 = (lane >> 4) & 1, i16 = lane & 15, q_ = i16 >> 2, p_ = i16 & 3;
    bf16x8 qra[4], qrb[4];
    if (QREG) {
#pragma unroll
        for (int d0 = 0; d0 < 4; ++d0) { qra[d0] = *(const LAS bf16x8*)(qp + d0 * 1024); qrb[d0] = *(const LAS bf16x8*)(qp + 4096 + d0 * 1024); }
    }
    int cur = 0;
    for (int kt = lo; kt < hi_t; ++kt) {
        const bool more1 = kt + 1 < hi_t;
        u32x4 kreg, vreg;
        if (more1) { kreg = tile_ld(Kg, ld, (kt + 1) * 64, 0, rmax, tid); vreg = tile_ld(Vg, ld, (kt + 1) * 64, 0, rmax, tid); }
        TileInfo<MODE> ta = classify<MODE>(kt, tw0, sel0, blkshift, W, b129), tb = classify<MODE>(kt, tw0 + 32, sel1, blkshift, W, b129);
        if (ta.want || tb.want) {
            if (!ta.want) { ta.cinit = NEG; ta.near = false; }
            if (!tb.want) { tb.cinit = NEG; tb.near = false; }
            const LAS unsigned char* Kt = lds + (cur ? L_K1 : L_K0); const LAS unsigned char* Vt = lds + (cur ? L_V1 : L_V0);
            f32x16 a0, a1, b0, b1;
#pragma unroll
            for (int i = 0; i < 16; ++i) { a0[i] = ta.cinit; a1[i] = ta.cinit; b0[i] = tb.cinit; b1[i] = tb.cinit; }
            const LAS unsigned char* kb = Kt + r32 * ROWB + hi * 16;
#pragma unroll
            for (int d0 = 0; d0 < 4; ++d0) {
                const bf16x8 k0 = *(const LAS bf16x8*)(kb + d0 * 32);
                const bf16x8 k1 = *(const LAS bf16x8*)(kb + 32 * ROWB + d0 * 32);
                const bf16x8 qa = QREG ? qra[d0] : *(const LAS bf16x8*)(qp + d0 * 1024), qb_ = QREG ? qrb[d0] : *(const LAS bf16x8*)(qp + 4096 + d0 * 1024);
                a0 = __builtin_amdgcn_mfma_f32_32x32x16_bf16(k0, qa, a0, 0, 0, 0);
                b0 = __builtin_amdgcn_mfma_f32_32x32x16_bf16(k0, qb_, b0, 0, 0, 0);
                a1 = __builtin_amdgcn_mfma_f32_32x32x16_bf16(k1, qa, a1, 0, 0, 0);
                b1 = __builtin_amdgcn_mfma_f32_32x32x16_bf16(k1, qb_, b1, 0, 0, 0);
            }
            if (MODE != 0) {
                if (ta.near) apply_general(a0, a1, t0 - kt * 64 - 4 * hi, tab, ta.allow, W);
                if (tb.near) apply_general(b0, b1, t0 + 32 - kt * 64 - 4 * hi, tab, tb.allow, W);
            }
            sm_update2(A[0], A[1], a0, a1, b0, b1);
            const LAS unsigned char* vb = Vt + (4 * hi + q_) * VROWB + (16 * g1 + 4 * p_) * 2;
#pragma unroll
            for (int s = 0; s < 4; ++s) {
                const int bs = 8 * (s & 1);
                u32x4 wa, wb;
                if (s < 2) { wa.x = cvt_pk_bf16(a0[bs + 0], a0[bs + 1]); wa.y = cvt_pk_bf16(a0[bs + 2], a0[bs + 3]); wa.z = cvt_pk_bf16(a0[bs + 4], a0[bs + 5]); wa.w = cvt_pk_bf16(a0[bs + 6], a0[bs + 7]);
                             wb.x = cvt_pk_bf16(b0[bs + 0], b0[bs + 1]); wb.y = cvt_pk_bf16(b0[bs + 2], b0[bs + 3]); wb.z = cvt_pk_bf16(b0[bs + 4], b0[bs + 5]); wb.w = cvt_pk_bf16(b0[bs + 6], b0[bs + 7]); }
                else       { wa.x = cvt_pk_bf16(a1[bs + 0], a1[bs + 1]); wa.y = cvt_pk_bf16(a1[bs + 2], a1[bs + 3]); wa.z = cvt_pk_bf16(a1[bs + 4], a1[bs + 5]); wa.w = cvt_pk_bf16(a1[bs + 6], a1[bs + 7]);
                             wb.x = cvt_pk_bf16(b1[bs + 0], b1[bs + 1]); wb.y = cvt_pk_bf16(b1[bs + 2], b1[bs + 3]); wb.z = cvt_pk_bf16(b1[bs + 4], b1[bs + 5]); wb.w = cvt_pk_bf16(b1[bs + 6], b1[bs + 7]); }
                const bf16x8 pfa = __builtin_bit_cast(bf16x8, wa), pfb = __builtin_bit_cast(bf16x8, wb);
#pragma unroll
                for (int dh = 0; dh < 2; ++dh) {
                    const s16x4 lo4 = vtr(vb + (16 * s) * VROWB + dh * 64);
                    const s16x4 h4 = vtr(vb + (16 * s + 8) * VROWB + dh * 64);
                    const bf16x8 vf = (bf16x8){lo4[0], lo4[1], lo4[2], lo4[3], h4[0], h4[1], h4[2], h4[3]};
                    if (dh == 0) { A[0].o0 = __builtin_amdgcn_mfma_f32_32x32x16_bf16(vf, pfa, A[0].o0, 0, 0, 0); A[1].o0 = __builtin_amdgcn_mfma_f32_32x32x16_bf16(vf, pfb, A[1].o0, 0, 0, 0); }
                    else         { A[0].o1 = __builtin_amdgcn_mfma_f32_32x32x16_bf16(vf, pfa, A[0].o1, 0, 0, 0); A[1].o1 = __builtin_amdgcn_mfma_f32_32x32x16_bf16(vf, pfb, A[1].o1, 0, 0, 0); }
                }
            }
        }
        if (more1) { tile_st(lds + (cur ? L_K0 : L_K1), kreg, tid); tile_stv(lds + (cur ? L_V0 : L_V1), vreg, tid); }
        __syncthreads();
        cur ^= 1;
    }
}
}

struct Ctx { int tid, lane, wid, gtid, gsz, gw, ngw; };

template <int MAP>
__device__ __forceinline__ void xpose_w(const Ctx& c, const float* W, int K, int N, bf16_t* WT, int Ndst, int dst_off = 0) {
    const int nk = K >> 6; const long total = (long)Ndst * nk;
    for (long i = c.gtid; i < total; i += c.gsz) {
        const int n = (int)(i % Ndst), kc = (int)(i / Ndst);
        int src = n;
        if (MAP == 1) { if (n >= 1152 && n < 1408) src = 1188 + (n - 1152); else if (n >= 1408 && n < 1444) src = 1152 + (n - 1408); else if (n >= 1444) src = -1; }
        else if (MAP == 2) { const int tl = n >> 8, wi = n & 255; src = wi < 128 ? tl * 128 + wi : 2816 + tl * 128 + (wi - 128); }
        else if (n >= N) src = -1;
        bf16_t* dst = WT + (size_t)(dst_off + n) * K + kc * 64;
        if (src < 0) {
#pragma unroll
            for (int q = 0; q < 8; ++q) *(u32x4*)(dst + q * 8) = (u32x4){0u, 0u, 0u, 0u};
        } else {
            const float* s = W + (size_t)(kc * 64) * N + src;
            float v[64];
#pragma unroll
            for (int k = 0; k < 64; ++k) v[k] = s[(size_t)k * N];
#pragma unroll
            for (int q = 0; q < 8; ++q) {
                u32x4 w; w.x = cvt_pk_bf16(v[8 * q], v[8 * q + 1]); w.y = cvt_pk_bf16(v[8 * q + 2], v[8 * q + 3]); w.z = cvt_pk_bf16(v[8 * q + 4], v[8 * q + 5]); w.w = cvt_pk_bf16(v[8 * q + 6], v[8 * q + 7]);
                *(u32x4*)(dst + q * 8) = w;
            }
        }
    }
}
__device__ __forceinline__ void cvt_rows(const Ctx& c, const float* X, bf16_t* XB, long nelem) {
    const long n8 = nelem >> 3;
    for (long i0 = c.gtid; i0 < n8; i0 += 4l * c.gsz) {
        f32x4 a[4], b[4];
#pragma unroll
        for (int u = 0; u < 4; ++u) { const long i = i0 + (long)u * c.gsz; if (i < n8) { a[u] = __builtin_nontemporal_load((const f32x4*)(X + i * 8)); b[u] = __builtin_nontemporal_load((const f32x4*)(X + i * 8 + 4)); } }
#pragma unroll
        for (int u = 0; u < 4; ++u) { const long i = i0 + (long)u * c.gsz; if (i < n8) {
            u32x4 w; w.x = cvt_pk_bf16(a[u][0], a[u][1]); w.y = cvt_pk_bf16(a[u][2], a[u][3]); w.z = cvt_pk_bf16(b[u][0], b[u][1]); w.w = cvt_pk_bf16(b[u][2], b[u][3]);
            *(u32x4*)(XB + i * 8) = w; } }
    }
}
__device__ __forceinline__ void prep_late(const Params& p, const Ctx& c) {
    unsigned char* ws = p.ws;
    xpose_w<0>(c, p.in[I_AWOUT], DM, DM, (bf16_t*)(ws + WS_WAOUT), DM);
    xpose_w<0>(c, p.in[I_SWKV], DM, 1536, (bf16_t*)(ws + WS_WSKV), 1536);
    xpose_w<0>(c, p.in[I_BWIN], DM, DM, (bf16_t*)(ws + WS_WBIN), DM);
    xpose_w<0>(c, p.in[I_BWOUT], DM, DM, (bf16_t*)(ws + WS_WBOUT), DM);
    for (int l = 0; l < 2; ++l) {
        xpose_w<2>(c, p.in[I_FWIN] + (size_t)l * DM * 2 * DFF, DM, 2 * DFF, (bf16_t*)(ws + WS_WFIN) + (size_t)l * 2 * DFF * DM, 2 * DFF);
        xpose_w<0>(c, p.in[I_FWOUT] + (size_t)l * DFF * DM, DFF, DM, (bf16_t*)(ws + WS_WFOUT) + (size_t)l * DM * DFF, DM);
    }
}
constexpr int LATE_FIRST_WG = 160;
__device__ __forceinline__ void phase_prep(const Params& p, const Ctx& c) {
    unsigned char* ws = p.ws;
    xpose_w<1>(c, p.in[I_AWIN], DM, AIN, (bf16_t*)(ws + WS_WAIN), AINP);
    xpose_w<0>(c, p.in[I_AWMKV], DM, 512, (bf16_t*)(ws + WS_WMKV), 512, 0);
    xpose_w<0>(c, p.in[I_BWMKV], DM, 512, (bf16_t*)(ws + WS_WMKV), 512, 512);
    xpose_w<0>(c, p.in[I_W1K], 2048, 256, (bf16_t*)(ws + WS_WC1K), 256);
    xpose_w<0>(c, p.in[I_W1V], 2048, 256, (bf16_t*)(ws + WS_WC1V), 256);
    if ((int)gridDim.x < LATE_FIRST_WG + 32) prep_late(p, c);
    cvt_rows(c, p.in[I_X], (bf16_t*)(ws + WS_XB), (long)NTOK * DM);
    cvt_rows(c, p.in[I_MEM], (bf16_t*)(ws + WS_MEMB), (long)BATCH * NMEM * DM);
    for (int o = c.gw; o < 512; o += c.ngw) {
        const int which = o >> 8, j = o & 255;
        const float* pe = p.in[which ? I_PEV : I_PEK]; const float* w1 = p.in[which ? I_W1V : I_W1K];
        float s = 0.f;
#pragma unroll 8
        for (int k = c.lane; k < 2048; k += 64) s += pe[k] * w1[(size_t)k * 256 + j];
#pragma unroll
        for (int sh = 1; sh < 64; sh <<= 1) s += __shfl_xor(s, sh);
        if (c.lane == 0) ((float*)(ws + WS_CBIAS))[which * 256 + j] = s;
    }
}
__device__ __forceinline__ void phase_cmp2(const Params& p, const Ctx& c) {
    unsigned char* ws = p.ws;
    for (int i = c.gtid; i < 2 * 4096 * 64; i += c.gsz) {
        const int which = i >> 18, m = (i >> 6) & 4095, d = i & 63;
        const float* hid = (const float*)(ws + WS_CMPH) + ((size_t)which * 4096 + m) * 256; const float* w2 = p.in[which ? I_W2V : I_W2K];
        float s = 0.f;
#pragma unroll 8
        for (int j = 0; j < 256; ++j) s += hid[j] * w2[j * 64 + d];
        if ((m & 127) == 127) s = 0.f;
        unsigned u = __float_as_uint(s); u = (u + 0x7fffu + ((u >> 16) & 1u)) >> 16;
        ((bf16_t*)(ws + (which ? WS_VCMP : WS_KCMP)))[(size_t)m * 64 + d] = (bf16_t)u;
    }
}
__device__ __forceinline__ void phase_ln(const Ctx& c, const float* y, const float* g, const float* bta, float* xf, bf16_t* xb) {
    for (int row = c.gw; row < NTOK; row += c.ngw) {
        const float* yr = y + (size_t)row * DM + c.lane * 4;
        f32x4 v[4]; float s = 0.f;
#pragma unroll
        for (int j = 0; j < 4; ++j) { v[j] = *(const f32x4*)(yr + 256 * j); s += (v[j][0] + v[j][1]) + (v[j][2] + v[j][3]); }
#pragma unroll
        for (int o = 1; o < 64; o <<= 1) s += __shfl_xor(s, o);
        const float mean = s * (1.0f / DM); float q = 0.f;
#pragma unroll
        for (int j = 0; j < 4; ++j) { v[j] = v[j] - mean; q += (v[j][0] * v[j][0] + v[j][1] * v[j][1]) + (v[j][2] * v[j][2] + v[j][3] * v[j][3]); }
#pragma unroll
        for (int o = 1; o < 64; o <<= 1) q += __shfl_xor(q, o);
        const float rstd = 1.0f / sqrtf(q * (1.0f / DM) + LN_EPS);
#pragma unroll
        for (int j = 0; j < 4; ++j) {
            const f32x4 gg = *(const f32x4*)(g + c.lane * 4 + 256 * j), bb = *(const f32x4*)(bta + c.lane * 4 + 256 * j);
            const f32x4 o = v[j] * rstd * gg + bb;
            if (xf) *(f32x4*)(xf + (size_t)row * DM + c.lane * 4 + 256 * j) = o;
            if (xb) { u32x2 w; w.x = cvt_pk_bf16(o[0], o[1]); w.y = cvt_pk_bf16(o[2], o[3]); *(u32x2*)(xb + (size_t)row * DM + c.lane * 4 + 256 * j) = w; }
        }
    }
}
__device__ __forceinline__ void unpack8(const u32x4 w, float (&f)[8]) {
    f[0] = __uint_as_float(w.x << 16); f[1] = __uint_as_float(w.x & 0xffff0000u); f[2] = __uint_as_float(w.y << 16); f[3] = __uint_as_float(w.y & 0xffff0000u);
    f[4] = __uint_as_float(w.z << 16); f[5] = __uint_as_float(w.z & 0xffff0000u); f[6] = __uint_as_float(w.w << 16); f[7] = __uint_as_float(w.w & 0xffff0000u);
}
__device__ __forceinline__ void ffn_fixup(const Ctx& c, unsigned char* big, const float* cw, const float* cbias, int pm) {
    const float* TAILA = (const float*)(big + BIG_TAILA); const float* HEADA = (const float*)(big + BIG_HEADA); const float* HEADB = (const float*)(big + BIG_HEADB); bf16_t* H = (bf16_t*)(big + BIG_H);
    constexpr int NCH = DFF / 8;
    for (int it = c.tid; it < 4 * 2 * NCH; it += NTHR) {
        const int ch = it % NCH, gi = it / NCH, i = gi & 1, G = pm * 4 + (gi >> 1), col = ch * 8;
        const bool first = ((G * 64) & (SEQ - 1)) == 0;
        float p0[8], p1[8], a0[8], a1[8], b[8], h[8];
#pragma unroll
        for (int j = 0; j < 8; ++j) { p0[j] = 0.f; p1[j] = 0.f; }
        if (!first) {
            const float* t0 = TAILA + ((size_t)(G - 1) * 2) * DFF + col;
#pragma unroll
            for (int j = 0; j < 8; ++j) { p0[j] = t0[j]; p1[j] = t0[DFF + j]; }
        }
        const float* ha = HEADA + ((size_t)G * 2) * DFF + col; const float* hb = HEADB + ((size_t)G * 2 + i) * DFF + col;
#pragma unroll
        for (int j = 0; j < 8; ++j) { a0[j] = ha[j]; a1[j] = ha[DFF + j]; b[j] = hb[j]; }
#pragma unroll
        for (int j = 0; j < 8; ++j) {
            const float am2 = i ? p1[j] : p0[j], am1 = i ? a0[j] : p1[j], a = i ? a1[j] : a0[j];
            const float pre = cw[col + j] * am2 + cw[DFF + col + j] * am1 + cw[2 * DFF + col + j] * a + cbias[col + j];
            h[j] = gelu_tanh(pre) * b[j];
        }
        u32x4 w; w.x = cvt_pk_bf16(h[0], h[1]); w.y = cvt_pk_bf16(h[2], h[3]); w.z = cvt_pk_bf16(h[4], h[5]); w.w = cvt_pk_bf16(h[6], h[7]);
        *(u32x4*)(H + (size_t)(G * 64 + i) * DFF + col) = w;
    }
}
__device__ __forceinline__ void phase_kmean(const Ctx& c, const bf16_t* KV, float* KM) {
    for (int it = c.gw; it < BATCH * 8 * 12; it += c.ngw) {
        const int cg_ = it % 12, bn = it / 12, ch = c.lane & 7, rs = c.lane >> 3;
        float s[8];
#pragma unroll
        for (int j = 0; j < 8; ++j) s[j] = 0.f;
        const bf16_t* src = KV + (size_t)bn * 256 * 1536 + cg_ * 64 + ch * 8;
#pragma unroll 4
        for (int r = rs; r < 256; r += 8) { float v[8]; unpack8(*(const u32x4*)(src + (size_t)r * 1536), v);
#pragma unroll
            for (int j = 0; j < 8; ++j) s[j] += v[j]; }
#pragma unroll
        for (int j = 0; j < 8; ++j) { s[j] += __shfl_xor(s[j], 8); s[j] += __shfl_xor(s[j], 16); s[j] += __shfl_xor(s[j], 32); }
        if (rs == 0) {
#pragma unroll
            for (int j = 0; j < 8; ++j) KM[(size_t)bn * 768 + cg_ * 64 + ch * 8 + j] = s[j] * (1.0f / 256.0f);
        }
    }
}

__device__ __forceinline__ void nsa1_unit(const Params& p, LAS unsigned char* lds, int b, int qb) {
    using namespace att;
    int tid_ = threadIdx.x; asm volatile("" : "+v"(tid_));
    const int tid = tid_, lane = tid & 63, r32 = lane & 31, hi = lane >> 5, wid = tid >> 6;
    unsigned char* ws = p.ws;
    const bf16_t* P = (const bf16_t*)(ws + WS_BIG + BIG_P); bf16_t* O = (bf16_t*)(ws + WS_BIG + BIG_O0);
    const bf16_t* KC = (const bf16_t*)(ws + WS_KCMP) + (size_t)b * 128 * 64; const bf16_t* VC = (const bf16_t*)(ws + WS_VCMP) + (size_t)b * 128 * 64;
    __syncthreads();
    tile_st(lds + L_K0, tile_ld(KC, 64, 0, 0, 127, tid), tid); tile_st(lds + L_K1, tile_ld(KC, 64, 64, 0, 127, tid), tid);
    tile_stv(lds + L_V0, tile_ld(VC, 64, 0, 0, 127, tid), tid); tile_stv(lds + L_V1, tile_ld(VC, 64, 64, 0, 127, tid), tid);
    fill_tab(lds, p.in[I_RELB], 0, NH, tid);
    __syncthreads();
    const int t = qb * 256 + wid * 32 + r32; const size_t row = (size_t)b * SEQ + t;
    LAS float* simp = (LAS float*)(lds + L_SIMP) + (wid * 32 + r32) * 33;
#pragma unroll
    for (int i = 0; i < 16; ++i) simp[2 * i + hi] = 0.f;
#pragma nounroll
    for (int h = 0; h < NH; ++h) {
        bf16x8 qr[4]; load_q(qr, P + row * AINP + P_Q + h * 64, hi);
        f32x16 pp[4];
        qk_tile(pp[0], pp[1], lds + L_K0, qr, r32, hi); qk_tile(pp[2], pp[3], lds + L_K1, qr, r32, hi);
        const LAS float* tab = (const LAS float*)(lds + L_TAB) + h * 132;
        float mx = NEG;
        const int tws = __builtin_amdgcn_readfirstlane(t - r32);
#pragma unroll
        for (int a = 0; a < 4; ++a) {
            if (tws >= 512 * a + 655) { const float bb = tab[129];
#pragma unroll
                for (int r = 0; r < 16; ++r) { const float s = pp[a][r] + bb; pp[a][r] = s; mx = fmaxf(mx, s); } }
            else if (tws < 512 * a) {
#pragma unroll
                for (int r = 0; r < 16; ++r) pp[a][r] = NEG; }
            else {
#pragma unroll
                for (int r = 0; r < 16; ++r) { const int n = (r & 3) + 8 * (r >> 2) + 4 * hi + 32 * a; const int d = t - 30 - 16 * n;
                    const float s = pp[a][r] + tab[min(max(d, 0), 129)]; pp[a][r] = s; mx = fmaxf(mx, s); } }
        }
        mx = fmaxf(mx, __shfl_xor(mx, 32));
        const bool dead = mx < -5e29f;
        const float msc = (dead ? 0.f : mx) * SC2;
        float sum = 0.f;
#pragma unroll
        for (int a = 0; a < 4; ++a)
#pragma unroll
            for (int r = 0; r < 16; ++r) { const float e = __builtin_amdgcn_exp2f(pp[a][r] * SC2 - msc); pp[a][r] = e; sum += e; }
        sum += __shfl_xor(sum, 32);
        const float inv = dead ? 0.f : 1.0f / fmaxf(sum, 1e-30f);
#pragma unroll
        for (int a = 0; a < 4; ++a)
#pragma unroll
            for (int r = 0; r < 16; ++r) pp[a][r] *= inv;
#pragma unroll
        for (int a = 0; a < 4; ++a)
#pragma unroll
            for (int g = 0; g < 4; ++g) {
                const float gs = (pp[a][4 * g] + pp[a][4 * g + 1]) + (pp[a][4 * g + 2] + pp[a][4 * g + 3]);
                const float lastv = pp[a][4 * g + 3];
                const float shifted = (g >= 1) ? pp[a][4 * (g - 1) + 3] : ((a >= 1) ? pp[(a >= 1) ? a - 1 : 0][15] : 0.f);
                const float snd = hi ? shifted : lastv;
                const float rcv = __shfl_xor(snd, 32);
                simp[8 * a + 2 * g + hi] += gs + rcv;
            }
        f32x16 o0 = zero16(), o1 = zero16();
        pv_tile(o0, o1, lds + L_V0, pp[0], pp[1], lane); pv_tile(o0, o1, lds + L_V1, pp[2], pp[3], lane);
        const float gate = sigmoidf(bf2f(P[row * AINP + P_G + h * 3 + 0]));
#pragma unroll
        for (int r = 0; r < 16; ++r) { o0[r] *= gate; o1[r] *= gate; }
        store_o(O + row * DM + h * 64, o0, o1, hi);
    }
    __syncthreads();
    const int cur = t >> 6; unsigned mask;
    if (cur < 16) mask = (2u << cur) - 1u;
    else {
        mask = 1u | (1u << cur) | (1u << (cur - 1));
        unsigned cand = ((1u << (cur - 1)) - 1u) & ~1u;
#pragma nounroll
        for (int k = 0; k < 13; ++k) {
            float best = -3e38f; int bi = 0;
#pragma nounroll
            for (int s = 1; s <= 29; ++s) { const float v = simp[s]; const bool take = ((cand >> s) & 1u) && (v > best); best = take ? v : best; bi = take ? s : bi; }
            mask |= 1u << bi; cand &= ~(1u << bi);
        }
    }
    if (hi == 0) ((unsigned*)(ws + WS_SEL))[row] = mask;
}
__device__ __forceinline__ void nsa2_unit(const Params& p, LAS unsigned char* lds, int b, int h0, int qb) {
    using namespace att;
    int tid_ = threadIdx.x; asm volatile("" : "+v"(tid_));
    const int tid = tid_, lane = tid & 63, r32 = lane & 31, hi = lane >> 5, wid = tid >> 6;
    unsigned char* ws = p.ws;
    const bf16_t* P = (const bf16_t*)(ws + WS_BIG + BIG_P); bf16_t* O = (bf16_t*)(ws + WS_BIG + BIG_O0);
    __syncthreads();
    fill_tab(lds, p.in[I_RELB], h0, 2, tid);
    const int h = h0 + (wid >> 2);
    const LAS float* tab = (const LAS float*)(lds + L_TAB) + (wid >> 2) * 132;
    const int tw0 = qb * 256 + (wid & 3) * 64, t0 = tw0 + r32; const size_t row0 = (size_t)b * SEQ + t0, row1 = row0 + 32;
    const LAS unsigned char* qp = park_q(lds, P + row0 * AINP + P_Q + h * 64, P + row1 * AINP + P_Q + h * 64, wid, lane, hi);
    const unsigned sel0 = ((const unsigned*)(ws + WS_SEL))[row0], sel1 = ((const unsigned*)(ws + WS_SEL))[row1];
    const bf16_t* Pb = P + (size_t)b * SEQ * AINP;
    Acc A[2]; acc_init(A[0]); acc_init(A[1]);
    seg2<1, false>(A, lds, Pb + P_KS, Pb + P_VS, AINP, SEQ - 1, 0, qb * 4 + 4, qp, t0, tw0, sel0, sel1, 0, 1 << 30, tab, tid);
#pragma unroll
    for (int s = 0; s < 2; ++s) {
        const size_t row = s ? row1 : row0;
        const float gs = sigmoidf(bf2f(P[row * AINP + P_G + h * 3 + 1])) * acc_inv(A[s]);
#pragma unroll
        for (int r = 0; r < 16; ++r) { A[s].o0[r] *= gs; A[s].o1[r] *= gs; }
        bf16_t* orow = O + row * DM + h * 64;
        add_prev_o(orow, A[s].o0, A[s].o1, hi); store_o(orow, A[s].o0, A[s].o1, hi);
        acc_init(A[s]);
    }
    const int wlo = qb * 4 - 8 < 0 ? 0 : qb * 4 - 8;
    seg2<2, false>(A, lds, Pb + P_KW, Pb + P_VW, AINP, SEQ - 1, wlo, qb * 4 + 4, qp, t0, tw0, 0u, 0u, 0, 512, tab, tid);
#pragma unroll
    for (int s = 0; s < 2; ++s) {
        const size_t row = s ? row1 : row0;
        const float gw = sigmoidf(bf2f(P[row * AINP + P_G + h * 3 + 2])) * acc_inv(A[s]);
#pragma unroll
        for (int r = 0; r < 16; ++r) { A[s].o0[r] *= gw; A[s].o1[r] *= gw; }
        bf16_t* orow = O + row * DM + h * 64;
        add_prev_o(orow, A[s].o0, A[s].o1, hi); store_o(orow, A[s].o0, A[s].o1, hi);
    }
}
__device__ __forceinline__ unsigned moba_select(const float* KM, const bf16x8 (&qr)[4], int b, int h, int qb, int hi) {
    float gt[7];
#pragma unroll
    for (int n = 0; n < 7; ++n) {
        float s = 0.f;
        if (n < qb) {
            const float* km = KM + ((size_t)(b * 8 + n) * NH + h) * 64 + hi * 8;
#pragma unroll
            for (int d0 = 0; d0 < 4; ++d0) { const f32x4 k0 = *(const f32x4*)(km + d0 * 16), k1 = *(const f32x4*)(km + d0 * 16 + 4);
                s += bf2f((unsigned short)qr[d0][0]) * k0[0] + bf2f((unsigned short)qr[d0][1]) * k0[1] + bf2f((unsigned short)qr[d0][2]) * k0[2] + bf2f((unsigned short)qr[d0][3]) * k0[3]
                   + bf2f((unsigned short)qr[d0][4]) * k1[0] + bf2f((unsigned short)qr[d0][5]) * k1[1] + bf2f((unsigned short)qr[d0][6]) * k1[2] + bf2f((unsigned short)qr[d0][7]) * k1[3]; }
        }
        s += __shfl_xor(s, 32);
        gt[n] = s;
    }
    unsigned sel = 1u << qb, cand = (1u << qb) - 1u;
#pragma nounroll
    for (int k = 0; k < 3; ++k) {
        float best = -3e38f; int bi = -1;
#pragma unroll
        for (int n = 0; n < 7; ++n) { const bool take = ((cand >> n) & 1u) && (gt[n] > best); best = take ? gt[n] : best; bi = take ? n : bi; }
        if (bi >= 0) { sel |= 1u << bi; cand &= ~(1u << bi); }
    }
    return sel;
}
__device__ __forceinline__ void moba_unit(const Params& p, LAS unsigned char* lds, int b, int h, int qp) {
    using namespace att;
    int tid_ = threadIdx.x; asm volatile("" : "+v"(tid_));
    const int tid = tid_, lane = tid & 63, r32 = lane & 31, hi = lane >> 5, wid = tid >> 6;
    unsigned char* ws = p.ws;
    const bf16_t* KV = (const bf16_t*)(ws + WS_BIG + BIG_KV); const bf16_t* Q = (const bf16_t*)(ws + WS_BIG + BIG_Q1); bf16_t* O = (bf16_t*)(ws + WS_BIG + BIG_O1);
    const float* KM = (const float*)(ws + WS_KMEAN);
    __syncthreads();
    fill_tab(lds, p.in[I_RELB], h, 1, tid);
    const LAS float* tab = (const LAS float*)(lds + L_TAB);
    const int qb = 2 * qp + (wid >> 2);
    const int tw0 = qb * 256 + (wid & 3) * 64, t0 = tw0 + r32; const size_t row0 = (size_t)b * SEQ + t0, row1 = row0 + 32;
    unsigned sel0, sel1;
    { bf16x8 qr[4]; load_q(qr, Q + row0 * DM + h * 64, hi); sel0 = moba_select(KM, qr, b, h, qb, hi); }
    { bf16x8 qr[4]; load_q(qr, Q + row1 * DM + h * 64, hi); sel1 = moba_select(KM, qr, b, h, qb, hi); }
    const LAS unsigned char* qp_ = park_q(lds, Q + row0 * DM + h * 64, Q + row1 * DM + h * 64, wid, lane, hi);
    const bf16_t* Kb = KV + (size_t)b * SEQ * 1536 + h * 64;
    Acc A[2]; acc_init(A[0]); acc_init(A[1]);
    seg2<1, true>(A, lds, Kb, Kb + MAINW, 1536, SEQ - 1, 0, qp * 8 + 8, qp_, t0, tw0, sel0, sel1, 2, 1 << 30, tab, tid);
#pragma unroll
    for (int s = 0; s < 2; ++s) {
        const float inv = acc_inv(A[s]);
#pragma unroll
        for (int r = 0; r < 16; ++r) { A[s].o0[r] *= inv; A[s].o1[r] *= inv; }
        store_o(O + (s ? row1 : row0) * DM + h * 64, A[s].o0, A[s].o1, hi);
    }
}
__device__ __forceinline__ void mem_unit(const Params& p, LAS unsigned char* lds, const bf16_t* Q, int ldq, int qcol, bf16_t* O, int kvcol, int b, int mh, int qq) {
    using namespace att;
    int tid_ = threadIdx.x; asm volatile("" : "+v"(tid_));
    const int tid = tid_, lane = tid & 63, r32 = lane & 31, hi = lane >> 5, wid = tid >> 6;
    const bf16_t* MKV = (const bf16_t*)(p.ws + WS_MKV) + (size_t)b * NMEM * 1024 + kvcol + mh * 64;
    const int tw0 = qq * 512 + wid * 64, t0 = tw0 + r32; const size_t row0 = (size_t)b * SEQ + t0, row1 = row0 + 32;
    __syncthreads();
    const LAS unsigned char* qp = park_q(lds, Q + row0 * ldq + qcol + mh * 64, Q + row1 * ldq + qcol + mh * 64, wid, lane, hi);
    Acc A[2]; acc_init(A[0]); acc_init(A[1]);
    seg2<0, true>(A, lds, MKV, MKV + 256, 1024, NMEM - 1, 0, 4, qp, t0, tw0, 0u, 0u, 0, 1 << 30, (const LAS float*)(lds + L_TAB), tid);
#pragma unroll
    for (int s = 0; s < 2; ++s) {
        const float inv = acc_inv(A[s]);
#pragma unroll
        for (int r = 0; r < 16; ++r) { A[s].o0[r] *= inv; A[s].o1[r] *= inv; }
        store_o(O + (s ? row1 : row0) * DM + MAINW + mh * 64, A[s].o0, A[s].o1, hi);
    }
}

#define XB_TMO      128
#define XB_XCNT(j)  (256  + 64 * (j))
#define XB_XSUB(j)  (1280 + 64 * (j))
#define XB_XGEN(j)  (2304 + 64 * (j))
#define XB_TOP      3328
#define XB_TOPGEN   3392
#define XCD_BAR_WORDS 3456
#define XB_SPIN_CAP (1u << 18)
__device__ __forceinline__ unsigned xb_ld(unsigned* p)              { return __hip_atomic_load(p, __ATOMIC_RELAXED, __HIP_MEMORY_SCOPE_AGENT); }
__device__ __forceinline__ unsigned xb_add(unsigned* p, unsigned v) { return __hip_atomic_fetch_add(p, v, __ATOMIC_RELAXED, __HIP_MEMORY_SCOPE_AGENT); }
__device__ __forceinline__ unsigned xb_xcc_id() { return (unsigned)__builtin_amdgcn_s_getreg((3 << 11) | 20) & 0xFu; }
#define XB_SPIN(cond, bar) do { unsigned _sp = 0; while (cond) { __builtin_amdgcn_s_sleep(1); \
    if ((++_sp & 255u) == 0u) { if (xb_ld(&(bar)[XB_TMO])) break; if (_sp > XB_SPIN_CAP) { atomicAdd(&(bar)[XB_TMO], 1u); break; } } } } while (0)
struct XcdBarrier { unsigned* bar; unsigned x; volatile LAS unsigned* st; };
__device__ __forceinline__ XcdBarrier xcd_barrier_post(unsigned* bar, volatile LAS unsigned* st) {
    XcdBarrier b; b.bar = bar; b.x = xb_xcc_id(); b.st = st;
    if (threadIdx.x == 0) (void)xb_add(&bar[XB_XCNT(b.x)], 1u);
    return b;
}
__device__ __forceinline__ void xcd_barrier_complete(unsigned* bar, unsigned x, unsigned& nloc, unsigned& nx) {
    const unsigned G = gridDim.x * gridDim.y * gridDim.z;
    unsigned sum, cnt, mine, sp = 0u;
    for (;;) {
        sum = 0u; cnt = 0u; mine = 0u;
#pragma unroll
        for (unsigned j = 0; j < 16; ++j) { const unsigned c = xb_ld(&bar[XB_XCNT(j)]); sum += c; cnt += (c > 0u) ? 1u : 0u; mine = (j == x) ? c : mine; }
        if (sum == G) break;
        __builtin_amdgcn_s_sleep(1);
        if ((++sp & 255u) == 0u) { if (xb_ld(&bar[XB_TMO])) break; if (sp > XB_SPIN_CAP) { atomicAdd(&bar[XB_TMO], 1u); break; } }
    }
    nloc = mine > 0u ? mine : 1u; nx = cnt > 0u ? cnt : 1u;
}
__device__ __forceinline__ void xcd_barrier(const XcdBarrier& b) {
    asm volatile("s_waitcnt vmcnt(0)" ::: "memory");
    __syncthreads();
    if (threadIdx.x == 0) {
        unsigned* bar = b.bar;
        __builtin_amdgcn_s_waitcnt(0);
        unsigned nloc = b.st[0], nx = b.st[1];
        if (nloc == 0u) { xcd_barrier_complete(bar, b.x, nloc, nx); b.st[0] = nloc; b.st[1] = nx; }
        const unsigned old = xb_add(&bar[XB_XSUB(b.x)], 1u);
        const unsigned gen = old / nloc;
        if (old + 1u == (gen + 1u) * nloc) {
            __builtin_amdgcn_fence(__ATOMIC_RELEASE, "agent");
            asm volatile("s_waitcnt vmcnt(0)" ::: "memory");
            const unsigned og = xb_add(&bar[XB_TOP], 1u);
            const unsigned tg = og / nx;
            if (og + 1u == (tg + 1u) * nx) xb_add(&bar[XB_TOPGEN], 1u);
            else XB_SPIN(xb_ld(&bar[XB_TOPGEN]) == tg, bar);
            __builtin_amdgcn_fence(__ATOMIC_ACQUIRE, "agent");
            xb_add(&bar[XB_XGEN(b.x)], 1u);
            asm volatile("s_waitcnt vmcnt(0)" ::: "memory");
        } else {
            XB_SPIN(xb_ld(&bar[XB_XGEN(b.x)]) == gen, bar);
            __builtin_amdgcn_fence(__ATOMIC_ACQUIRE, "agent");
            asm volatile("s_waitcnt vmcnt(0)" ::: "memory");
        }
    }
    __syncthreads();
}

enum { PH_PREP = 0, PH_A_GEMM, PH_A_CMP1, PH_A_CMP2, PH_A_NSA1, PH_A_NSA2, PH_A_OUT, PH_A_LN1, PH_A_F0, PH_A_F1, PH_A_LN2,
       PH_B_GEMM, PH_B_KMEAN, PH_B_ATT, PH_B_OUT, PH_B_LN1, PH_B_F0, PH_B_F1, PH_B_LN2, PH_COUNT };

struct GemmJob { pg8::Gemm g; int epi; void* O; const float* aux; const float* aux2; int ldc; int coff; };
__device__ __forceinline__ void set_job(GemmJob& J, const bf16_t* A, const bf16_t* Bt, int M, int N, int K, int lda, int epi, void* O, const float* aux, int ldc) {
    J.g.A = A; J.g.Bt = Bt; J.g.M = M; J.g.N = N; J.g.K = K; J.g.lda = lda; J.g.kstepA = 128; J.epi = epi; J.O = O; J.aux = aux; J.aux2 = nullptr; J.ldc = ldc; J.coff = 0;
}
__device__ __forceinline__ bool gemm_job(const Params& p, int ph, int j, GemmJob& J) {
    unsigned char* ws = p.ws;
    const bf16_t* XB = (const bf16_t*)(ws + WS_XB); const float* XF = (const float*)XB;
    unsigned char* big = ws + WS_BIG;
    const int layer = ph >= PH_B_GEMM ? 1 : 0;
    const bf16_t* Win = (const bf16_t*)(ws + WS_WFIN) + (size_t)layer * 2 * DFF * DM; const bf16_t* Wout = (const bf16_t*)(ws + WS_WFOUT) + (size_t)layer * DM * DFF;
    if (ph == PH_A_GEMM) {
        if (j == 0) { set_job(J, XB, (const bf16_t*)(ws + WS_WAIN), NTOK, AINP, DM, DM, 0, big + BIG_P, nullptr, AINP); return true; }
        return false;
    }
    if (ph == PH_A_CMP1) {
        if (j == 2) { set_job(J, (const bf16_t*)(ws + WS_MEMB), (const bf16_t*)(ws + WS_WMKV), BATCH * NMEM, 1024, DM, DM, 0, ws + WS_MKV, nullptr, 1024); J.coff = 32; return true; }
        if (j >= 3) return false;
        const bf16_t* P = (const bf16_t*)(big + BIG_P);
        set_job(J, P + (j ? P_VC : P_KC), (const bf16_t*)(ws + (j ? WS_WC1V : WS_WC1K)), 4096, 256, 2048, 16 * AINP, 1, (float*)(ws + WS_CMPH) + (size_t)j * 4096 * 256, (const float*)(ws + WS_CBIAS) + j * 256, 256);
        J.g.kstepA = AINP * 2; J.coff = j * 16; return true;
    }
    if (ph == PH_A_OUT) { if (j) return false; set_job(J, (const bf16_t*)(big + BIG_O0), (const bf16_t*)(ws + WS_WAOUT), NTOK, DM, DM, DM, 2, p.out, p.in[I_X], DM); return true; }
    if (ph == PH_B_OUT) { if (j) return false; set_job(J, (const bf16_t*)(big + BIG_O1), (const bf16_t*)(ws + WS_WBOUT), NTOK, DM, DM, DM, 4, p.out, XF, DM); return true; }
    if (ph == PH_B_GEMM) {
        if (j == 0) { set_job(J, XB, (const bf16_t*)(ws + WS_WSKV), NTOK, 1536, DM, DM, 0, big + BIG_KV, nullptr, 1536); return true; }
        if (j == 1) { set_job(J, XB, (const bf16_t*)(ws + WS_WBIN), NTOK, DM, DM, DM, 0, big + BIG_Q1, nullptr, DM); return true; }
        return false;
    }
    const int f = layer ? ph - PH_B_F0 : ph - PH_A_F0;
    if (j) return false;
    if (f == 0) { set_job(J, XB, Win, NTOK, 2 * DFF, DM, DM, 3, big + BIG_H, p.in[I_FCW] + (size_t)layer * 3 * DFF, DFF); J.aux2 = p.in[I_FCB] + (size_t)layer * DFF; return true; }
    if (f == 1) { set_job(J, (const bf16_t*)(big + BIG_H), Wout, NTOK, DM, DFF, DFF, 4, p.out, XF, DM); return true; }
    return false;
}
__device__ __forceinline__ bool is_gemm_phase(int ph) {
    return ph == PH_A_GEMM || ph == PH_A_CMP1 || ph == PH_A_OUT || ph == PH_B_OUT || ph == PH_B_GEMM || ph == PH_A_F0 || ph == PH_A_F1 || ph == PH_B_F0 || ph == PH_B_F1;
}
template <int JJ>
__device__ __forceinline__ void run_gemm_job(const Params& p, LAS unsigned char* lds, int ph) {
    GemmJob J;
    if (!gemm_job(p, ph, JJ, J)) return;
    pg8::StaticOrder S; S.init(J.g.M, J.g.N, (int)gridDim.x, (int)blockIdx.x - J.coff);
    if (J.epi == 0) { pg8::EpiBf16 E{(bf16_t*)J.O, J.ldc}; pg8::gemm_phase<pg8::EpiBf16>(lds, J.g, S, E); }
    else if (J.epi == 1) { pg8::EpiF32BiasGelu E{(float*)J.O, J.ldc, J.aux}; pg8::gemm_phase<pg8::EpiF32BiasGelu>(lds, J.g, S, E); }
    else if (J.epi == 3) { unsigned char* big = p.ws + WS_BIG; pg8::EpiConvGate E{(bf16_t*)J.O, J.aux, J.aux2, (float*)(big + BIG_TAILA), (float*)(big + BIG_HEADA), (float*)(big + BIG_HEADB)}; pg8::gemm_phase<pg8::EpiConvGate>(lds, J.g, S, E); }
    else if (J.epi == 2) { pg8::EpiResF32<true> E{J.aux, (float*)J.O, J.ldc, ALPHA}; pg8::gemm_phase<pg8::EpiResF32<true>>(lds, J.g, S, E); }
    else { pg8::EpiResF32<false> E{J.aux, (float*)J.O, J.ldc, ALPHA}; pg8::gemm_phase<pg8::EpiResF32<false>>(lds, J.g, S, E); }
}
__device__ __forceinline__ void run_gemm_phase(const Params& p, LAS unsigned char* lds, int ph) {
    run_gemm_job<0>(p, lds, ph); run_gemm_job<1>(p, lds, ph); run_gemm_job<2>(p, lds, ph);
}

__device__ __forceinline__ void run_phase(const Params& p, LAS unsigned char* lds, const Ctx& c, int ph) {
    unsigned char* ws = p.ws;
    bf16_t* XB = (bf16_t*)(ws + WS_XB);
    const int G = (int)gridDim.x, bid = (int)blockIdx.x;
    if (ph == PH_A_F1 || ph == PH_B_F1) {
        const int layer = ph == PH_B_F1 ? 1 : 0;
        pg8::StaticOrder S; S.init(NTOK, DM, G, bid); pg8::Unit u;
        for (int i = 0; S.next(i, u); ++i) ffn_fixup(c, ws + WS_BIG, p.in[I_FCW] + (size_t)layer * 3 * DFF, p.in[I_FCB] + (size_t)layer * DFF, u.pm);
        asm volatile("s_waitcnt vmcnt(0)" ::: "memory"); __syncthreads();
    }
    if (ph == PH_A_CMP1 && G >= LATE_FIRST_WG + 32 && bid >= LATE_FIRST_WG) {
        Ctx c2 = c; c2.gtid = (bid - LATE_FIRST_WG) * NTHR + c.tid; c2.gsz = (G - LATE_FIRST_WG) * NTHR;
        prep_late(p, c2);
    }
    if (is_gemm_phase(ph)) { run_gemm_phase(p, lds, ph); return; }
    switch (ph) {
    case PH_PREP: phase_prep(p, c); break;
    case PH_A_CMP2: phase_cmp2(p, c); break;
    case PH_A_NSA1: {
        for (int u = bid; u < BATCH * 8; u += G) nsa1_unit(p, lds, u >> 3, u & 7);
    } break;
    case PH_A_NSA2: {
        for (int u = bid; u < BATCH * (NH / 2) * 4; u += G) { const int b = u / 24, r = u % 24, hp = r >> 2, s = (r + u / G) & 3;
#pragma nounroll
            for (int k = 0; k < 2; ++k) nsa2_unit(p, lds, b, 2 * hp, k ? s : 7 - s); }
    } break;
    case PH_B_ATT: {
        for (int u = bid; u < BATCH * NH * 2; u += G) { const int b = u / 24, r = u % 24, h = r >> 1, s = r & 1;
#pragma nounroll
            for (int k = 0; k < 2; ++k) moba_unit(p, lds, b, h, k ? s : 3 - s); }
    } break;
    case PH_A_LN1: case PH_B_LN1: case PH_A_LN2: case PH_B_LN2: {
        const int layer = ph >= PH_B_GEMM ? 1 : 0; const bool second = (ph == PH_A_LN2 || ph == PH_B_LN2); const bool fin = (ph == PH_B_LN2);
        phase_ln(c, p.out, p.in[second ? I_LN2G : I_LN1G] + layer * DM, p.in[second ? I_LN2B : I_LN1B] + layer * DM, fin ? p.out : nullptr, fin ? nullptr : XB);
    } break;
    case PH_B_KMEAN: phase_kmean(c, (const bf16_t*)(ws + WS_BIG + BIG_KV), (float*)(ws + WS_KMEAN)); break;
    default: break;
    }
    if (ph == PH_A_NSA1 || ph == PH_B_ATT) {
        const bool la = (ph == PH_A_NSA1);
        const bf16_t* Q = (const bf16_t*)(ws + WS_BIG + (la ? BIG_P : BIG_Q1)); bf16_t* O = (bf16_t*)(ws + WS_BIG + (la ? BIG_O0 : BIG_O1));
        for (int u = bid; u < BATCH * 4 * 4; u += G) mem_unit(p, lds, Q, la ? AINP : DM, la ? P_QM : MAINW, O, la ? 0 : 512, u >> 4, (u >> 2) & 3, u & 3);
    }
}

template <int PH>
__device__ __forceinline__ void phase_seq(const Params& p, LAS unsigned char* lds, const Ctx& c, cg::grid_group& grid, const XcdBarrier& bar) {
    if constexpr (PH < PH_COUNT) {
        if (PH >= p.ph_lo && PH < p.ph_hi) {
            Ctx cc; { int t_ = threadIdx.x; asm volatile("" : "+v"(t_)); cc.tid = t_; cc.lane = t_ & 63; cc.wid = t_ >> 6; cc.gtid = blockIdx.x * NTHR + t_; cc.gsz = gridDim.x * NTHR; cc.gw = blockIdx.x * (NTHR / 64) + cc.wid; cc.ngw = gridDim.x * (NTHR / 64); }
            run_phase(p, lds, cc, PH); if (PH + 1 < p.ph_hi) { if (PH == 0) grid.sync(); else xcd_barrier(bar); } }
        phase_seq<PH + 1>(p, lds, c, grid, bar);
    }
}
__global__ void __launch_bounds__(NTHR) yoco_mega(Params p) {
    extern __shared__ __attribute__((aligned(16))) unsigned char lds_raw[];
    LAS unsigned char* lds = (LAS unsigned char*)lds_raw;
    cg::grid_group grid = cg::this_grid();
    Ctx c; c.tid = threadIdx.x; c.lane = c.tid & 63; c.wid = c.tid >> 6; c.gtid = blockIdx.x * NTHR + c.tid; c.gsz = gridDim.x * NTHR; c.gw = blockIdx.x * (NTHR / 64) + c.wid; c.ngw = gridDim.x * (NTHR / 64);
    if (c.tid < 130) ((LAS int*)(lds + att::L_BKT))[c.tid] = c.tid == 0 ? 0 : att::rel_bucket(c.tid - 1);
    if (c.tid < 2) ((LAS unsigned*)(lds + att::L_MISC))[c.tid] = 0u;
    __syncthreads();
    const XcdBarrier bar = xcd_barrier_post((unsigned*)(p.ws + WS_CTL), (volatile LAS unsigned*)(lds + att::L_MISC));
    phase_seq<0>(p, lds, c, grid, bar);
}

extern "C" void kernel_launch(void* const* d_in, const int* in_sizes, int n_in, void* d_out, int out_size, void* d_ws, size_t ws_size, hipStream_t stream) {
    static int grid = 0;
    if (grid == 0) {
        if (n_in != 24 || ws_size < WS_NEED) { fprintf(stderr, "kernel_launch: unexpected n_in %d / ws_size %zu (need %zu)\n", n_in, ws_size, (size_t)WS_NEED); grid = -1; return; }
        int dev = 0, cus = 0, per_cu = 0;
        hipGetDevice(&dev); hipDeviceGetAttribute(&cus, hipDeviceAttributeMultiprocessorCount, dev);
        if (hipFuncSetAttribute((const void*)yoco_mega, hipFuncAttributeMaxDynamicSharedMemorySize, LDS_BYTES) != hipSuccess) { fprintf(stderr, "kernel_launch: hipFuncSetAttribute failed\n"); grid = -1; return; }
        if (hipOccupancyMaxActiveBlocksPerMultiprocessor(&per_cu, (const void*)yoco_mega, NTHR, LDS_BYTES) != hipSuccess || per_cu < 1) { fprintf(stderr, "kernel_launch: occupancy query says %d\n", per_cu); per_cu = 1; }
        (void)hipGetLastError();
        grid = cus * per_cu;
        fprintf(stderr, "kernel_launch: grid %d (cus %d x %d)\n", grid, cus, per_cu);
    }
    if (grid < 0) return;
    if (hipMemsetAsync((char*)d_ws + WS_CTL, 0, CTL_BYTES, stream) != hipSuccess) { fprintf(stderr, "kernel_launch: memset failed\n"); return; }
    Params p{};
    for (int i = 0; i < 24; ++i) p.in[i] = (const float*)d_in[i];
    p.out = (float*)d_out; p.ws = (unsigned char*)d_ws; p.ph_lo = 0; p.ph_hi = PH_COUNT;
    void* args[] = {&p};
    hipError_t e = hipLaunchCooperativeKernel((const void*)yoco_mega, dim3(grid), dim3(NTHR), args, LDS_BYTES, stream);
    if (e != hipSuccess) fprintf(stderr, "kernel_launch: cooperative launch failed: %s (grid %d)\n", hipGetErrorString(e), grid);
}
```

```cpp
#include <hip/hip_runtime.h>
#include <hip/hip_cooperative_groups.h>
#include <cstdio>
#include <cstdint>
namespace cg = cooperative_groups;

#define LAS __attribute__((address_space(3)))
typedef unsigned short bf16_t;
typedef short bf16x8 __attribute__((ext_vector_type(8)));
typedef short s16x4 __attribute__((ext_vector_type(4)));
typedef float f32x4 __attribute__((ext_vector_type(4)));
typedef float f32x2 __attribute__((ext_vector_type(2)));
typedef float f32x16 __attribute__((ext_vector_type(16)));
typedef unsigned u32x4 __attribute__((ext_vector_type(4)));
typedef unsigned u32x2 __attribute__((ext_vector_type(2)));

__device__ __forceinline__ unsigned cvt_pk_bf16(float lo, float hi) { unsigned r; asm volatile("v_cvt_pk_bf16_f32 %0, %1, %2" : "=v"(r) : "v"(lo), "v"(hi)); return r; }
__device__ __forceinline__ float bf2f(unsigned short b) { return __uint_as_float(((unsigned)b) << 16); }
__device__ __forceinline__ float gelu_tanh(float x) {
    const float x2 = x * x;
    const float w = x * (-2.302208198f - 0.1029432397f * x2);
    return x * __builtin_amdgcn_rcpf(1.0f + __builtin_amdgcn_exp2f(w));
}

namespace pg8 {
constexpr int BM = 256, BK = 64, HALF = 128, HTB = HALF * BK * 2, STAGE_BYTES = 8 * HTB, NXCD = 8, WGM = 8;
__host__ __device__ __forceinline__ int lds_byte(int r, int c) { const int st = (r >> 4) * 2 + (c >> 5), rr = r & 15, cc = c & 31, ob = rr * 64 + cc * 2; return st * 1024 + (ob ^ (((ob >> 9) & 1) << 5)); }
__host__ __device__ __forceinline__ void stage_rc(int b, int& R, int& C) { const int st = b / 1024, sb = b % 1024, swz = sb ^ (((sb >> 9) & 1) << 5); R = (st >> 1) * 16 + swz / 64; C = (st & 1) * 32 + (swz % 64) / 2; }
__host__ __device__ __forceinline__ int perm32(int rho) { const int n = rho >> 4, i = rho & 15; return 8 * (i >> 2) + 4 * n + (i & 3); }

struct Unit { int pm, pn; };
struct Gemm { const bf16_t* A; const bf16_t* Bt; int M, N, K; int lda; int kstepA; };

struct StaticOrder {
    int nM, nN, nwg, G, c;
    __host__ __device__ void init(int M, int N, int G_, int c_) { nM = M / BM; nN = N / BM; nwg = nM * nN; G = G_; c = c_; }
    __host__ __device__ bool next(int i, Unit& u) const {
        if (c < 0) return false;
        const long L = (long)i * G + c; if (L >= nwg) return false;
        int wgid = (int)L; { const int q = nwg / NXCD, r = nwg % NXCD, xcd = wgid % NXCD, off = wgid / NXCD; wgid = (xcd < r ? xcd * (q + 1) : r * (q + 1) + (xcd - r) * q) + off; }
        const int nig = WGM * nN, gid = wgid / nig, fm = gid * WGM, gsz = (nM - fm) < WGM ? (nM - fm) : WGM;
        u.pm = fm + ((wgid % nig) % gsz); u.pn = (wgid % nig) / gsz; return true;
    }
};

struct EpiBf16 {
    static constexpr bool PERM = true;
    bf16_t* O; int ldc;
    __device__ __forceinline__ void operator()(const f32x4 (&acc)[2][2][4][2], const Unit& u, int wr, int wc, int fr, int fq) const {
        const int row0 = u.pm * BM + wr * 64 + fr; const int col0 = u.pn * BM + wc * 32 + 8 * fq;
#pragma unroll
        for (int ai = 0; ai < 2; ++ai)
#pragma unroll
            for (int m = 0; m < 4; ++m) { bf16_t* rowp = O + (size_t)(row0 + ai * HALF + m * 16) * ldc + col0;
#pragma unroll
                for (int bj = 0; bj < 2; ++bj) { const f32x4 v0 = acc[ai][bj][m][0], v1 = acc[ai][bj][m][1];
                    u32x4 w; w.x = cvt_pk_bf16(v0[0], v0[1]); w.y = cvt_pk_bf16(v0[2], v0[3]); w.z = cvt_pk_bf16(v1[0], v1[1]); w.w = cvt_pk_bf16(v1[2], v1[3]);
                    *(u32x4*)(rowp + bj * HALF) = w; } }
    }
};
struct EpiF32BiasGelu {
    static constexpr bool PERM = false;
    float* O; int ldc; const float* bias;
    __device__ __forceinline__ void operator()(const f32x4 (&acc)[2][2][4][2], const Unit& u, int wr, int wc, int fr, int fq) const {
        const int row0 = u.pm * BM + wr * 64 + fr; const int col0 = u.pn * BM + wc * 32 + 4 * fq;
#pragma unroll
        for (int bj = 0; bj < 2; ++bj)
#pragma unroll
            for (int n = 0; n < 2; ++n) { const f32x4 bv = *(const f32x4*)(bias + col0 + bj * HALF + n * 16);
#pragma unroll
                for (int ai = 0; ai < 2; ++ai)
#pragma unroll
                    for (int m = 0; m < 4; ++m) { f32x4 v = acc[ai][bj][m][n] + bv; v[0] = gelu_tanh(v[0]); v[1] = gelu_tanh(v[1]); v[2] = gelu_tanh(v[2]); v[3] = gelu_tanh(v[3]);
                        *(f32x4*)(O + (size_t)(row0 + ai * HALF + m * 16) * ldc + col0 + bj * HALF + n * 16) = v; } }
    }
};
template <int CTRL> __device__ __forceinline__ float dppf(float old, float src) {
    return __int_as_float(__builtin_amdgcn_update_dpp(__float_as_int(old), __float_as_int(src), CTRL, 0xf, 0xf, false));
}
struct EpiConvGate {
    static constexpr bool PERM = true;
    bf16_t* H; const float* cw; const float* cb; float* TAILA; float* HEADA; float* HEADB;
    __device__ __forceinline__ void operator()(const f32x4 (&acc)[2][2][4][2], const Unit& u, int wr, int wc, int fr, int fq) const {
        constexpr int DFF_ = 2816;
        const int cf0 = u.pn * 128 + wc * 32 + 8 * fq;
        f32x4 w0[2], w1[2], w2[2], cv[2];
#pragma unroll
        for (int n = 0; n < 2; ++n) { w0[n] = *(const f32x4*)(cw + cf0 + 4 * n); w1[n] = *(const f32x4*)(cw + DFF_ + cf0 + 4 * n); w2[n] = *(const f32x4*)(cw + 2 * DFF_ + cf0 + 4 * n); cv[n] = *(const f32x4*)(cb + cf0 + 4 * n); }
#pragma unroll
        for (int ai = 0; ai < 2; ++ai) {
            const int G = u.pm * 4 + ai * 2 + wr;
#pragma unroll
            for (int m = 0; m < 4; ++m) {
                const int row = u.pm * BM + ai * HALF + wr * 64 + m * 16 + fr;
                f32x4 hv[2];
#pragma unroll
                for (int n = 0; n < 2; ++n) {
                    const f32x4 a = acc[ai][0][m][n], b = acc[ai][1][m][n];
                    const f32x4 pv = acc[ai][0][m > 0 ? m - 1 : 0][n];
#pragma unroll
                    for (int j = 0; j < 4; ++j) {
                        const float am1 = dppf<0x111>(dppf<0x121>(0.f, pv[j]), a[j]);
                        const float am2 = dppf<0x112>(dppf<0x122>(0.f, pv[j]), a[j]);
                        const float pre = w0[n][j] * am2 + w1[n][j] * am1 + w2[n][j] * a[j] + cv[n][j];
                        hv[n][j] = gelu_tanh(pre) * b[j];
                    }
                }
                if (m > 0 || fr >= 2) {
                    u32x4 w; w.x = cvt_pk_bf16(hv[0][0], hv[0][1]); w.y = cvt_pk_bf16(hv[0][2], hv[0][3]); w.z = cvt_pk_bf16(hv[1][0], hv[1][1]); w.w = cvt_pk_bf16(hv[1][2], hv[1][3]);
                    *(u32x4*)(H + (size_t)row * DFF_ + cf0) = w;
                } else {
                    float* ha = HEADA + ((size_t)G * 2 + fr) * DFF_ + cf0; float* hb = HEADB + ((size_t)G * 2 + fr) * DFF_ + cf0;
                    *(f32x4*)ha = acc[ai][0][0][0]; *(f32x4*)(ha + 4) = acc[ai][0][0][1]; *(f32x4*)hb = acc[ai][1][0][0]; *(f32x4*)(hb + 4) = acc[ai][1][0][1];
                }
                if (m == 3 && fr >= 14) { float* ta = TAILA + ((size_t)G * 2 + (fr - 14)) * DFF_ + cf0; *(f32x4*)ta = acc[ai][0][3][0]; *(f32x4*)(ta + 4) = acc[ai][0][3][1]; }
            }
        }
    }
};
template <bool BASE_F32>
struct EpiResF32 {
    static constexpr bool PERM = false;
    const void* basev; float* O; int ldc; float alpha;
    __device__ __forceinline__ void operator()(const f32x4 (&acc)[2][2][4][2], const Unit& u, int wr, int wc, int fr, int fq) const {
        const int row0 = u.pm * BM + wr * 64 + fr; const int col0 = u.pn * BM + wc * 32 + 4 * fq;
#pragma unroll
        for (int ai = 0; ai < 2; ++ai)
#pragma unroll
            for (int m = 0; m < 4; ++m) { const size_t off = (size_t)(row0 + ai * HALF + m * 16) * ldc + col0;
#pragma unroll
                for (int bj = 0; bj < 2; ++bj)
#pragma unroll
                    for (int n = 0; n < 2; ++n) { f32x4 bs;
                        if (BASE_F32) bs = *(const f32x4*)((const float*)basev + off + bj * HALF + n * 16);
                        else { const u32x2 w = *(const u32x2*)((const bf16_t*)basev + off + bj * HALF + n * 16); bs[0] = __uint_as_float(w.x << 16); bs[1] = __uint_as_float(w.x & 0xffff0000u); bs[2] = __uint_as_float(w.y << 16); bs[3] = __uint_as_float(w.y & 0xffff0000u); }
                        *(f32x4*)(O + off + bj * HALF + n * 16) = bs * alpha + acc[ai][bj][m][n]; } }
    }
};

template <class Epi>
__device__ __forceinline__ void gemm_phase(LAS unsigned char* lds, const Gemm g, const StaticOrder& S, const Epi& E) {
    const int tid = threadIdx.x, wid = __builtin_amdgcn_readfirstlane(tid >> 6), lane = tid & 63, wr = wid >> 2, wc = wid & 3, fr = lane & 15, fq = lane >> 4;
    const int K = g.K, nt = K / BK;
    unsigned voffA[2], voffB[2];
#pragma unroll
    for (int i = 0; i < 2; ++i) { int R, C; stage_rc(tid * 16 + i * 8192, R, C); const int Rb = Epi::PERM ? ((R & ~31) + perm32(R & 31)) : R;
        voffA[i] = (unsigned)(R * g.lda + C) * 2u; voffB[i] = (unsigned)(Rb * K + C) * 2u; }
    const size_t kstepA = (size_t)g.kstepA, kstepB = (size_t)(BK * 2);
    const size_t hstepA = (size_t)HALF * g.lda * 2, hstepB = (size_t)HALF * K * 2;
    const size_t tstepA = 2 * hstepA, tstepB = 2 * hstepB;
    const unsigned ldsw = (unsigned)wid * 1024u;
    const int aoff = lds_byte(wr * 64 + fr, fq * 8), boff = lds_byte(wc * 32 + fr, fq * 8);
#define PG8_SA(b, h) (((b) * 2 + (h)) * HTB)
#define PG8_SB(b, h) ((4 + (b) * 2 + (h)) * HTB)
#define PG8_STAGE(bufoff, gbase, voff) do { _Pragma("unroll") for (int _i = 0; _i < 2; ++_i) \
        __builtin_amdgcn_global_load_lds((const unsigned*)((const char*)(gbase) + (voff)[_i]), (LAS unsigned*)(lds + (bufoff) + ldsw + _i * 8192), 16, 0, 0); } while (0)
#define PG8_LDA(dst, b, h) do { _Pragma("unroll") for (int m = 0; m < 4; ++m) _Pragma("unroll") for (int k = 0; k < 2; ++k) dst[m][k] = *(const LAS bf16x8*)(lds + PG8_SA(b, h) + aoff + m * 2048 + k * 1024); } while (0)
#define PG8_LDB(dst, b, h) do { _Pragma("unroll") for (int n = 0; n < 2; ++n) _Pragma("unroll") for (int k = 0; k < 2; ++k) dst[n][k] = *(const LAS bf16x8*)(lds + PG8_SB(b, h) + boff + n * 2048 + k * 1024); } while (0)
#define PG8_MMA(ai, bj, At, Bt) do { __builtin_amdgcn_s_setprio(1); _Pragma("unroll") for (int m = 0; m < 4; ++m) _Pragma("unroll") for (int n = 0; n < 2; ++n) _Pragma("unroll") for (int k = 0; k < 2; ++k) \
        acc[ai][bj][m][n] = __builtin_amdgcn_mfma_f32_16x16x32_bf16(Bt[n][k], At[m][k], acc[ai][bj][m][n], 0, 0, 0); __builtin_amdgcn_s_setprio(0); } while (0)
#define PG8_WAIT_V(n) asm volatile("s_waitcnt vmcnt(" #n ")" ::: "memory")
#define PG8_WAIT_L(n) asm volatile("s_waitcnt lgkmcnt(" #n ")" ::: "memory")
#define PG8_BAR __builtin_amdgcn_s_barrier()
#define PG8_SCHED __builtin_amdgcn_sched_barrier(0)
    Unit cur, nxt; int ui = 0;
    if (!S.next(0, cur)) return;
    f32x4 acc[2][2][4][2];
#pragma unroll
    for (int a = 0; a < 2; ++a)
#pragma unroll
        for (int b = 0; b < 2; ++b)
#pragma unroll
            for (int m = 0; m < 4; ++m)
#pragma unroll
                for (int n = 0; n < 2; ++n) acc[a][b][m][n] = (f32x4){0.f, 0.f, 0.f, 0.f};
    bf16x8 At[4][2], B0[2][2], B1[2][2];
    const char* cA = (const char*)g.A + (size_t)cur.pm * tstepA; const char* cB = (const char*)g.Bt + (size_t)cur.pn * tstepB;
    PG8_STAGE(PG8_SB(0, 0), cB, voffB); PG8_STAGE(PG8_SB(0, 1), cB + hstepB, voffB); PG8_STAGE(PG8_SA(0, 0), cA, voffA); PG8_STAGE(PG8_SA(0, 1), cA + hstepA, voffA);
    if (wr == 1) PG8_BAR;
    PG8_WAIT_V(2); PG8_BAR;
    PG8_STAGE(PG8_SB(1, 0), cB + kstepB, voffB); PG8_STAGE(PG8_SA(1, 0), cA + kstepA, voffA); PG8_STAGE(PG8_SB(1, 1), cB + hstepB + kstepB, voffB);
    PG8_WAIT_V(6); PG8_BAR;
    for (;;) {
        const bool has_next = S.next(ui + 1, nxt);
        const char* nA = has_next ? (const char*)g.A + (size_t)nxt.pm * tstepA : cA; const char* nB = has_next ? (const char*)g.Bt + (size_t)nxt.pn * tstepB : cB;
        for (int t = 0; t < nt; t += 2) {
            const bool last = (t == nt - 2);
            const char* a1 = cA + (size_t)(t + 1) * kstepA;
            const char* a2 = last ? nA : cA + (size_t)(t + 2) * kstepA; const char* b2 = last ? nB : cB + (size_t)(t + 2) * kstepB;
            const char* a3 = a2 + kstepA; const char* b3 = b2 + kstepB;
            PG8_LDB(B0, 0, 0); PG8_LDB(B1, 0, 1); PG8_SCHED; PG8_LDA(At, 0, 0); PG8_STAGE(PG8_SA(1, 1), a1 + hstepA, voffA);
            PG8_WAIT_V(8); PG8_WAIT_L(0); PG8_BAR; PG8_MMA(0, 0, At, B0); PG8_MMA(0, 1, At, B1); PG8_BAR; PG8_SCHED;
            PG8_LDA(At, 0, 1); PG8_STAGE(PG8_SB(0, 0), b2, voffB); PG8_STAGE(PG8_SB(0, 1), b2 + hstepB, voffB); PG8_STAGE(PG8_SA(0, 0), a2, voffA);
            PG8_WAIT_V(8); PG8_WAIT_L(0); PG8_BAR; PG8_MMA(1, 0, At, B0); PG8_MMA(1, 1, At, B1); PG8_BAR; PG8_SCHED;
            PG8_LDB(B0, 1, 0); PG8_LDB(B1, 1, 1); PG8_SCHED; PG8_LDA(At, 1, 0); PG8_STAGE(PG8_SA(0, 1), a2 + hstepA, voffA);
            PG8_WAIT_V(8); PG8_WAIT_L(0); PG8_BAR; PG8_MMA(0, 0, At, B0); PG8_MMA(0, 1, At, B1); PG8_BAR; PG8_SCHED;
            PG8_LDA(At, 1, 1); PG8_STAGE(PG8_SB(1, 0), b3, voffB); PG8_STAGE(PG8_SB(1, 1), b3 + hstepB, voffB); PG8_STAGE(PG8_SA(1, 0), a3, voffA);
            PG8_WAIT_V(8); PG8_WAIT_L(0); PG8_BAR; PG8_MMA(1, 0, At, B0); PG8_MMA(1, 1, At, B1); PG8_BAR; PG8_SCHED;
        }
        if (wr == 0) PG8_BAR;
        E(acc, cur, wr, wc, fr, fq);
        if (!has_next) break;
#pragma unroll
        for (int a = 0; a < 2; ++a)
#pragma unroll
            for (int b = 0; b < 2; ++b)
#pragma unroll
                for (int m = 0; m < 4; ++m)
#pragma unroll
                    for (int n = 0; n < 2; ++n) acc[a][b][m][n] = (f32x4){0.f, 0.f, 0.f, 0.f};
        cur = nxt; cA = nA; cB = nB; ++ui;
        if (wr == 1) PG8_BAR;
    }
    PG8_WAIT_V(0);
    PG8_BAR;
#undef PG8_SA
#undef PG8_SB
#undef PG8_STAGE
#undef PG8_LDA
#undef PG8_LDB
#undef PG8_MMA
#undef PG8_WAIT_V
#undef PG8_WAIT_L
#undef PG8_BAR
#undef PG8_SCHED
}
}

constexpr int BATCH = 32, SEQ = 2048, DM = 1024, NTOK = BATCH * SEQ, NMEM = 256, NH = 12, HD = 64, MAINW = 768;
constexpr int AIN = 1444, AINP = 1536, DFF = 2816, NCMP = 127;
constexpr int HALF_TOK = NTOK / 2;
constexpr float ALPHA = 1.4142135623730951f;
constexpr float LN_EPS = 1e-5f;
constexpr int P_Q = 0, P_KC = 768, P_VC = 832, P_KS = 896, P_VS = 960, P_KW = 1024, P_VW = 1088, P_QM = 1152, P_G = 1408;
constexpr size_t MiB = 1u << 20;
constexpr size_t WS_WAIN = 0 * MiB, WS_WAMKV = 3 * MiB, WS_WAOUT = 4 * MiB, WS_WSKV = 6 * MiB, WS_WBIN = 9 * MiB, WS_WBMKV = 11 * MiB, WS_WBOUT = 12 * MiB;
constexpr size_t WS_WFIN = 14 * MiB  , WS_WFOUT = 36 * MiB  , WS_WC1K = 47 * MiB, WS_WC1V = 48 * MiB, WS_WMKV = 49 * MiB  ;
constexpr size_t WS_CTL = 51 * MiB, CTL_BYTES = 16384;
constexpr size_t WS_MEMB = 52 * MiB, WS_MKV = 68 * MiB  , WS_CMPH = 84 * MiB, WS_KCMP = 92 * MiB, WS_VCMP = 93 * MiB, WS_CBIAS = 94 * MiB, WS_SEL = 94 * MiB + 65536, WS_KMEAN = 95 * MiB;
constexpr size_t WS_XB = 96 * MiB, WS_BIG = 226 * MiB;
constexpr size_t BIG_P = 0, BIG_O0 = 193 * MiB, BIG_H = 0, BIG_TAILA = 352 * MiB, BIG_HEADA = 374 * MiB, BIG_HEADB = 396 * MiB, BIG_KV = 0, BIG_Q1 = 193 * MiB, BIG_O1 = 321 * MiB;
constexpr size_t WS_NEED = WS_BIG + 449 * MiB;

constexpr int LDS_BYTES = 147456;
constexpr int NTHR = 512;

struct Params {
    const float* in[24];
    float* out;
    unsigned char* ws;
    int ph_lo, ph_hi;
};
enum { I_X = 0, I_MEM, I_RELB, I_AWIN, I_PEK, I_W1K, I_W2K, I_PEV, I_W1V, I_W2V, I_AWMKV, I_AWOUT, I_SWKV, I_BWIN, I_BWMKV, I_BWOUT, I_LN1G, I_LN1B, I_LN2G, I_LN2B, I_FWIN, I_FCW, I_FCB, I_FWOUT };

namespace att {
constexpr int ROWB = 144, TILEB = 64 * ROWB, VROWB = 192, VTILEB = 64 * VROWB;
constexpr float NEG = -1e30f;
constexpr float LOG2E = 1.4426950408889634f;
constexpr float SC2 = 0.125f * LOG2E;
typedef short v4i16_t __attribute__((ext_vector_type(4)));

__device__ __forceinline__ f32x16 zero16() { f32x16 z;
#pragma unroll
    for (int i = 0; i < 16; ++i) z[i] = 0.f; return z; }

__device__ __forceinline__ void qk_tile(f32x16& p0, f32x16& p1, const LAS unsigned char* Kt, const bf16x8 (&qr)[4], int r32, int hi, float cinit = 0.f) {
    const LAS unsigned char* kb = Kt + r32 * ROWB + hi * 16;
#pragma unroll
    for (int i = 0; i < 16; ++i) { p0[i] = cinit; p1[i] = cinit; }
#pragma unroll
    for (int d0 = 0; d0 < 4; ++d0) {
        const bf16x8 k0 = *(const LAS bf16x8*)(kb + d0 * 32);
        const bf16x8 k1 = *(const LAS bf16x8*)(kb + 32 * ROWB + d0 * 32);
        p0 = __builtin_amdgcn_mfma_f32_32x32x16_bf16(k0, qr[d0], p0, 0, 0, 0);
        p1 = __builtin_amdgcn_mfma_f32_32x32x16_bf16(k1, qr[d0], p1, 0, 0, 0);
    }
}
__device__ __forceinline__ s16x4 vtr(const LAS unsigned char* p) { return __builtin_bit_cast(s16x4, __builtin_amdgcn_ds_read_tr16_b64_v4i16((LAS v4i16_t*)p)); }
__device__ __forceinline__ void pv_tile(f32x16& o0, f32x16& o1, const LAS unsigned char* Vt, const f32x16& p0, const f32x16& p1, int lane) {
    const int hi = lane >> 5, g1 = (lane >> 4) & 1, i = lane & 15, q_ = i >> 2, p_ = i & 3;
    const LAS unsigned char* vb = Vt + (4 * hi + q_) * VROWB + (16 * g1 + 4 * p_) * 2;
#pragma unroll
    for (int s = 0; s < 4; ++s) {
        u32x4 w;
        if (s < 2) { const int b = 8 * (s & 1); w.x = cvt_pk_bf16(p0[b + 0], p0[b + 1]); w.y = cvt_pk_bf16(p0[b + 2], p0[b + 3]); w.z = cvt_pk_bf16(p0[b + 4], p0[b + 5]); w.w = cvt_pk_bf16(p0[b + 6], p0[b + 7]); }
        else       { const int b = 8 * (s & 1); w.x = cvt_pk_bf16(p1[b + 0], p1[b + 1]); w.y = cvt_pk_bf16(p1[b + 2], p1[b + 3]); w.z = cvt_pk_bf16(p1[b + 4], p1[b + 5]); w.w = cvt_pk_bf16(p1[b + 6], p1[b + 7]); }
        const bf16x8 pf = __builtin_bit_cast(bf16x8, w);
#pragma unroll
        for (int dh = 0; dh < 2; ++dh) {
            const s16x4 lo = vtr(vb + (16 * s) * VROWB + dh * 64);
            const s16x4 h4 = vtr(vb + (16 * s + 8) * VROWB + dh * 64);
            const bf16x8 vf = (bf16x8){lo[0], lo[1], lo[2], lo[3], h4[0], h4[1], h4[2], h4[3]};
            if (dh == 0) o0 = __builtin_amdgcn_mfma_f32_32x32x16_bf16(vf, pf, o0, 0, 0, 0);
            else         o1 = __builtin_amdgcn_mfma_f32_32x32x16_bf16(vf, pf, o1, 0, 0, 0);
        }
    }
}
struct Acc { float m, l; f32x16 o0, o1; };
__device__ __forceinline__ void acc_init(Acc& A) { A.m = NEG; A.l = 0.f; A.o0 = zero16(); A.o1 = zero16(); }
constexpr float THR_RAW = 8.0f / SC2;
__device__ __forceinline__ void sm_update(Acc& A, f32x16& p0, f32x16& p1) {
    float m0 = fmaxf(p0[0], p1[0]), m1 = fmaxf(p0[1], p1[1]);
#pragma unroll
    for (int r = 2; r < 16; r += 2) { m0 = fmaxf(fmaxf(m0, p0[r]), p1[r]); m1 = fmaxf(fmaxf(m1, p0[r + 1]), p1[r + 1]); }
    float mx = fmaxf(m0, m1);
    mx = fmaxf(mx, __shfl_xor(mx, 32));
    if (__any(mx > A.m + THR_RAW)) {
        const float mn = fmaxf(A.m, mx);
        const float alpha = __builtin_amdgcn_exp2f((A.m - (mn < -5e29f ? 0.f : mn)) * SC2);
        A.l *= alpha; A.m = mn;
#pragma unroll
        for (int r = 0; r < 16; ++r) { A.o0[r] *= alpha; A.o1[r] *= alpha; }
    }
    const float msc = (A.m < -5e29f ? 0.f : A.m) * SC2;
    float rs0 = 0.f, rs1 = 0.f;
#pragma unroll
    for (int r = 0; r < 16; ++r) {
        const float e0 = __builtin_amdgcn_exp2f(p0[r] * SC2 - msc);
        const float e1 = __builtin_amdgcn_exp2f(p1[r] * SC2 - msc);
        p0[r] = e0; p1[r] = e1; rs0 += e0; rs1 += e1;
    }
    A.l += rs0 + rs1;
}
__device__ __forceinline__ float rowmax32(const f32x16& p0, const f32x16& p1) {
    float m0 = fmaxf(p0[0], p1[0]), m1 = fmaxf(p0[1], p1[1]), m2 = fmaxf(p0[2], p1[2]), m3 = fmaxf(p0[3], p1[3]);
#pragma unroll
    for (int r = 4; r < 16; r += 4) { m0 = fmaxf(fmaxf(m0, p0[r]), p1[r]); m1 = fmaxf(fmaxf(m1, p0[r + 1]), p1[r + 1]); m2 = fmaxf(fmaxf(m2, p0[r + 2]), p1[r + 2]); m3 = fmaxf(fmaxf(m3, p0[r + 3]), p1[r + 3]); }
    return fmaxf(fmaxf(m0, m1), fmaxf(m2, m3));
}
__device__ __forceinline__ void sm_update2(Acc& A, Acc& B, f32x16& a0, f32x16& a1, f32x16& b0, f32x16& b1) {
    float mxa = rowmax32(a0, a1), mxb = rowmax32(b0, b1);
    mxa = fmaxf(mxa, __shfl_xor(mxa, 32)); mxb = fmaxf(mxb, __shfl_xor(mxb, 32));
    if (__any((mxa > A.m + THR_RAW) || (mxb > B.m + THR_RAW))) {
        const float mna = fmaxf(A.m, mxa), mnb = fmaxf(B.m, mxb);
        const float ala = __builtin_amdgcn_exp2f((A.m - (mna < -5e29f ? 0.f : mna)) * SC2), alb = __builtin_amdgcn_exp2f((B.m - (mnb < -5e29f ? 0.f : mnb)) * SC2);
        A.l *= ala; A.m = mna; B.l *= alb; B.m = mnb;
#pragma unroll
        for (int r = 0; r < 16; ++r) { A.o0[r] *= ala; B.o0[r] *= alb; A.o1[r] *= ala; B.o1[r] *= alb; }
    }
    const float msa = (A.m < -5e29f ? 0.f : A.m) * SC2, msb = (B.m < -5e29f ? 0.f : B.m) * SC2;
    float ra0 = 0.f, ra1 = 0.f, rb0 = 0.f, rb1 = 0.f;
#pragma unroll
    for (int r = 0; r < 16; ++r) {
        const float ea0 = __builtin_amdgcn_exp2f(a0[r] * SC2 - msa), eb0 = __builtin_amdgcn_exp2f(b0[r] * SC2 - msb);
        const float ea1 = __builtin_amdgcn_exp2f(a1[r] * SC2 - msa), eb1 = __builtin_amdgcn_exp2f(b1[r] * SC2 - msb);
        a0[r] = ea0; b0[r] = eb0; a1[r] = ea1; b1[r] = eb1; ra0 += ea0; rb0 += eb0; ra1 += ea1; rb1 += eb1;
    }
    A.l += ra0 + ra1; B.l += rb0 + rb1;
}
__device__ __forceinline__ float acc_inv(const Acc& A) { const float lt = A.l + __shfl_xor(A.l, 32); return 1.0f / fmaxf(lt, 1e-30f); }

__device__ __forceinline__ void apply_general(f32x16& p0, f32x16& p1, int dist0, const LAS float* tab, bool allow, int W) {
    const unsigned We = allow ? (unsigned)W : 0u;
#pragma unroll
    for (int r = 0; r < 16; ++r) {
        const int d_0 = dist0 - ((r & 3) + 8 * (r >> 2)), d_1 = d_0 - 32;
        const int i0 = ((unsigned)d_0 < We) ? min(d_0, 128) + 1 : 0, i1 = ((unsigned)d_1 < We) ? min(d_1, 128) + 1 : 0;
        p0[r] += tab[i0];
        p1[r] += tab[i1];
        if ((r & 3) == 3) __builtin_amdgcn_sched_barrier(0);
    }
}
__device__ __forceinline__ int rel_bucket(int n) {
    if (n < 16) return n;
    const float v = logf((float)n / 16.0f) / 2.0794415416798357f * 16.0f;
    int l = 16 + (int)v; return l < 31 ? l : 31;
}
__device__ __forceinline__ u32x4 tile_ld(const bf16_t* base, long ld, int row0, int rmin, int rmax, int tid) {
    int r = row0 + (tid >> 3); r = r < rmin ? rmin : (r > rmax ? rmax : r);
    return *(const u32x4*)(base + (long)r * ld + (tid & 7) * 8);
}
__device__ __forceinline__ void tile_st(LAS unsigned char* buf, u32x4 v, int tid) { *(LAS u32x4*)(buf + (tid >> 3) * ROWB + (tid & 7) * 16) = v; }
__device__ __forceinline__ void tile_stv(LAS unsigned char* buf, u32x4 v, int tid) { *(LAS u32x4*)(buf + (tid >> 3) * VROWB + (tid & 7) * 16) = v; }
__device__ __forceinline__ void load_q(bf16x8 (&qr)[4], const bf16_t* qrow, int hi) {
#pragma unroll
    for (int d0 = 0; d0 < 4; ++d0) qr[d0] = *(const bf16x8*)(qrow + d0 * 16 + hi * 8);
}
__device__ __forceinline__ void store_o(bf16_t* orow, const f32x16& o0, const f32x16& o1, int hi) {
#pragma unroll
    for (int g = 0; g < 4; ++g) {
        u32x2 w0, w1; w0.x = cvt_pk_bf16(o0[4 * g], o0[4 * g + 1]); w0.y = cvt_pk_bf16(o0[4 * g + 2], o0[4 * g + 3]);
        w1.x = cvt_pk_bf16(o1[4 * g], o1[4 * g + 1]); w1.y = cvt_pk_bf16(o1[4 * g + 2], o1[4 * g + 3]);
        *(u32x2*)(orow + 8 * g + 4 * hi) = w0; *(u32x2*)(orow + 32 + 8 * g + 4 * hi) = w1;
    }
}
__device__ __forceinline__ void add_prev_o(const bf16_t* orow, f32x16& o0, f32x16& o1, int hi) {
#pragma unroll
    for (int g = 0; g < 4; ++g) {
        const u32x2 w0 = *(const u32x2*)(orow + 8 * g + 4 * hi), w1 = *(const u32x2*)(orow + 32 + 8 * g + 4 * hi);
        o0[4 * g] += __uint_as_float(w0.x << 16); o0[4 * g + 1] += __uint_as_float(w0.x & 0xffff0000u); o0[4 * g + 2] += __uint_as_float(w0.y << 16); o0[4 * g + 3] += __uint_as_float(w0.y & 0xffff0000u);
        o1[4 * g] += __uint_as_float(w1.x << 16); o1[4 * g + 1] += __uint_as_float(w1.x & 0xffff0000u); o1[4 * g + 2] += __uint_as_float(w1.y << 16); o1[4 * g + 3] += __uint_as_float(w1.y & 0xffff0000u);
    }
}
__device__ __forceinline__ float sigmoidf(float x) { return 1.0f / (1.0f + __expf(-x)); }

constexpr int L_K0 = 0, L_K1 = TILEB, L_V0 = 2 * TILEB, L_V1 = 2 * TILEB + VTILEB, L_TAB = 2 * TILEB + 2 * VTILEB  , L_SIMP = 53248  , L_Q = 53248  , L_BKT = 131072  , L_MISC = 131072 + 1024  ;

__device__ __forceinline__ const LAS unsigned char* park_q(LAS unsigned char* lds, const bf16_t* q0, const bf16_t* q1, int wid, int lane, int hi) {
    LAS unsigned char* qp = lds + L_Q + wid * 8192 + lane * 16;
#pragma unroll
    for (int d0 = 0; d0 < 4; ++d0) { *(LAS bf16x8*)(qp + d0 * 1024) = *(const bf16x8*)(q0 + d0 * 16 + hi * 8); *(LAS bf16x8*)(qp + 4096 + d0 * 1024) = *(const bf16x8*)(q1 + d0 * 16 + hi * 8); }
    return qp;
}
__device__ __forceinline__ void fill_tab(LAS unsigned char* lds, const float* relb, int h0, int nh, int tid) {
    LAS float* tab = (LAS float*)(lds + L_TAB);
    const LAS int* bkt = (const LAS int*)(lds + L_BKT);
    for (int i = tid; i < nh * 130; i += NTHR) { const int hh = i / 130, d = i % 130; tab[hh * 132 + d] = d == 0 ? NEG : relb[bkt[d] * NH + h0 + hh] * 8.0f; }
}

template <int MODE>
struct TileInfo { bool want, near, allow; float cinit; };
template <int MODE>
__device__ __forceinline__ TileInfo<MODE> classify(int kt, int tw, unsigned selmask, int blkshift, int W, float b129) {
    TileInfo<MODE> ti; const int kbase = kt * 64;
    if (MODE == 0) { ti.want = true; ti.near = false; ti.allow = true; ti.cinit = 0.f; }
    else if (MODE == 1) { ti.allow = (selmask >> (kt >> blkshift)) & 1u; ti.want = (kbase <= tw + 31) && __any(ti.allow); ti.near = !(tw - (kbase + 63) >= 128); ti.cinit = ti.near ? 0.f : (ti.allow ? b129 : NEG); }
    else { ti.allow = true; ti.want = (kbase <= tw + 31) && (kbase + 63 >= tw - (W - 1)); ti.near = !((tw - (kbase + 63) >= 128) && (tw + 31 - kbase < W)); ti.cinit = ti.near ? 0.f : b129; }
    return ti;
}
template <int MODE, bool QREG>
__device__ __forceinline__ void seg2(Acc (&A)[2], LAS unsigned char* lds, const bf16_t* Kg, const bf16_t* Vg, long ld, int rmax, int lo, int hi_t,
                                     const LAS unsigned char* qp  , int t0  , int tw0, unsigned sel0, unsigned sel1, int blkshift, int W, const LAS float* tab, int tid) {
    const int lane = tid & 63, r32 = lane & 31, hi = lane >> 5;
    if (lo >= hi_t) return;
    {
        const u32x4 k0 = tile_ld(Kg, ld, lo * 64, 0, rmax, tid), v0 = tile_ld(Vg, ld, lo * 64, 0, rmax, tid);
        __syncthreads();
        tile_st(lds + L_K0, k0, tid); tile_stv(lds + L_V0, v0, tid);
        __syncthreads();
    }
    const float b129 = (MODE == 0) ? 0.f : tab[129];
    const int g1 = (lane >> 4) & 1, i16 = lane & 15, q_ = i16 >> 2, p_ = i16 & 3;
    bf16x8 qra[4], qrb[4];
    if (QREG) {
#pragma unroll
        for (int d0 = 0; d0 < 4; ++d0) { qra[d0] = *(const LAS bf16x8*)(qp + d0 * 1024); qrb[d0] = *(const LAS bf16x8*)(qp + 4096 + d0 * 1024); }
    }
    int cur = 0;
    for (int kt = lo; kt < hi_t; ++kt) {
        const bool more1 = kt + 1 < hi_t;
        u32x4 kreg, vreg;
        if (more1) { kreg = tile_ld(Kg, ld, (kt + 1) * 64, 0, rmax, tid); vreg = tile_ld(Vg, ld, (kt + 1) * 64, 0, rmax, tid); }
        TileInfo<MODE> ta = classify<MODE>(kt, tw0, sel0, blkshift, W, b129), tb = classify<MODE>(kt, tw0 + 32, sel1, blkshift, W, b129);
        if (ta.want || tb.want) {
            if (!ta.want) { ta.cinit = NEG; ta.near = false; }
            if (!tb.want) { tb.cinit = NEG; tb.near = false; }
            const LAS unsigned char* Kt = lds + (cur ? L_K1 : L_K0); const LAS unsigned char* Vt = lds + (cur ? L_V1 : L_V0);
            f32x16 a0, a1, b0, b1;
#pragma unroll
            for (int i = 0; i < 16; ++i) { a0[i] = ta.cinit; a1[i] = ta.cinit; b0[i] = tb.cinit; b1[i] = tb.cinit; }
            const LAS unsigned char* kb = Kt + r32 * ROWB + hi * 16;
#pragma unroll
            for (int d0 = 0; d0 < 4; ++d0) {
                const bf16x8 k0 = *(const LAS bf16x8*)(kb + d0 * 32);
                const bf16x8 k1 = *(const LAS bf16x8*)(kb + 32 * ROWB + d0 * 32);
                const bf16x8 qa = QREG ? qra[d0] : *(const LAS bf16x8*)(qp + d0 * 1024), qb_ = QREG ? qrb[d0] : *(const LAS bf16x8*)(qp + 4096 + d0 * 1024);
                a0 = __builtin_amdgcn_mfma_f32_32x32x16_bf16(k0, qa, a0, 0, 0, 0);
                b0 = __builtin_amdgcn_mfma_f32_32x32x16_bf16(k0, qb_, b0, 0, 0, 0);
                a1 = __builtin_amdgcn_mfma_f32_32x32x16_bf16(k1, qa, a1, 0, 0, 0);
                b1 = __builtin_amdgcn_mfma_f32_32x32x16_bf16(k1, qb_, b1, 0, 0, 0);
            }
            if (MODE != 0) {
                if (ta.near) apply_general(a0, a1, t0 - kt * 64 - 4 * hi, tab, ta.allow, W);
                if (tb.near) apply_general(b0, b1, t0 + 32 - kt * 64 - 4 * hi, tab, tb.allow, W);
            }
            sm_update2(A[0], A[1], a0, a1, b0, b1);
            const LAS unsigned char* vb = Vt + (4 * hi + q_) * VROWB + (16 * g1 + 4 * p_) * 2;
#pragma unroll
            for (int s = 0; s < 4; ++s) {
                const int bs = 8 * (s & 1);
                u32x4 wa, wb;
                if (s < 2) { wa.x = cvt_pk_bf16(a0[bs + 0], a0[bs + 1]); wa.y = cvt_pk_bf16(a0[bs + 2], a0[bs + 3]); wa.z = cvt_pk_bf16(a0[bs + 4], a0[bs + 5]); wa.w = cvt_pk_bf16(a0[bs + 6], a0[bs + 7]);
                             wb.x = cvt_pk_bf16(b0[bs + 0], b0[bs + 1]); wb.y = cvt_pk_bf16(b0[bs + 2], b0[bs + 3]); wb.z = cvt_pk_bf16(b0[bs + 4], b0[bs + 5]); wb.w = cvt_pk_bf16(b0[bs + 6], b0[bs + 7]); }
                else       { wa.x = cvt_pk_bf16(a1[bs + 0], a1[bs + 1]); wa.y = cvt_pk_bf16(a1[bs + 2], a1[bs + 3]); wa.z = cvt_pk_bf16(a1[bs + 4], a1[bs + 5]); wa.w = cvt_pk_bf16(a1[bs + 6], a1[bs + 7]);
                             wb.x = cvt_pk_bf16(b1[bs + 0], b1[bs + 1]); wb.y = cvt_pk_bf16(b1[bs + 2], b1[bs + 3]); wb.z = cvt_pk_bf16(b1[bs + 4], b1[bs + 5]); wb.w = cvt_pk_bf16(b1[bs + 6], b1[bs + 7]); }
                const bf16x8 pfa = __builtin_bit_cast(bf16x8, wa), pfb = __builtin_bit_cast(bf16x8, wb);
#pragma unroll
                for (int dh = 0; dh < 2; ++dh) {
                    const s16x4 lo4 = vtr(vb + (16 * s) * VROWB + dh * 64);
                    const s16x4 h4 = vtr(vb + (16 * s + 8) * VROWB + dh * 64);
                    const bf16x8 vf = (bf16x8){lo4[0], lo4[1], lo4[2], lo4[3], h4[0], h4[1], h4[2], h4[3]};
                    if (dh == 0) { A[0].o0 = __builtin_amdgcn_mfma_f32_32x32x16_bf16(vf, pfa, A[0].o0, 0, 0, 0); A[1].o0 = __builtin_amdgcn_mfma_f32_32x32x16_bf16(vf, pfb, A[1].o0, 0, 0, 0); }
                    else         { A[0].o1 = __builtin_amdgcn_mfma_f32_32x32x16_bf16(vf, pfa, A[0].o1, 0, 0, 0); A[1].o1 = __builtin_amdgcn_mfma_f32_32x32x16_bf16(vf, pfb, A[1].o1, 0, 0, 0); }
                }
            }
        }
        if (more1) { tile_st(lds + (cur ? L_K0 : L_K1), kreg, tid); tile_stv(lds + (cur ? L_V0 : L_V1), vreg, tid); }
        __syncthreads();
        cur ^= 1;
    }
}
}

struct Ctx { int tid, lane, wid, gtid, gsz, gw, ngw; };

template <int MAP>
__device__ __forceinline__ void xpose_w(const Ctx& c, const float* W, int K, int N, bf16_t* WT, int Ndst, int dst_off = 0) {
    const int nk = K >> 6; const long total = (long)Ndst * nk;
    for (long i = c.gtid; i < total; i += c.gsz) {
        const int n = (int)(i % Ndst), kc = (int)(i / Ndst);
        int src = n;
        if (MAP == 1) { if (n >= 1152 && n < 1408) src = 1188 + (n - 1152); else if (n >= 1408 && n < 1444) src = 1152 + (n - 1408); else if (n >= 1444) src = -1; }
        else if (MAP == 2) { const int tl = n >> 8, wi = n & 255; src = wi < 128 ? tl * 128 + wi : 2816 + tl * 128 + (wi - 128); }
        else if (n >= N) src = -1;
        bf16_t* dst = WT + (size_t)(dst_off + n) * K + kc * 64;
        if (src < 0) {
#pragma unroll
            for (int q = 0; q < 8; ++q) *(u32x4*)(dst + q * 8) = (u32x4){0u, 0u, 0u, 0u};
        } else {
            const float* s = W + (size_t)(kc * 64) * N + src;
            float v[64];
#pragma unroll
            for (int k = 0; k < 64; ++k) v[k] = s[(size_t)k * N];
#pragma unroll
            for (int q = 0; q < 8; ++q) {
                u32x4 w; w.x = cvt_pk_bf16(v[8 * q], v[8 * q + 1]); w.y = cvt_pk_bf16(v[8 * q + 2], v[8 * q + 3]); w.z = cvt_pk_bf16(v[8 * q + 4], v[8 * q + 5]); w.w = cvt_pk_bf16(v[8 * q + 6], v[8 * q + 7]);
                *(u32x4*)(dst + q * 8) = w;
            }
        }
    }
}
__device__ __forceinline__ void cvt_rows(const Ctx& c, const float* X, bf16_t* XB, long nelem) {
    const long n8 = nelem >> 3;
    for (long i0 = c.gtid; i0 < n8; i0 += 4l * c.gsz) {
        f32x4 a[4], b[4];
#pragma unroll
        for (int u = 0; u < 4; ++u) { const long i = i0 + (long)u * c.gsz; if (i < n8) { a[u] = __builtin_nontemporal_load((const f32x4*)(X + i * 8)); b[u] = __builtin_nontemporal_load((const f32x4*)(X + i * 8 + 4)); } }
#pragma unroll
        for (int u = 0; u < 4; ++u) { const long i = i0 + (long)u * c.gsz; if (i < n8) {
            u32x4 w; w.x = cvt_pk_bf16(a[u][0], a[u][1]); w.y = cvt_pk_bf16(a[u][2], a[u][3]); w.z = cvt_pk_bf16(b[u][0], b[u][1]); w.w = cvt_pk_bf16(b[u][2], b[u][3]);
            *(u32x4*)(XB + i * 8) = w; } }
    }
}
__device__ __forceinline__ void prep_late(const Params& p, const Ctx& c) {
    unsigned char* ws = p.ws;
    xpose_w<0>(c, p.in[I_AWOUT], DM, DM, (bf16_t*)(ws + WS_WAOUT), DM);
    xpose_w<0>(c, p.in[I_SWKV], DM, 1536, (bf16_t*)(ws + WS_WSKV), 1536);
    xpose_w<0>(c, p.in[I_BWIN], DM, DM, (bf16_t*)(ws + WS_WBIN), DM);
    xpose_w<0>(c, p.in[I_BWOUT], DM, DM, (bf16_t*)(ws + WS_WBOUT), DM);
    for (int l = 0; l < 2; ++l) {
        xpose_w<2>(c, p.in[I_FWIN] + (size_t)l * DM * 2 * DFF, DM, 2 * DFF, (bf16_t*)(ws + WS_WFIN) + (size_t)l * 2 * DFF * DM, 2 * DFF);
        xpose_w<0>(c, p.in[I_FWOUT] + (size_t)l * DFF * DM, DFF, DM, (bf16_t*)(ws + WS_WFOUT) + (size_t)l * DM * DFF, DM);
    }
}
constexpr int LATE_FIRST_WG = 160;
__device__ __forceinline__ void phase_prep(const Params& p, const Ctx& c) {
    unsigned char* ws = p.ws;
    xpose_w<1>(c, p.in[I_AWIN], DM, AIN, (bf16_t*)(ws + WS_WAIN), AINP);
    xpose_w<0>(c, p.in[I_AWMKV], DM, 512, (bf16_t*)(ws + WS_WMKV), 512, 0);
    xpose_w<0>(c, p.in[I_BWMKV], DM, 512, (bf16_t*)(ws + WS_WMKV), 512, 512);
    xpose_w<0>(c, p.in[I_W1K], 2048, 256, (bf16_t*)(ws + WS_WC1K), 256);
    xpose_w<0>(c, p.in[I_W1V], 2048, 256, (bf16_t*)(ws + WS_WC1V), 256);
    if ((int)gridDim.x < LATE_FIRST_WG + 32) prep_late(p, c);
    cvt_rows(c, p.in[I_X], (bf16_t*)(ws + WS_XB), (long)NTOK * DM);
    cvt_rows(c, p.in[I_MEM], (bf16_t*)(ws + WS_MEMB), (long)BATCH * NMEM * DM);
    for (int o = c.gw; o < 512; o += c.ngw) {
        const int which = o >> 8, j = o & 255;
        const float* pe = p.in[which ? I_PEV : I_PEK]; const float* w1 = p.in[which ? I_W1V : I_W1K];
        float s = 0.f;
#pragma unroll 8
        for (int k = c.lane; k < 2048; k += 64) s += pe[k] * w1[(size_t)k * 256 + j];
#pragma unroll
        for (int sh = 1; sh < 64; sh <<= 1) s += __shfl_xor(s, sh);
        if (c.lane == 0) ((float*)(ws + WS_CBIAS))[which * 256 + j] = s;
    }
}
__device__ __forceinline__ void phase_cmp2(const Params& p, const Ctx& c) {
    unsigned char* ws = p.ws;
    for (int i = c.gtid; i < 2 * 4096 * 64; i += c.gsz) {
        const int which = i >> 18, m = (i >> 6) & 4095, d = i & 63;
        const float* hid = (const float*)(ws + WS_CMPH) + ((size_t)which * 4096 + m) * 256; const float* w2 = p.in[which ? I_W2V : I_W2K];
        float s = 0.f;
#pragma unroll 8
        for (int j = 0; j < 256; ++j) s += hid[j] * w2[j * 64 + d];
        if ((m & 127) == 127) s = 0.f;
        unsigned u = __float_as_uint(s); u = (u + 0x7fffu + ((u >> 16) & 1u)) >> 16;
        ((bf16_t*)(ws + (which ? WS_VCMP : WS_KCMP)))[(size_t)m * 64 + d] = (bf16_t)u;
    }
}
__device__ __forceinline__ void phase_ln(const Ctx& c, const float* y, const float* g, const float* bta, float* xf, bf16_t* xb) {
    for (int row = c.gw; row < NTOK; row += c.ngw) {
        const float* yr = y + (size_t)row * DM + c.lane * 4;
        f32x4 v[4]; float s = 0.f;
#pragma unroll
        for (int j = 0; j < 4; ++j) { v[j] = *(const f32x4*)(yr + 256 * j); s += (v[j][0] + v[j][1]) + (v[j][2] + v[j][3]); }
#pragma unroll
        for (int o = 1; o < 64; o <<= 1) s += __shfl_xor(s, o);
        const float mean = s * (1.0f / DM); float q = 0.f;
#pragma unroll
        for (int j = 0; j < 4; ++j) { v[j] = v[j] - mean; q += (v[j][0] * v[j][0] + v[j][1] * v[j][1]) + (v[j][2] * v[j][2] + v[j][3] * v[j][3]); }
#pragma unroll
        for (int o = 1; o < 64; o <<= 1) q += __shfl_xor(q, o);
        const float rstd = 1.0f / sqrtf(q * (1.0f / DM) + LN_EPS);
#pragma unroll
        for (int j = 0; j < 4; ++j) {
            const f32x4 gg = *(const f32x4*)(g + c.lane * 4 + 256 * j), bb = *(const f32x4*)(bta + c.lane * 4 + 256 * j);
            const f32x4 o = v[j] * rstd * gg + bb;
            if (xf) *(f32x4*)(xf + (size_t)row * DM + c.lane * 4 + 256 * j) = o;
            if (xb) { u32x2 w; w.x = cvt_pk_bf16(o[0], o[1]); w.y = cvt_pk_bf16(o[2], o[3]); *(u32x2*)(xb + (size_t)row * DM + c.lane * 4 + 256 * j) = w; }
        }
    }
}
__device__ __forceinline__ void unpack8(const u32x4 w, float (&f)[8]) {
    f[0] = __uint_as_float(w.x << 16); f[1] = __uint_as_float(w.x & 0xffff0000u); f[2] = __uint_as_float(w.y << 16); f[3] = __uint_as_float(w.y & 0xffff0000u);
    f[4] = __uint_as_float(w.z << 16); f[5] = __uint_as_float(w.z & 0xffff0000u); f[6] = __uint_as_float(w.w << 16); f[7] = __uint_as_float(w.w & 0xffff0000u);
}
__device__ __forceinline__ void ffn_fixup(const Ctx& c, unsigned char* big, const float* cw, const float* cbias, int pm) {
    const float* TAILA = (const float*)(big + BIG_TAILA); const float* HEADA = (const float*)(big + BIG_HEADA); const float* HEADB = (const float*)(big + BIG_HEADB); bf16_t* H = (bf16_t*)(big + BIG_H);
    constexpr int NCH = DFF / 8;
    for (int it = c.tid; it < 4 * 2 * NCH; it += NTHR) {
        const int ch = it % NCH, gi = it / NCH, i = gi & 1, G = pm * 4 + (gi >> 1), col = ch * 8;
        const bool first = ((G * 64) & (SEQ - 1)) == 0;
        float p0[8], p1[8], a0[8], a1[8], b[8], h[8];
#pragma unroll
        for (int j = 0; j < 8; ++j) { p0[j] = 0.f; p1[j] = 0.f; }
        if (!first) {
            const float* t0 = TAILA + ((size_t)(G - 1) * 2) * DFF + col;
#pragma unroll
            for (int j = 0; j < 8; ++j) { p0[j] = t0[j]; p1[j] = t0[DFF + j]; }
        }
        const float* ha = HEADA + ((size_t)G * 2) * DFF + col; const float* hb = HEADB + ((size_t)G * 2 + i) * DFF + col;
#pragma unroll
        for (int j = 0; j < 8; ++j) { a0[j] = ha[j]; a1[j] = ha[DFF + j]; b[j] = hb[j]; }
#pragma unroll
        for (int j = 0; j < 8; ++j) {
            const float am2 = i ? p1[j] : p0[j], am1 = i ? a0[j] : p1[j], a = i ? a1[j] : a0[j];
            const float pre = cw[col + j] * am2 + cw[DFF + col + j] * am1 + cw[2 * DFF + col + j] * a + cbias[col + j];
            h[j] = gelu_tanh(pre) * b[j];
        }
        u32x4 w; w.x = cvt_pk_bf16(h[0], h[1]); w.y = cvt_pk_bf16(h[2], h[3]); w.z = cvt_pk_bf16(h[4], h[5]); w.w = cvt_pk_bf16(h[6], h[7]);
        *(u32x4*)(H + (size_t)(G * 64 + i) * DFF + col) = w;
    }
}
__device__ __forceinline__ void phase_kmean(const Ctx& c, const bf16_t* KV, float* KM) {
    for (int it = c.gw; it < BATCH * 8 * 12; it += c.ngw) {
        const int cg_ = it % 12, bn = it / 12, ch = c.lane & 7, rs = c.lane >> 3;
        float s[8];
#pragma unroll
        for (int j = 0; j < 8; ++j) s[j] = 0.f;
        const bf16_t* src = KV + (size_t)bn * 256 * 1536 + cg_ * 64 + ch * 8;
#pragma unroll 4
        for (int r = rs; r < 256; r += 8) { float v[8]; unpack8(*(const u32x4*)(src + (size_t)r * 1536), v);
#pragma unroll
            for (int j = 0; j < 8; ++j) s[j] += v[j]; }
#pragma unroll
        for (int j = 0; j < 8; ++j) { s[j] += __shfl_xor(s[j], 8); s[j] += __shfl_xor(s[j], 16); s[j] += __shfl_xor(s[j], 32); }
        if (rs == 0) {
#pragma unroll
            for (int j = 0; j < 8; ++j) KM[(size_t)bn * 768 + cg_ * 64 + ch * 8 + j] = s[j] * (1.0f / 256.0f);
        }
    }
}

__device__ __forceinline__ void nsa1_unit(const Params& p, LAS unsigned char* lds, int b, int qb) {
    using namespace att;
    int tid_ = threadIdx.x; asm volatile("" : "+v"(tid_));
    const int tid = tid_, lane = tid & 63, r32 = lane & 31, hi = lane >> 5, wid = tid >> 6;
    unsigned char* ws = p.ws;
    const bf16_t* P = (const bf16_t*)(ws + WS_BIG + BIG_P); bf16_t* O = (bf16_t*)(ws + WS_BIG + BIG_O0);
    const bf16_t* KC = (const bf16_t*)(ws + WS_KCMP) + (size_t)b * 128 * 64; const bf16_t* VC = (const bf16_t*)(ws + WS_VCMP) + (size_t)b * 128 * 64;
    __syncthreads();
    tile_st(lds + L_K0, tile_ld(KC, 64, 0, 0, 127, tid), tid); tile_st(lds + L_K1, tile_ld(KC, 64, 64, 0, 127, tid), tid);
    tile_stv(lds + L_V0, tile_ld(VC, 64, 0, 0, 127, tid), tid); tile_stv(lds + L_V1, tile_ld(VC, 64, 64, 0, 127, tid), tid);
    fill_tab(lds, p.in[I_RELB], 0, NH, tid);
    __syncthreads();
    const int t = qb * 256 + wid * 32 + r32; const size_t row = (size_t)b * SEQ + t;
    LAS float* simp = (LAS float*)(lds + L_SIMP) + (wid * 32 + r32) * 33;
#pragma unroll
    for (int i = 0; i < 16; ++i) simp[2 * i + hi] = 0.f;
#pragma nounroll
    for (int h = 0; h < NH; ++h) {
        bf16x8 qr[4]; load_q(qr, P + row * AINP + P_Q + h * 64, hi);
        f32x16 pp[4];
        qk_tile(pp[0], pp[1], lds + L_K0, qr, r32, hi); qk_tile(pp[2], pp[3], lds + L_K1, qr, r32, hi);
        const LAS float* tab = (const LAS float*)(lds + L_TAB) + h * 132;
        float mx = NEG;
        const int tws = __builtin_amdgcn_readfirstlane(t - r32);
#pragma unroll
        for (int a = 0; a < 4; ++a) {
            if (tws >= 512 * a + 655) { const float bb = tab[129];
#pragma unroll
                for (int r = 0; r < 16; ++r) { const float s = pp[a][r] + bb; pp[a][r] = s; mx = fmaxf(mx, s); } }
            else if (tws < 512 * a) {
#pragma unroll
                for (int r = 0; r < 16; ++r) pp[a][r] = NEG; }
            else {
#pragma unroll
                for (int r = 0; r < 16; ++r) { const int n = (r & 3) + 8 * (r >> 2) + 4 * hi + 32 * a; const int d = t - 30 - 16 * n;
                    const float s = pp[a][r] + tab[min(max(d, 0), 129)]; pp[a][r] = s; mx = fmaxf(mx, s); } }
        }
        mx = fmaxf(mx, __shfl_xor(mx, 32));
        const bool dead = mx < -5e29f;
        const float msc = (dead ? 0.f : mx) * SC2;
        float sum = 0.f;
#pragma unroll
        for (int a = 0; a < 4; ++a)
#pragma unroll
            for (int r = 0; r < 16; ++r) { const float e = __builtin_amdgcn_exp2f(pp[a][r] * SC2 - msc); pp[a][r] = e; sum += e; }
        sum += __shfl_xor(sum, 32);
        const float inv = dead ? 0.f : 1.0f / fmaxf(sum, 1e-30f);
#pragma unroll
        for (int a = 0; a < 4; ++a)
#pragma unroll
            for (int r = 0; r < 16; ++r) pp[a][r] *= inv;
#pragma unroll
        for (int a = 0; a < 4; ++a)
#pragma unroll
            for (int g = 0; g < 4; ++g) {
                const float gs = (pp[a][4 * g] + pp[a][4 * g + 1]) + (pp[a][4 * g + 2] + pp[a][4 * g + 3]);
                const float lastv = pp[a][4 * g + 3];
                const float shifted = (g >= 1) ? pp[a][4 * (g - 1) + 3] : ((a >= 1) ? pp[(a >= 1) ? a - 1 : 0][15] : 0.f);
                const float snd = hi ? shifted : lastv;
                const float rcv = __shfl_xor(snd, 32);
                simp[8 * a + 2 * g + hi] += gs + rcv;
            }
        f32x16 o0 = zero16(), o1 = zero16();
        pv_tile(o0, o1, lds + L_V0, pp[0], pp[1], lane); pv_tile(o0, o1, lds + L_V1, pp[2], pp[3], lane);
        const float gate = sigmoidf(bf2f(P[row * AINP + P_G + h * 3 + 0]));
#pragma unroll
        for (int r = 0; r < 16; ++r) { o0[r] *= gate; o1[r] *= gate; }
        store_o(O + row * DM + h * 64, o0, o1, hi);
    }
    __syncthreads();
    const int cur = t >> 6; unsigned mask;
    if (cur < 16) mask = (2u << cur) - 1u;
    else {
        mask = 1u | (1u << cur) | (1u << (cur - 1));
        unsigned cand = ((1u << (cur - 1)) - 1u) & ~1u;
#pragma nounroll
        for (int k = 0; k < 13; ++k) {
            float best = -3e38f; int bi = 0;
#pragma nounroll
            for (int s = 1; s <= 29; ++s) { const float v = simp[s]; const bool take = ((cand >> s) & 1u) && (v > best); best = take ? v : best; bi = take ? s : bi; }
            mask |= 1u << bi; cand &= ~(1u << bi);
        }
    }
    if (hi == 0) ((unsigned*)(ws + WS_SEL))[row] = mask;
}
__device__ __forceinline__ void nsa2_unit(const Params& p, LAS unsigned char* lds, int b, int h0, int qb) {
    using namespace att;
    int tid_ = threadIdx.x; asm volatile("" : "+v"(tid_));
    const int tid = tid_, lane = tid & 63, r32 = lane & 31, hi = lane >> 5, wid = tid >> 6;
    unsigned char* ws = p.ws;
    const bf16_t* P = (const bf16_t*)(ws + WS_BIG + BIG_P); bf16_t* O = (bf16_t*)(ws + WS_BIG + BIG_O0);
    __syncthreads();
    fill_tab(lds, p.in[I_RELB], h0, 2, tid);
    const int h = h0 + (wid >> 2);
    const LAS float* tab = (const LAS float*)(lds + L_TAB) + (wid >> 2) * 132;
    const int tw0 = qb * 256 + (wid & 3) * 64, t0 = tw0 + r32; const size_t row0 = (size_t)b * SEQ + t0, row1 = row0 + 32;
    const LAS unsigned char* qp = park_q(lds, P + row0 * AINP + P_Q + h * 64, P + row1 * AINP + P_Q + h * 64, wid, lane, hi);
    const unsigned sel0 = ((const unsigned*)(ws + WS_SEL))[row0], sel1 = ((const unsigned*)(ws + WS_SEL))[row1];
    const bf16_t* Pb = P + (size_t)b * SEQ * AINP;
    Acc A[2]; acc_init(A[0]); acc_init(A[1]);
    seg2<1, false>(A, lds, Pb + P_KS, Pb + P_VS, AINP, SEQ - 1, 0, qb * 4 + 4, qp, t0, tw0, sel0, sel1, 0, 1 << 30, tab, tid);
#pragma unroll
    for (int s = 0; s < 2; ++s) {
        const size_t row = s ? row1 : row0;
        const float gs = sigmoidf(bf2f(P[row * AINP + P_G + h * 3 + 1])) * acc_inv(A[s]);
#pragma unroll
        for (int r = 0; r < 16; ++r) { A[s].o0[r] *= gs; A[s].o1[r] *= gs; }
        bf16_t* orow = O + row * DM + h * 64;
        add_prev_o(orow, A[s].o0, A[s].o1, hi); store_o(orow, A[s].o0, A[s].o1, hi);
        acc_init(A[s]);
    }
    const int wlo = qb * 4 - 8 < 0 ? 0 : qb * 4 - 8;
    seg2<2, false>(A, lds, Pb + P_KW, Pb + P_VW, AINP, SEQ - 1, wlo, qb * 4 + 4, qp, t0, tw0, 0u, 0u, 0, 512, tab, tid);
#pragma unroll
    for (int s = 0; s < 2; ++s) {
        const size_t row = s ? row1 : row0;
        const float gw = sigmoidf(bf2f(P[row * AINP + P_G + h * 3 + 2])) * acc_inv(A[s]);
#pragma unroll
        for (int r = 0; r < 16; ++r) { A[s].o0[r] *= gw; A[s].o1[r] *= gw; }
        bf16_t* orow = O + row * DM + h * 64;
        add_prev_o(orow, A[s].o0, A[s].o1, hi); store_o(orow, A[s].o0, A[s].o1, hi);
    }
}
__device__ __forceinline__ unsigned moba_select(const float* KM, const bf16x8 (&qr)[4], int b, int h, int qb, int hi) {
    float gt[7];
#pragma unroll
    for (int n = 0; n < 7; ++n) {
        float s = 0.f;
        if (n < qb) {
            const float* km = KM + ((size_t)(b * 8 + n) * NH + h) * 64 + hi * 8;
#pragma unroll
            for (int d0 = 0; d0 < 4; ++d0) { const f32x4 k0 = *(const f32x4*)(km + d0 * 16), k1 = *(const f32x4*)(km + d0 * 16 + 4);
                s += bf2f((unsigned short)qr[d0][0]) * k0[0] + bf2f((unsigned short)qr[d0][1]) * k0[1] + bf2f((unsigned short)qr[d0][2]) * k0[2] + bf2f((unsigned short)qr[d0][3]) * k0[3]
                   + bf2f((unsigned short)qr[d0][4]) * k1[0] + bf2f((unsigned short)qr[d0][5]) * k1[1] + bf2f((unsigned short)qr[d0][6]) * k1[2] + bf2f((unsigned short)qr[d0][7]) * k1[3]; }
        }
        s += __shfl_xor(s, 32);
        gt[n] = s;
    }
    unsigned sel = 1u << qb, cand = (1u << qb) - 1u;
#pragma nounroll
    for (int k = 0; k < 3; ++k) {
        float best = -3e38f; int bi = -1;
#pragma unroll
        for (int n = 0; n < 7; ++n) { const bool take = ((cand >> n) & 1u) && (gt[n] > best); best = take ? gt[n] : best; bi = take ? n : bi; }
        if (bi >= 0) { sel |= 1u << bi; cand &= ~(1u << bi); }
    }
    return sel;
}
__device__ __forceinline__ void moba_unit(const Params& p, LAS unsigned char* lds, int b, int h, int qp) {
    using namespace att;
    int tid_ = threadIdx.x; asm volatile("" : "+v"(tid_));
    const int tid = tid_, lane = tid & 63, r32 = lane & 31, hi = lane >> 5, wid = tid >> 6;
    unsigned char* ws = p.ws;
    const bf16_t* KV = (const bf16_t*)(ws + WS_BIG + BIG_KV); const bf16_t* Q = (const bf16_t*)(ws + WS_BIG + BIG_Q1); bf16_t* O = (bf16_t*)(ws + WS_BIG + BIG_O1);
    const float* KM = (const float*)(ws + WS_KMEAN);
    __syncthreads();
    fill_tab(lds, p.in[I_RELB], h, 1, tid);
    const LAS float* tab = (const LAS float*)(lds + L_TAB);
    const int qb = 2 * qp + (wid >> 2);
    const int tw0 = qb * 256 + (wid & 3) * 64, t0 = tw0 + r32; const size_t row0 = (size_t)b * SEQ + t0, row1 = row0 + 32;
    unsigned sel0, sel1;
    { bf16x8 qr[4]; load_q(qr, Q + row0 * DM + h * 64, hi); sel0 = moba_select(KM, qr, b, h, qb, hi); }
    { bf16x8 qr[4]; load_q(qr, Q + row1 * DM + h * 64, hi); sel1 = moba_select(KM, qr, b, h, qb, hi); }
    const LAS unsigned char* qp_ = park_q(lds, Q + row0 * DM + h * 64, Q + row1 * DM + h * 64, wid, lane, hi);
    const bf16_t* Kb = KV + (size_t)b * SEQ * 1536 + h * 64;
    Acc A[2]; acc_init(A[0]); acc_init(A[1]);
    seg2<1, true>(A, lds, Kb, Kb + MAINW, 1536, SEQ - 1, 0, qp * 8 + 8, qp_, t0, tw0, sel0, sel1, 2, 1 << 30, tab, tid);
#pragma unroll
    for (int s = 0; s < 2; ++s) {
        const float inv = acc_inv(A[s]);
#pragma unroll
        for (int r = 0; r < 16; ++r) { A[s].o0[r] *= inv; A[s].o1[r] *= inv; }
        store_o(O + (s ? row1 : row0) * DM + h * 64, A[s].o0, A[s].o1, hi);
    }
}
__device__ __forceinline__ void mem_unit(const Params& p, LAS unsigned char* lds, const bf16_t* Q, int ldq, int qcol, bf16_t* O, int kvcol, int b, int mh, int qq) {
    using namespace att;
    int tid_ = threadIdx.x; asm volatile("" : "+v"(tid_));
    const int tid = tid_, lane = tid & 63, r32 = lane & 31, hi = lane >> 5, wid = tid >> 6;
    const bf16_t* MKV = (const bf16_t*)(p.ws + WS_MKV) + (size_t)b * NMEM * 1024 + kvcol + mh * 64;
    const int tw0 = qq * 512 + wid * 64, t0 = tw0 + r32; const size_t row0 = (size_t)b * SEQ + t0, row1 = row0 + 32;
    __syncthreads();
    const LAS unsigned char* qp = park_q(lds, Q + row0 * ldq + qcol + mh * 64, Q + row1 * ldq + qcol + mh * 64, wid, lane, hi);
    Acc A[2]; acc_init(A[0]); acc_init(A[1]);
    seg2<0, true>(A, lds, MKV, MKV + 256, 1024, NMEM - 1, 0, 4, qp, t0, tw0, 0u, 0u, 0, 1 << 30, (const LAS float*)(lds + L_TAB), tid);
#pragma unroll
    for (int s = 0; s < 2; ++s) {
        const float inv = acc_inv(A[s]);
#pragma unroll
        for (int r = 0; r < 16; ++r) { A[s].o0[r] *= inv; A[s].o1[r] *= inv; }
        store_o(O + (s ? row1 : row0) * DM + MAINW + mh * 64, A[s].o0, A[s].o1, hi);
    }
}

#define XB_TMO      128
#define XB_XCNT(j)  (256  + 64 * (j))
#define XB_XSUB(j)  (1280 + 64 * (j))
#define XB_XGEN(j)  (2304 + 64 * (j))
#define XB_TOP      3328
#define XB_TOPGEN   3392
#define XCD_BAR_WORDS 3456
#define XB_SPIN_CAP (1u << 18)
__device__ __forceinline__ unsigned xb_ld(unsigned* p)              { return __hip_atomic_load(p, __ATOMIC_RELAXED, __HIP_MEMORY_SCOPE_AGENT); }
__device__ __forceinline__ unsigned xb_add(unsigned* p, unsigned v) { return __hip_atomic_fetch_add(p, v, __ATOMIC_RELAXED, __HIP_MEMORY_SCOPE_AGENT); }
__device__ __forceinline__ unsigned xb_xcc_id() { return (unsigned)__builtin_amdgcn_s_getreg((3 << 11) | 20) & 0xFu; }
#define XB_SPIN(cond, bar) do { unsigned _sp = 0; while (cond) { __builtin_amdgcn_s_sleep(1); \
    if ((++_sp & 255u) == 0u) { if (xb_ld(&(bar)[XB_TMO])) break; if (_sp > XB_SPIN_CAP) { atomicAdd(&(bar)[XB_TMO], 1u); break; } } } } while (0)
struct XcdBarrier { unsigned* bar; unsigned x; volatile LAS unsigned* st; };
__device__ __forceinline__ XcdBarrier xcd_barrier_post(unsigned* bar, volatile LAS unsigned* st) {
    XcdBarrier b; b.bar = bar; b.x = xb_xcc_id(); b.st = st;
    if (threadIdx.x == 0) (void)xb_add(&bar[XB_XCNT(b.x)], 1u);
    return b;
}
__device__ __forceinline__ void xcd_barrier_complete(unsigned* bar, unsigned x, unsigned& nloc, unsigned& nx) {
    const unsigned G = gridDim.x * gridDim.y * gridDim.z;
    unsigned sum, cnt, mine, sp = 0u;
    for (;;) {
        sum = 0u; cnt = 0u; mine = 0u;
#pragma unroll
        for (unsigned j = 0; j < 16; ++j) { const unsigned c = xb_ld(&bar[XB_XCNT(j)]); sum += c; cnt += (c > 0u) ? 1u : 0u; mine = (j == x) ? c : mine; }
        if (sum == G) break;
        __builtin_amdgcn_s_sleep(1);
        if ((++sp & 255u) == 0u) { if (xb_ld(&bar[XB_TMO])) break; if (sp > XB_SPIN_CAP) { atomicAdd(&bar[XB_TMO], 1u); break; } }
    }
    nloc = mine > 0u ? mine : 1u; nx = cnt > 0u ? cnt : 1u;
}
__device__ __forceinline__ void xcd_barrier(const XcdBarrier& b) {
    asm volatile("s_waitcnt vmcnt(0)" ::: "memory");
    __syncthreads();
    if (threadIdx.x == 0) {
        unsigned* bar = b.bar;
        __builtin_amdgcn_s_waitcnt(0);
        unsigned nloc = b.st[0], nx = b.st[1];
        if (nloc == 0u) { xcd_barrier_complete(bar, b.x, nloc, nx); b.st[0] = nloc; b.st[1] = nx; }
        const unsigned old = xb_add(&bar[XB_XSUB(b.x)], 1u);
        const unsigned gen = old / nloc;
        if (old + 1u == (gen + 1u) * nloc) {
            __builtin_amdgcn_fence(__ATOMIC_RELEASE, "agent");
            asm volatile("s_waitcnt vmcnt(0)" ::: "memory");
            const unsigned og = xb_add(&bar[XB_TOP], 1u);
            const unsigned tg = og / nx;
            if (og + 1u == (tg + 1u) * nx) xb_add(&bar[XB_TOPGEN], 1u);
            else XB_SPIN(xb_ld(&bar[XB_TOPGEN]) == tg, bar);
            __builtin_amdgcn_fence(__ATOMIC_ACQUIRE, "agent");
            xb_add(&bar[XB_XGEN(b.x)], 1u);
            asm volatile("s_waitcnt vmcnt(0)" ::: "memory");
        } else {
            XB_SPIN(xb_ld(&bar[XB_XGEN(b.x)]) == gen, bar);
            __builtin_amdgcn_fence(__ATOMIC_ACQUIRE, "agent");
            asm volatile("s_waitcnt vmcnt(0)" ::: "memory");
        }
    }
    __syncthreads();
}

enum { PH_PREP = 0, PH_A_GEMM, PH_A_CMP1, PH_A_CMP2, PH_A_NSA1, PH_A_NSA2, PH_A_OUT, PH_A_LN1, PH_A_F0, PH_A_FIX, PH_A_F1, PH_A_LN2,
       PH_B_GEMM, PH_B_KMEAN, PH_B_ATT, PH_B_OUT, PH_B_LN1, PH_B_F0, PH_B_FIX, PH_B_F1, PH_B_LN2, PH_COUNT };

struct GemmJob { pg8::Gemm g; int epi; void* O; const float* aux; const float* aux2; int ldc; int coff; };
__device__ __forceinline__ void set_job(GemmJob& J, const bf16_t* A, const bf16_t* Bt, int M, int N, int K, int lda, int epi, void* O, const float* aux, int ldc) {
    J.g.A = A; J.g.Bt = Bt; J.g.M = M; J.g.N = N; J.g.K = K; J.g.lda = lda; J.g.kstepA = 128; J.epi = epi; J.O = O; J.aux = aux; J.aux2 = nullptr; J.ldc = ldc; J.coff = 0;
}
__device__ __forceinline__ bool gemm_job(const Params& p, int ph, int j, GemmJob& J) {
    unsigned char* ws = p.ws;
    const bf16_t* XB = (const bf16_t*)(ws + WS_XB); const float* XF = (const float*)XB;
    unsigned char* big = ws + WS_BIG;
    const int layer = ph >= PH_B_GEMM ? 1 : 0;
    const bf16_t* Win = (const bf16_t*)(ws + WS_WFIN) + (size_t)layer * 2 * DFF * DM; const bf16_t* Wout = (const bf16_t*)(ws + WS_WFOUT) + (size_t)layer * DM * DFF;
    if (ph == PH_A_GEMM) {
        if (j == 0) { set_job(J, XB, (const bf16_t*)(ws + WS_WAIN), NTOK, AINP, DM, DM, 0, big + BIG_P, nullptr, AINP); return true; }
        return false;
    }
    if (ph == PH_A_CMP1) {
        if (j == 2) { set_job(J, (const bf16_t*)(ws + WS_MEMB), (const bf16_t*)(ws + WS_WMKV), BATCH * NMEM, 1024, DM, DM, 0, ws + WS_MKV, nullptr, 1024); J.coff = 32; return true; }
        if (j >= 3) return false;
        const bf16_t* P = (const bf16_t*)(big + BIG_P);
        set_job(J, P + (j ? P_VC : P_KC), (const bf16_t*)(ws + (j ? WS_WC1V : WS_WC1K)), 4096, 256, 2048, 16 * AINP, 1, (float*)(ws + WS_CMPH) + (size_t)j * 4096 * 256, (const float*)(ws + WS_CBIAS) + j * 256, 256);
        J.g.kstepA = AINP * 2; J.coff = j * 16; return true;
    }
    if (ph == PH_A_OUT) { if (j) return false; set_job(J, (const bf16_t*)(big + BIG_O0), (const bf16_t*)(ws + WS_WAOUT), NTOK, DM, DM, DM, 2, p.out, p.in[I_X], DM); return true; }
    if (ph == PH_B_OUT) { if (j) return false; set_job(J, (const bf16_t*)(big + BIG_O1), (const bf16_t*)(ws + WS_WBOUT), NTOK, DM, DM, DM, 4, p.out, XF, DM); return true; }
    if (ph == PH_B_GEMM) {
        if (j == 0) { set_job(J, XB, (const bf16_t*)(ws + WS_WSKV), NTOK, 1536, DM, DM, 0, big + BIG_KV, nullptr, 1536); return true; }
        if (j == 1) { set_job(J, XB, (const bf16_t*)(ws + WS_WBIN), NTOK, DM, DM, DM, 0, big + BIG_Q1, nullptr, DM); return true; }
        return false;
    }
    const int f = layer ? ph - PH_B_F0 : ph - PH_A_F0;
    if (j) return false;
    if (f == 0) { set_job(J, XB, Win, NTOK, 2 * DFF, DM, DM, 3, big + BIG_H, p.in[I_FCW] + (size_t)layer * 3 * DFF, DFF); J.aux2 = p.in[I_FCB] + (size_t)layer * DFF; return true; }
    if (f == 2) { set_job(J, (const bf16_t*)(big + BIG_H), Wout, NTOK, DM, DFF, DFF, 4, p.out, XF, DM); return true; }
    return false;
}
__device__ __forceinline__ bool is_gemm_phase(int ph) {
    return ph == PH_A_GEMM || ph == PH_A_CMP1 || ph == PH_A_OUT || ph == PH_B_OUT || ph == PH_B_GEMM || ph == PH_A_F0 || ph == PH_A_F1 || ph == PH_B_F0 || ph == PH_B_F1;
}
template <int JJ>
__device__ __forceinline__ void run_gemm_job(const Params& p, LAS unsigned char* lds, int ph) {
    GemmJob J;
    if (!gemm_job(p, ph, JJ, J)) return;
    pg8::StaticOrder S; S.init(J.g.M, J.g.N, (int)gridDim.x, (int)blockIdx.x - J.coff);
    if (J.epi == 0) { pg8::EpiBf16 E{(bf16_t*)J.O, J.ldc}; pg8::gemm_phase<pg8::EpiBf16>(lds, J.g, S, E); }
    else if (J.epi == 1) { pg8::EpiF32BiasGelu E{(float*)J.O, J.ldc, J.aux}; pg8::gemm_phase<pg8::EpiF32BiasGelu>(lds, J.g, S, E); }
    else if (J.epi == 3) { unsigned char* big = p.ws + WS_BIG; pg8::EpiConvGate E{(bf16_t*)J.O, J.aux, J.aux2, (float*)(big + BIG_TAILA), (float*)(big + BIG_HEADA), (float*)(big + BIG_HEADB)}; pg8::gemm_phase<pg8::EpiConvGate>(lds, J.g, S, E); }
    else if (J.epi == 2) { pg8::EpiResF32<true> E{J.aux, (float*)J.O, J.ldc, ALPHA}; pg8::gemm_phase<pg8::EpiResF32<true>>(lds, J.g, S, E); }
    else { pg8::EpiResF32<false> E{J.aux, (float*)J.O, J.ldc, ALPHA}; pg8::gemm_phase<pg8::EpiResF32<false>>(lds, J.g, S, E); }
}
__device__ __forceinline__ void run_gemm_phase(const Params& p, LAS unsigned char* lds, int ph) {
    run_gemm_job<0>(p, lds, ph); run_gemm_job<1>(p, lds, ph); run_gemm_job<2>(p, lds, ph);
}

__device__ __forceinline__ void run_phase(const Params& p, LAS unsigned char* lds, const Ctx& c, int ph) {
    unsigned char* ws = p.ws;
    bf16_t* XB = (bf16_t*)(ws + WS_XB);
    const int G = (int)gridDim.x, bid = (int)blockIdx.x;
    if (ph == PH_A_FIX || ph == PH_B_FIX) {
        const int layer = ph == PH_B_FIX ? 1 : 0;
        for (int pm = bid; pm < NTOK / 256; pm += G) ffn_fixup(c, ws + WS_BIG, p.in[I_FCW] + (size_t)layer * 3 * DFF, p.in[I_FCB] + (size_t)layer * DFF, pm);
        return;
    }
    if (ph == PH_A_CMP1 && G >= LATE_FIRST_WG + 32 && bid >= LATE_FIRST_WG) {
        Ctx c2 = c; c2.gtid = (bid - LATE_FIRST_WG) * NTHR + c.tid; c2.gsz = (G - LATE_FIRST_WG) * NTHR;
        prep_late(p, c2);
    }
    if (is_gemm_phase(ph)) { run_gemm_phase(p, lds, ph); return; }
    switch (ph) {
    case PH_PREP: phase_prep(p, c); break;
    case PH_A_CMP2: phase_cmp2(p, c); break;
    case PH_A_NSA1: {
        for (int u = bid; u < BATCH * 8; u += G) nsa1_unit(p, lds, u >> 3, u & 7);
    } break;
    case PH_A_NSA2: {
        for (int u = bid; u < BATCH * (NH / 2) * 4; u += G) { const int b = u / 24, r = u % 24, hp = r >> 2, s = (r + u / G) & 3;
#pragma nounroll
            for (int k = 0; k < 2; ++k) nsa2_unit(p, lds, b, 2 * hp, k ? s : 7 - s); }
    } break;
    case PH_B_ATT: {
        for (int u = bid; u < BATCH * NH * 2; u += G) { const int b = u / 24, r = u % 24, h = r >> 1, s = r & 1;
#pragma nounroll
            for (int k = 0; k < 2; ++k) moba_unit(p, lds, b, h, k ? s : 3 - s); }
    } break;
    case PH_A_LN1: case PH_B_LN1: case PH_A_LN2: case PH_B_LN2: {
        const int layer = ph >= PH_B_GEMM ? 1 : 0; const bool second = (ph == PH_A_LN2 || ph == PH_B_LN2); const bool fin = (ph == PH_B_LN2);
        phase_ln(c, p.out, p.in[second ? I_LN2G : I_LN1G] + layer * DM, p.in[second ? I_LN2B : I_LN1B] + layer * DM, fin ? p.out : nullptr, fin ? nullptr : XB);
    } break;
    case PH_B_KMEAN: phase_kmean(c, (const bf16_t*)(ws + WS_BIG + BIG_KV), (float*)(ws + WS_KMEAN)); break;
    default: break;
    }
    if (ph == PH_A_NSA1 || ph == PH_B_ATT) {
        const bool la = (ph == PH_A_NSA1);
        const bf16_t* Q = (const bf16_t*)(ws + WS_BIG + (la ? BIG_P : BIG_Q1)); bf16_t* O = (bf16_t*)(ws + WS_BIG + (la ? BIG_O0 : BIG_O1));
        for (int u = bid; u < BATCH * 4 * 4; u += G) mem_unit(p, lds, Q, la ? AINP : DM, la ? P_QM : MAINW, O, la ? 0 : 512, u >> 4, (u >> 2) & 3, u & 3);
    }
}

template <int PH>
__device__ __forceinline__ void phase_seq(const Params& p, LAS unsigned char* lds, const Ctx& c, cg::grid_group& grid, const XcdBarrier& bar) {
    if constexpr (PH < PH_COUNT) {
        if (PH >= p.ph_lo && PH < p.ph_hi) {
            Ctx cc; { int t_ = threadIdx.x; asm volatile("" : "+v"(t_)); cc.tid = t_; cc.lane = t_ & 63; cc.wid = t_ >> 6; cc.gtid = blockIdx.x * NTHR + t_; cc.gsz = gridDim.x * NTHR; cc.gw = blockIdx.x * (NTHR / 64) + cc.wid; cc.ngw = gridDim.x * (NTHR / 64); }
            run_phase(p, lds, cc, PH); if (PH + 1 < p.ph_hi) { if (PH == 0) grid.sync(); else xcd_barrier(bar); } }
        phase_seq<PH + 1>(p, lds, c, grid, bar);
    }
}
__global__ void __launch_bounds__(NTHR) yoco_mega(Params p) {
    extern __shared__ __attribute__((aligned(16))) unsigned char lds_raw[];
    LAS unsigned char* lds = (LAS unsigned char*)lds_raw;
    cg::grid_group grid = cg::this_grid();
    Ctx c; c.tid = threadIdx.x; c.lane = c.tid & 63; c.wid = c.tid >> 6; c.gtid = blockIdx.x * NTHR + c.tid; c.gsz = gridDim.x * NTHR; c.gw = blockIdx.x * (NTHR / 64) + c.wid; c.ngw = gridDim.x * (NTHR / 64);
    if (c.tid < 130) ((LAS int*)(lds + att::L_BKT))[c.tid] = c.tid == 0 ? 0 : att::rel_bucket(c.tid - 1);
    if (c.tid < 2) ((LAS unsigned*)(lds + att::L_MISC))[c.tid] = 0u;
    __syncthreads();
    const XcdBarrier bar = xcd_barrier_post((unsigned*)(p.ws + WS_CTL), (volatile LAS unsigned*)(lds + att::L_MISC));
    phase_seq<0>(p, lds, c, grid, bar);
}

extern "C" void kernel_launch(void* const* d_in, const int* in_sizes, int n_in, void* d_out, int out_size, void* d_ws, size_t ws_size, hipStream_t stream) {
    static int grid = 0;
    if (grid == 0) {
        if (n_in != 24 || ws_size < WS_NEED) { fprintf(stderr, "kernel_launch: unexpected n_in %d / ws_size %zu (need %zu)\n", n_in, ws_size, (size_t)WS_NEED); grid = -1; return; }
        int dev = 0, cus = 0, per_cu = 0;
        hipGetDevice(&dev); hipDeviceGetAttribute(&cus, hipDeviceAttributeMultiprocessorCount, dev);
        if (hipFuncSetAttribute((const void*)yoco_mega, hipFuncAttributeMaxDynamicSharedMemorySize, LDS_BYTES) != hipSuccess) { fprintf(stderr, "kernel_launch: hipFuncSetAttribute failed\n"); grid = -1; return; }
        if (hipOccupancyMaxActiveBlocksPerMultiprocessor(&per_cu, (const void*)yoco_mega, NTHR, LDS_BYTES) != hipSuccess || per_cu < 1) { fprintf(stderr, "kernel_launch: occupancy query says %d\n", per_cu); per_cu = 1; }
        (void)hipGetLastError();
        grid = cus * per_cu;
        fprintf(stderr, "kernel_launch: grid %d (cus %d x %d)\n", grid, cus, per_cu);
    }
    if (grid < 0) return;
    if (hipMemsetAsync((char*)d_ws + WS_CTL, 0, CTL_BYTES, stream) != hipSuccess) { fprintf(stderr, "kernel_launch: memset failed\n"); return; }
    Params p{};
    for (int i = 0; i < 24; ++i) p.in[i] = (const float*)d_in[i];
    p.out = (float*)d_out; p.ws = (unsigned char*)d_ws; p.ph_lo = 0; p.ph_hi = PH_COUNT;
    void* args[] = {&p};
    hipError_t e = hipLaunchCooperativeKernel((const void*)yoco_mega, dim3(grid), dim3(NTHR), args, LDS_BYTES, stream);
    if (e != hipSuccess) fprintf(stderr, "kernel_launch: cooperative launch failed: %s (grid %d)\n", hipGetErrorString(e), grid);
}
```

```cpp
#include <hip/hip_runtime.h>
#include <hip/hip_cooperative_groups.h>
#include <cstdio>
#include <cstdint>
namespace cg = cooperative_groups;

#define LAS __attribute__((address_space(3)))
typedef unsigned short bf16_t;
typedef short bf16x8 __attribute__((ext_vector_type(8)));
typedef short s16x4 __attribute__((ext_vector_type(4)));
typedef float f32x4 __attribute__((ext_vector_type(4)));
typedef float f32x2 __attribute__((ext_vector_type(2)));
typedef float f32x16 __attribute__((ext_vector_type(16)));
typedef unsigned u32x4 __attribute__((ext_vector_type(4)));
typedef unsigned u32x2 __attribute__((ext_vector_type(2)));

__device__ __forceinline__ unsigned cvt_pk_bf16(float lo, float hi) { unsigned r; asm volatile("v_cvt_pk_bf16_f32 %0, %1, %2" : "=v"(r) : "v"(lo), "v"(hi)); return r; }
__device__ __forceinline__ float bf2f(unsigned short b) { return __uint_as_float(((unsigned)b) << 16); }
__device__ __forceinline__ float gelu_tanh(float x) {
    const float x2 = x * x;
    const float w = x * (-2.302208198f - 0.1029432397f * x2);
    return x * __builtin_amdgcn_rcpf(1.0f + __builtin_amdgcn_exp2f(w));
}

namespace pg8 {
constexpr int BM = 256, BK = 64, HALF = 128, HTB = HALF * BK * 2, STAGE_BYTES = 8 * HTB, NXCD = 8, WGM = 8;
__host__ __device__ __forceinline__ int lds_byte(int r, int c) { const int st = (r >> 4) * 2 + (c >> 5), rr = r & 15, cc = c & 31, ob = rr * 64 + cc * 2; return st * 1024 + (ob ^ (((ob >> 9) & 1) << 5)); }
__host__ __device__ __forceinline__ void stage_rc(int b, int& R, int& C) { const int st = b / 1024, sb = b % 1024, swz = sb ^ (((sb >> 9) & 1) << 5); R = (st >> 1) * 16 + swz / 64; C = (st & 1) * 32 + (swz % 64) / 2; }
__host__ __device__ __forceinline__ int perm32(int rho) { const int n = rho >> 4, i = rho & 15; return 8 * (i >> 2) + 4 * n + (i & 3); }

struct Unit { int pm, pn; };
struct Gemm { const bf16_t* A; const bf16_t* Bt; int M, N, K; int lda; int kstepA; };

struct StaticOrder {
    int nM, nN, nwg, G, c;
    __host__ __device__ void init(int M, int N, int G_, int c_) { nM = M / BM; nN = N / BM; nwg = nM * nN; G = G_; c = c_; }
    __host__ __device__ bool next(int i, Unit& u) const {
        if (c < 0) return false;
        const long L = (long)i * G + c; if (L >= nwg) return false;
        int wgid = (int)L; { const int q = nwg / NXCD, r = nwg % NXCD, xcd = wgid % NXCD, off = wgid / NXCD; wgid = (xcd < r ? xcd * (q + 1) : r * (q + 1) + (xcd - r) * q) + off; }
        const int nig = WGM * nN, gid = wgid / nig, fm = gid * WGM, gsz = (nM - fm) < WGM ? (nM - fm) : WGM;
        u.pm = fm + ((wgid % nig) % gsz); u.pn = (wgid % nig) / gsz; return true;
    }
};

struct EpiBf16 {
    static constexpr bool PERM = true;
    bf16_t* O; int ldc;
    __device__ __forceinline__ void operator()(const f32x4 (&acc)[2][2][4][2], const Unit& u, int wr, int wc, int fr, int fq) const {
        const int row0 = u.pm * BM + wr * 64 + fr; const int col0 = u.pn * BM + wc * 32 + 8 * fq;
#pragma unroll
        for (int ai = 0; ai < 2; ++ai)
#pragma unroll
            for (int m = 0; m < 4; ++m) { bf16_t* rowp = O + (size_t)(row0 + ai * HALF + m * 16) * ldc + col0;
#pragma unroll
                for (int bj = 0; bj < 2; ++bj) { const f32x4 v0 = acc[ai][bj][m][0], v1 = acc[ai][bj][m][1];
                    u32x4 w; w.x = cvt_pk_bf16(v0[0], v0[1]); w.y = cvt_pk_bf16(v0[2], v0[3]); w.z = cvt_pk_bf16(v1[0], v1[1]); w.w = cvt_pk_bf16(v1[2], v1[3]);
                    *(u32x4*)(rowp + bj * HALF) = w; } }
    }
};
struct EpiF32BiasGelu {
    static constexpr bool PERM = false;
    float* O; int ldc; const float* bias;
    __device__ __forceinline__ void operator()(const f32x4 (&acc)[2][2][4][2], const Unit& u, int wr, int wc, int fr, int fq) const {
        const int row0 = u.pm * BM + wr * 64 + fr; const int col0 = u.pn * BM + wc * 32 + 4 * fq;
#pragma unroll
        for (int bj = 0; bj < 2; ++bj)
#pragma unroll
            for (int n = 0; n < 2; ++n) { const f32x4 bv = *(const f32x4*)(bias + col0 + bj * HALF + n * 16);
#pragma unroll
                for (int ai = 0; ai < 2; ++ai)
#pragma unroll
                    for (int m = 0; m < 4; ++m) { f32x4 v = acc[ai][bj][m][n] + bv; v[0] = gelu_tanh(v[0]); v[1] = gelu_tanh(v[1]); v[2] = gelu_tanh(v[2]); v[3] = gelu_tanh(v[3]);
                        *(f32x4*)(O + (size_t)(row0 + ai * HALF + m * 16) * ldc + col0 + bj * HALF + n * 16) = v; } }
    }
};
template <int CTRL> __device__ __forceinline__ float dppf(float old, float src) {
    return __int_as_float(__builtin_amdgcn_update_dpp(__float_as_int(old), __float_as_int(src), CTRL, 0xf, 0xf, false));
}
struct EpiConvGate {
    static constexpr bool PERM = true;
    bf16_t* H; const float* cw; const float* cb; float* TAILA; float* HEADA; float* HEADB;
    __device__ __forceinline__ void operator()(const f32x4 (&acc)[2][2][4][2], const Unit& u, int wr, int wc, int fr, int fq) const {
        constexpr int DFF_ = 2816;
        const int cf0 = u.pn * 128 + wc * 32 + 8 * fq;
        f32x4 w0[2], w1[2], w2[2], cv[2];
#pragma unroll
        for (int n = 0; n < 2; ++n) { w0[n] = *(const f32x4*)(cw + cf0 + 4 * n); w1[n] = *(const f32x4*)(cw + DFF_ + cf0 + 4 * n); w2[n] = *(const f32x4*)(cw + 2 * DFF_ + cf0 + 4 * n); cv[n] = *(const f32x4*)(cb + cf0 + 4 * n); }
#pragma unroll
        for (int ai = 0; ai < 2; ++ai) {
            const int G = u.pm * 4 + ai * 2 + wr;
#pragma unroll
            for (int m = 0; m < 4; ++m) {
                const int row = u.pm * BM + ai * HALF + wr * 64 + m * 16 + fr;
                f32x4 hv[2];
#pragma unroll
                for (int n = 0; n < 2; ++n) {
                    const f32x4 a = acc[ai][0][m][n], b = acc[ai][1][m][n];
                    const f32x4 pv = acc[ai][0][m > 0 ? m - 1 : 0][n];
#pragma unroll
                    for (int j = 0; j < 4; ++j) {
                        const float am1 = dppf<0x111>(dppf<0x121>(0.f, pv[j]), a[j]);
                        const float am2 = dppf<0x112>(dppf<0x122>(0.f, pv[j]), a[j]);
                        const float pre = w0[n][j] * am2 + w1[n][j] * am1 + w2[n][j] * a[j] + cv[n][j];
                        hv[n][j] = gelu_tanh(pre) * b[j];
                    }
                }
                if (m > 0 || fr >= 2) {
                    u32x4 w; w.x = cvt_pk_bf16(hv[0][0], hv[0][1]); w.y = cvt_pk_bf16(hv[0][2], hv[0][3]); w.z = cvt_pk_bf16(hv[1][0], hv[1][1]); w.w = cvt_pk_bf16(hv[1][2], hv[1][3]);
                    *(u32x4*)(H + (size_t)row * DFF_ + cf0) = w;
                } else {
                    float* ha = HEADA + ((size_t)G * 2 + fr) * DFF_ + cf0; float* hb = HEADB + ((size_t)G * 2 + fr) * DFF_ + cf0;
                    *(f32x4*)ha = acc[ai][0][0][0]; *(f32x4*)(ha + 4) = acc[ai][0][0][1]; *(f32x4*)hb = acc[ai][1][0][0]; *(f32x4*)(hb + 4) = acc[ai][1][0][1];
                }
                if (m == 3 && fr >= 14) { float* ta = TAILA + ((size_t)G * 2 + (fr - 14)) * DFF_ + cf0; *(f32x4*)ta = acc[ai][0][3][0]; *(f32x4*)(ta + 4) = acc[ai][0][3][1]; }
            }
        }
    }
};
template <bool BASE_F32>
struct EpiResF32 {
    static constexpr bool PERM = false;
    const void* basev; float* O; int ldc; float alpha;
    __device__ __forceinline__ void operator()(const f32x4 (&acc)[2][2][4][2], const Unit& u, int wr, int wc, int fr, int fq) const {
        const int row0 = u.pm * BM + wr * 64 + fr; const int col0 = u.pn * BM + wc * 32 + 4 * fq;
#pragma unroll
        for (int ai = 0; ai < 2; ++ai)
#pragma unroll
            for (int m = 0; m < 4; ++m) { const size_t off = (size_t)(row0 + ai * HALF + m * 16) * ldc + col0;
#pragma unroll
                for (int bj = 0; bj < 2; ++bj)
#pragma unroll
                    for (int n = 0; n < 2; ++n) { f32x4 bs;
                        if (BASE_F32) bs = *(const f32x4*)((const float*)basev + off + bj * HALF + n * 16);
                        else { const u32x2 w = *(const u32x2*)((const bf16_t*)basev + off + bj * HALF + n * 16); bs[0] = __uint_as_float(w.x << 16); bs[1] = __uint_as_float(w.x & 0xffff0000u); bs[2] = __uint_as_float(w.y << 16); bs[3] = __uint_as_float(w.y & 0xffff0000u); }
                        *(f32x4*)(O + off + bj * HALF + n * 16) = bs * alpha + acc[ai][bj][m][n]; } }
    }
};

template <class Epi>
__device__ __forceinline__ void gemm_phase(LAS unsigned char* lds, const Gemm g, const StaticOrder& S, const Epi& E) {
    const int tid = threadIdx.x, wid = __builtin_amdgcn_readfirstlane(tid >> 6), lane = tid & 63, wr = wid >> 2, wc = wid & 3, fr = lane & 15, fq = lane >> 4;
    const int K = g.K, nt = K / BK;
    unsigned voffA[2], voffB[2];
#pragma unroll
    for (int i = 0; i < 2; ++i) { int R, C; stage_rc(tid * 16 + i * 8192, R, C); const int Rb = Epi::PERM ? ((R & ~31) + perm32(R & 31)) : R;
        voffA[i] = (unsigned)(R * g.lda + C) * 2u; voffB[i] = (unsigned)(Rb * K + C) * 2u; }
    const size_t kstepA = (size_t)g.kstepA, kstepB = (size_t)(BK * 2);
    const size_t hstepA = (size_t)HALF * g.lda * 2, hstepB = (size_t)HALF * K * 2;
    const size_t tstepA = 2 * hstepA, tstepB = 2 * hstepB;
    const unsigned ldsw = (unsigned)wid * 1024u;
    const int aoff = lds_byte(wr * 64 + fr, fq * 8), boff = lds_byte(wc * 32 + fr, fq * 8);
#define PG8_SA(b, h) (((b) * 2 + (h)) * HTB)
#define PG8_SB(b, h) ((4 + (b) * 2 + (h)) * HTB)
#define PG8_STAGE(bufoff, gbase, voff) do { _Pragma("unroll") for (int _i = 0; _i < 2; ++_i) \
        __builtin_amdgcn_global_load_lds((const unsigned*)((const char*)(gbase) + (voff)[_i]), (LAS unsigned*)(lds + (bufoff) + ldsw + _i * 8192), 16, 0, 0); } while (0)
#define PG8_LDA(dst, b, h) do { _Pragma("unroll") for (int m = 0; m < 4; ++m) _Pragma("unroll") for (int k = 0; k < 2; ++k) dst[m][k] = *(const LAS bf16x8*)(lds + PG8_SA(b, h) + aoff + m * 2048 + k * 1024); } while (0)
#define PG8_LDB(dst, b, h) do { _Pragma("unroll") for (int n = 0; n < 2; ++n) _Pragma("unroll") for (int k = 0; k < 2; ++k) dst[n][k] = *(const LAS bf16x8*)(lds + PG8_SB(b, h) + boff + n * 2048 + k * 1024); } while (0)
#define PG8_MMA(ai, bj, At, Bt) do { __builtin_amdgcn_s_setprio(1); _Pragma("unroll") for (int m = 0; m < 4; ++m) _Pragma("unroll") for (int n = 0; n < 2; ++n) _Pragma("unroll") for (int k = 0; k < 2; ++k) \
        acc[ai][bj][m][n] = __builtin_amdgcn_mfma_f32_16x16x32_bf16(Bt[n][k], At[m][k], acc[ai][bj][m][n], 0, 0, 0); __builtin_amdgcn_s_setprio(0); } while (0)
#define PG8_WAIT_V(n) asm volatile("s_waitcnt vmcnt(" #n ")" ::: "memory")
#define PG8_WAIT_L(n) asm volatile("s_waitcnt lgkmcnt(" #n ")" ::: "memory")
#define PG8_BAR __builtin_amdgcn_s_barrier()
#define PG8_SCHED __builtin_amdgcn_sched_barrier(0)
    Unit cur, nxt; int ui = 0;
    if (!S.next(0, cur)) return;
    f32x4 acc[2][2][4][2];
#pragma unroll
    for (int a = 0; a < 2; ++a)
#pragma unroll
        for (int b = 0; b < 2; ++b)
#pragma unroll
            for (int m = 0; m < 4; ++m)
#pragma unroll
                for (int n = 0; n < 2; ++n) acc[a][b][m][n] = (f32x4){0.f, 0.f, 0.f, 0.f};
    bf16x8 At[4][2], B0[2][2], B1[2][2];
    const char* cA = (const char*)g.A + (size_t)cur.pm * tstepA; const char* cB = (const char*)g.Bt + (size_t)cur.pn * tstepB;
    PG8_STAGE(PG8_SB(0, 0), cB, voffB); PG8_STAGE(PG8_SB(0, 1), cB + hstepB, voffB); PG8_STAGE(PG8_SA(0, 0), cA, voffA); PG8_STAGE(PG8_SA(0, 1), cA + hstepA, voffA);
    if (wr == 1) PG8_BAR;
    PG8_WAIT_V(2); PG8_BAR;
    PG8_STAGE(PG8_SB(1, 0), cB + kstepB, voffB); PG8_STAGE(PG8_SA(1, 0), cA + kstepA, voffA); PG8_STAGE(PG8_SB(1, 1), cB + hstepB + kstepB, voffB);
    PG8_WAIT_V(6); PG8_BAR;
    for (;;) {
        const bool has_next = S.next(ui + 1, nxt);
        const char* nA = has_next ? (const char*)g.A + (size_t)nxt.pm * tstepA : cA; const char* nB = has_next ? (const char*)g.Bt + (size_t)nxt.pn * tstepB : cB;
        for (int t = 0; t < nt; t += 2) {
            const bool last = (t == nt - 2);
            const char* a1 = cA + (size_t)(t + 1) * kstepA;
            const char* a2 = last ? nA : cA + (size_t)(t + 2) * kstepA; const char* b2 = last ? nB : cB + (size_t)(t + 2) * kstepB;
            const char* a3 = a2 + kstepA; const char* b3 = b2 + kstepB;
            PG8_LDB(B0, 0, 0); PG8_LDB(B1, 0, 1); PG8_SCHED; PG8_LDA(At, 0, 0); PG8_STAGE(PG8_SA(1, 1), a1 + hstepA, voffA);
            PG8_WAIT_V(8); PG8_WAIT_L(0); PG8_BAR; PG8_MMA(0, 0, At, B0); PG8_MMA(0, 1, At, B1); PG8_BAR; PG8_SCHED;
            PG8_LDA(At, 0, 1); PG8_STAGE(PG8_SB(0, 0), b2, voffB); PG8_STAGE(PG8_SB(0, 1), b2 + hstepB, voffB); PG8_STAGE(PG8_SA(0, 0), a2, voffA);
            PG8_WAIT_V(8); PG8_WAIT_L(0); PG8_BAR; PG8_MMA(1, 0, At, B0); PG8_MMA(1, 1, At, B1); PG8_BAR; PG8_SCHED;
            PG8_LDB(B0, 1, 0); PG8_LDB(B1, 1, 1); PG8_SCHED; PG8_LDA(At, 1, 0); PG8_STAGE(PG8_SA(0, 1), a2 + hstepA, voffA);
            PG8_WAIT_V(8); PG8_WAIT_L(0); PG8_BAR; PG8_MMA(0, 0, At, B0); PG8_MMA(0, 1, At, B1); PG8_BAR; PG8_SCHED;
            PG8_LDA(At, 1, 1); PG8_STAGE(PG8_SB(1, 0), b3, voffB); PG8_STAGE(PG8_SB(1, 1), b3 + hstepB, voffB); PG8_STAGE(PG8_SA(1, 0), a3, voffA);
            PG8_WAIT_V(8); PG8_WAIT_L(0); PG8_BAR; PG8_MMA(1, 0, At, B0); PG8_MMA(1, 1, At, B1); PG8_BAR; PG8_SCHED;
        }
        if (wr == 0) PG8_BAR;
        E(acc, cur, wr, wc, fr, fq);
        if (!has_next) break;
#pragma unroll
        for (int a = 0; a < 2; ++a)
#pragma unroll
            for (int b = 0; b < 2; ++b)
#pragma unroll
                for (int m = 0; m < 4; ++m)
#pragma unroll
                    for (int n = 0; n < 2; ++n) acc[a][b][m][n] = (f32x4){0.f, 0.f, 0.f, 0.f};
        cur = nxt; cA = nA; cB = nB; ++ui;
        if (wr == 1) PG8_BAR;
    }
    PG8_WAIT_V(0);
    PG8_BAR;
#undef PG8_SA
#undef PG8_SB
#undef PG8_STAGE
#undef PG8_LDA
#undef PG8_LDB
#undef PG8_MMA
#undef PG8_WAIT_V
#undef PG8_WAIT_L
#undef PG8_BAR
#undef PG8_SCHED
}
}

constexpr int BATCH = 32, SEQ = 2048, DM = 1024, NTOK = BATCH * SEQ, NMEM = 256, NH = 12, HD = 64, MAINW = 768;
constexpr int AIN = 1444, AINP = 1536, DFF = 2816, NCMP = 127;
constexpr int HALF_TOK = NTOK / 2;
constexpr float ALPHA = 1.4142135623730951f;
constexpr float LN_EPS = 1e-5f;
constexpr int P_Q = 0, P_KC = 768, P_VC = 832, P_KS = 896, P_VS = 960, P_KW = 1024, P_VW = 1088, P_QM = 1152, P_G = 1408;
constexpr size_t MiB = 1u << 20;
constexpr size_t WS_WAIN = 0 * MiB, WS_WAMKV = 3 * MiB, WS_WAOUT = 4 * MiB, WS_WSKV = 6 * MiB, WS_WBIN = 9 * MiB, WS_WBMKV = 11 * MiB, WS_WBOUT = 12 * MiB;
constexpr size_t WS_WFIN = 14 * MiB  , WS_WFOUT = 36 * MiB  , WS_WC1K = 47 * MiB, WS_WC1V = 48 * MiB, WS_WMKV = 49 * MiB  ;
constexpr size_t WS_CTL = 51 * MiB, CTL_BYTES = 16384;
constexpr size_t WS_MEMB = 52 * MiB, WS_MKV = 68 * MiB  , WS_CMPH = 84 * MiB, WS_KCMP = 92 * MiB, WS_VCMP = 93 * MiB, WS_CBIAS = 94 * MiB, WS_SEL = 94 * MiB + 65536, WS_KMEAN = 95 * MiB;
constexpr size_t WS_XB = 96 * MiB, WS_BIG = 226 * MiB;
constexpr size_t BIG_P = 0, BIG_O0 = 193 * MiB, BIG_H = 0, BIG_TAILA = 352 * MiB, BIG_HEADA = 374 * MiB, BIG_HEADB = 396 * MiB, BIG_KV = 0, BIG_Q1 = 193 * MiB, BIG_O1 = 321 * MiB;
constexpr size_t WS_NEED = WS_BIG + 449 * MiB;

constexpr int LDS_BYTES = 147456;
constexpr int NTHR = 512;

struct Params {
    const float* in[24];
    float* out;
    unsigned char* ws;
    int ph_lo, ph_hi;
};
enum { I_X = 0, I_MEM, I_RELB, I_AWIN, I_PEK, I_W1K, I_W2K, I_PEV, I_W1V, I_W2V, I_AWMKV, I_AWOUT, I_SWKV, I_BWIN, I_BWMKV, I_BWOUT, I_LN1G, I_LN1B, I_LN2G, I_LN2B, I_FWIN, I_FCW, I_FCB, I_FWOUT };

namespace att {
constexpr int ROWB = 144, TILEB = 64 * ROWB, VROWB = 192, VTILEB = 64 * VROWB;
constexpr float NEG = -1e30f;
constexpr float LOG2E = 1.4426950408889634f;
constexpr float SC2 = 0.125f * LOG2E;
typedef short v4i16_t __attribute__((ext_vector_type(4)));

__device__ __forceinline__ f32x16 zero16() { f32x16 z;
#pragma unroll
    for (int i = 0; i < 16; ++i) z[i] = 0.f; return z; }

__device__ __forceinline__ void qk_tile(f32x16& p0, f32x16& p1, const LAS unsigned char* Kt, const bf16x8 (&qr)[4], int r32, int hi, float cinit = 0.f) {
    const LAS unsigned char* kb = Kt + r32 * ROWB + hi * 16;
#pragma unroll
    for (int i = 0; i < 16; ++i) { p0[i] = cinit; p1[i] = cinit; }
#pragma unroll
    for (int d0 = 0; d0 < 4; ++d0) {
        const bf16x8 k0 = *(const LAS bf16x8*)(kb + d0 * 32);
        const bf16x8 k1 = *(const LAS bf16x8*)(kb + 32 * ROWB + d0 * 32);
        p0 = __builtin_amdgcn_mfma_f32_32x32x16_bf16(k0, qr[d0], p0, 0, 0, 0);
        p1 = __builtin_amdgcn_mfma_f32_32x32x16_bf16(k1, qr[d0], p1, 0, 0, 0);
    }
}
__device__ __forceinline__ s16x4 vtr(const LAS unsigned char* p) { return __builtin_bit_cast(s16x4, __builtin_amdgcn_ds_read_tr16_b64_v4i16((LAS v4i16_t*)p)); }
__device__ __forceinline__ void pv_tile(f32x16& o0, f32x16& o1, const LAS unsigned char* Vt, const f32x16& p0, const f32x16& p1, int lane) {
    const int hi = lane >> 5, g1 = (lane >> 4) & 1, i = lane & 15, q_ = i >> 2, p_ = i & 3;
    const LAS unsigned char* vb = Vt + (4 * hi + q_) * VROWB + (16 * g1 + 4 * p_) * 2;
#pragma unroll
    for (int s = 0; s < 4; ++s) {
        u32x4 w;
        if (s < 2) { const int b = 8 * (s & 1); w.x = cvt_pk_bf16(p0[b + 0], p0[b + 1]); w.y = cvt_pk_bf16(p0[b + 2], p0[b + 3]); w.z = cvt_pk_bf16(p0[b + 4], p0[b + 5]); w.w = cvt_pk_bf16(p0[b + 6], p0[b + 7]); }
        else       { const int b = 8 * (s & 1); w.x = cvt_pk_bf16(p1[b + 0], p1[b + 1]); w.y = cvt_pk_bf16(p1[b + 2], p1[b + 3]); w.z = cvt_pk_bf16(p1[b + 4], p1[b + 5]); w.w = cvt_pk_bf16(p1[b + 6], p1[b + 7]); }
        const bf16x8 pf = __builtin_bit_cast(bf16x8, w);
#pragma unroll
        for (int dh = 0; dh < 2; ++dh) {
            const s16x4 lo = vtr(vb + (16 * s) * VROWB + dh * 64);
            const s16x4 h4 = vtr(vb + (16 * s + 8) * VROWB + dh * 64);
            const bf16x8 vf = (bf16x8){lo[0], lo[1], lo[2], lo[3], h4[0], h4[1], h4[2], h4[3]};
            if (dh == 0) o0 = __builtin_amdgcn_mfma_f32_32x32x16_bf16(vf, pf, o0, 0, 0, 0);
            else         o1 = __builtin_amdgcn_mfma_f32_32x32x16_bf16(vf, pf, o1, 0, 0, 0);
        }
    }
}
struct Acc { float m, l; f32x16 o0, o1; };
__device__ __forceinline__ void acc_init(Acc& A) { A.m = NEG; A.l = 0.f; A.o0 = zero16(); A.o1 = zero16(); }
constexpr float THR_RAW = 8.0f / SC2;
__device__ __forceinline__ void sm_update(Acc& A, f32x16& p0, f32x16& p1) {
    float m0 = fmaxf(p0[0], p1[0]), m1 = fmaxf(p0[1], p1[1]);
#pragma unroll
    for (int r = 2; r < 16; r += 2) { m0 = fmaxf(fmaxf(m0, p0[r]), p1[r]); m1 = fmaxf(fmaxf(m1, p0[r + 1]), p1[r + 1]); }
    float mx = fmaxf(m0, m1);
    mx = fmaxf(mx, __shfl_xor(mx, 32));
    if (__any(mx > A.m + THR_RAW)) {
        const float mn = fmaxf(A.m, mx);
        const float alpha = __builtin_amdgcn_exp2f((A.m - (mn < -5e29f ? 0.f : mn)) * SC2);
        A.l *= alpha; A.m = mn;
#pragma unroll
        for (int r = 0; r < 16; ++r) { A.o0[r] *= alpha; A.o1[r] *= alpha; }
    }
    const float msc = (A.m < -5e29f ? 0.f : A.m) * SC2;
    float rs0 = 0.f, rs1 = 0.f;
#pragma unroll
    for (int r = 0; r < 16; ++r) {
        const float e0 = __builtin_amdgcn_exp2f(p0[r] * SC2 - msc);
        const float e1 = __builtin_amdgcn_exp2f(p1[r] * SC2 - msc);
        p0[r] = e0; p1[r] = e1; rs0 += e0; rs1 += e1;
    }
    A.l += rs0 + rs1;
}
__device__ __forceinline__ float rowmax32(const f32x16& p0, const f32x16& p1) {
    float m0 = fmaxf(p0[0], p1[0]), m1 = fmaxf(p0[1], p1[1]), m2 = fmaxf(p0[2], p1[2]), m3 = fmaxf(p0[3], p1[3]);
#pragma unroll
    for (int r = 4; r < 16; r += 4) { m0 = fmaxf(fmaxf(m0, p0[r]), p1[r]); m1 = fmaxf(fmaxf(m1, p0[r + 1]), p1[r + 1]); m2 = fmaxf(fmaxf(m2, p0[r + 2]), p1[r + 2]); m3 = fmaxf(fmaxf(m3, p0[r + 3]), p1[r + 3]); }
    return fmaxf(fmaxf(m0, m1), fmaxf(m2, m3));
}
__device__ __forceinline__ void sm_update2(Acc& A, Acc& B, f32x16& a0, f32x16& a1, f32x16& b0, f32x16& b1) {
    float mxa = rowmax32(a0, a1), mxb = rowmax32(b0, b1);
    mxa = fmaxf(mxa, __shfl_xor(mxa, 32)); mxb = fmaxf(mxb, __shfl_xor(mxb, 32));
    if (__any((mxa > A.m + THR_RAW) || (mxb > B.m + THR_RAW))) {
        const float mna = fmaxf(A.m, mxa), mnb = fmaxf(B.m, mxb);
        const float ala = __builtin_amdgcn_exp2f((A.m - (mna < -5e29f ? 0.f : mna)) * SC2), alb = __builtin_amdgcn_exp2f((B.m - (mnb < -5e29f ? 0.f : mnb)) * SC2);
        A.l *= ala; A.m = mna; B.l *= alb; B.m = mnb;
#pragma unroll
        for (int r = 0; r < 16; ++r) { A.o0[r] *= ala; B.o0[r] *= alb; A.o1[r] *= ala; B.o1[r] *= alb; }
    }
    const float msa = (A.m < -5e29f ? 0.f : A.m) * SC2, msb = (B.m < -5e29f ? 0.f : B.m) * SC2;
    float ra0 = 0.f, ra1 = 0.f, rb0 = 0.f, rb1 = 0.f;
#pragma unroll
    for (int r = 0; r < 16; ++r) {
        const float ea0 = __builtin_amdgcn_exp2f(a0[r] * SC2 - msa), eb0 = __builtin_amdgcn_exp2f(b0[r] * SC2 - msb);
        const float ea1 = __builtin_amdgcn_exp2f(a1[r] * SC2 - msa), eb1 = __builtin_amdgcn_exp2f(b1[r] * SC2 - msb);
        a0[r] = ea0; b0[r] = eb0; a1[r] = ea1; b1[r] = eb1; ra0 += ea0; rb0 += eb0; ra1 += ea1; rb1 += eb1;
    }
    A.l += ra0 + ra1; B.l += rb0 + rb1;
}
__device__ __forceinline__ float acc_inv(const Acc& A) { const float lt = A.l + __shfl_xor(A.l, 32); return 1.0f / fmaxf(lt, 1e-30f); }

__device__ __forceinline__ void apply_general(f32x16& p0, f32x16& p1, int dist0, const LAS float* tab, bool allow, int W) {
    const unsigned We = allow ? (unsigned)W : 0u;
#pragma unroll
    for (int r = 0; r < 16; ++r) {
        const int d_0 = dist0 - ((r & 3) + 8 * (r >> 2)), d_1 = d_0 - 32;
        const int i0 = ((unsigned)d_0 < We) ? min(d_0, 128) + 1 : 0, i1 = ((unsigned)d_1 < We) ? min(d_1, 128) + 1 : 0;
        p0[r] += tab[i0];
        p1[r] += tab[i1];
        if ((r & 3) == 3) __builtin_amdgcn_sched_barrier(0);
    }
}
__device__ __forceinline__ int rel_bucket(int n) {
    if (n < 16) return n;
    const float v = logf((float)n / 16.0f) / 2.0794415416798357f * 16.0f;
    int l = 16 + (int)v; return l < 31 ? l : 31;
}
__device__ __forceinline__ u32x4 tile_ld(const bf16_t* base, long ld, int row0, int rmin, int rmax, int tid) {
    int r = row0 + (tid >> 3); r = r < rmin ? rmin : (r > rmax ? rmax : r);
    return *(const u32x4*)(base + (long)r * ld + (tid & 7) * 8);
}
__device__ __forceinline__ void tile_st(LAS unsigned char* buf, u32x4 v, int tid) { *(LAS u32x4*)(buf + (tid >> 3) * ROWB + (tid & 7) * 16) = v; }
__device__ __forceinline__ void tile_stv(LAS unsigned char* buf, u32x4 v, int tid) { *(LAS u32x4*)(buf + (tid >> 3) * VROWB + (tid & 7) * 16) = v; }
__device__ __forceinline__ void load_q(bf16x8 (&qr)[4], const bf16_t* qrow, int hi) {
#pragma unroll
    for (int d0 = 0; d0 < 4; ++d0) qr[d0] = *(const bf16x8*)(qrow + d0 * 16 + hi * 8);
}
__device__ __forceinline__ void store_o(bf16_t* orow, const f32x16& o0, const f32x16& o1, int hi) {
#pragma unroll
    for (int g = 0; g < 4; ++g) {
        u32x2 w0, w1; w0.x = cvt_pk_bf16(o0[4 * g], o0[4 * g + 1]); w0.y = cvt_pk_bf16(o0[4 * g + 2], o0[4 * g + 3]);
        w1.x = cvt_pk_bf16(o1[4 * g], o1[4 * g + 1]); w1.y = cvt_pk_bf16(o1[4 * g + 2], o1[4 * g + 3]);
        *(u32x2*)(orow + 8 * g + 4 * hi) = w0; *(u32x2*)(orow + 32 + 8 * g + 4 * hi) = w1;
    }
}
__device__ __forceinline__ void add_prev_o(const bf16_t* orow, f32x16& o0, f32x16& o1, int hi) {
#pragma unroll
    for (int g = 0; g < 4; ++g) {
        const u32x2 w0 = *(const u32x2*)(orow + 8 * g + 4 * hi), w1 = *(const u32x2*)(orow + 32 + 8 * g + 4 * hi);
        o0[4 * g] += __uint_as_float(w0.x << 16); o0[4 * g + 1] += __uint_as_float(w0.x & 0xffff0000u); o0[4 * g + 2] += __uint_as_float(w0.y << 16); o0[4 * g + 3] += __uint_as_float(w0.y & 0xffff0000u);
        o1[4 * g] += __uint_as_float(w1.x << 16); o1[4 * g + 1] += __uint_as_float(w1.x & 0xffff0000u); o1[4 * g + 2] += __uint_as_float(w1.y << 16); o1[4 * g + 3] += __uint_as_float(w1.y & 0xffff0000u);
    }
}
__device__ __forceinline__ float sigmoidf(float x) { return 1.0f / (1.0f + __expf(-x)); }

constexpr int L_K0 = 0, L_K1 = TILEB, L_V0 = 2 * TILEB, L_V1 = 2 * TILEB + VTILEB, L_TAB = 2 * TILEB + 2 * VTILEB  , L_SIMP = 53248  , L_Q = 53248  , L_BKT = 131072  , L_MISC = 131072 + 1024  ;

__device__ __forceinline__ const LAS unsigned char* park_q(LAS unsigned char* lds, const bf16_t* q0, const bf16_t* q1, int wid, int lane, int hi) {
    LAS unsigned char* qp = lds + L_Q + wid * 8192 + lane * 16;
#pragma unroll
    for (int d0 = 0; d0 < 4; ++d0) { *(LAS bf16x8*)(qp + d0 * 1024) = *(const bf16x8*)(q0 + d0 * 16 + hi * 8); *(LAS bf16x8*)(qp + 4096 + d0 * 1024) = *(const bf16x8*)(q1 + d0 * 16 + hi * 8); }
    return qp;
}
__device__ __forceinline__ void fill_tab(LAS unsigned char* lds, const float* relb, int h0, int nh, int tid) {
    LAS float* tab = (LAS float*)(lds + L_TAB);
    const LAS int* bkt = (const LAS int*)(lds + L_BKT);
    for (int i = tid; i < nh * 130; i += NTHR) { const int hh = i / 130, d = i % 130; tab[hh * 132 + d] = d == 0 ? NEG : relb[bkt[d] * NH + h0 + hh] * 8.0f; }
}

template <int MODE>
struct TileInfo { bool want, near, allow; float cinit; };
template <int MODE>
__device__ __forceinline__ TileInfo<MODE> classify(int kt, int tw, unsigned selmask, int blkshift, int W, float b129) {
    TileInfo<MODE> ti; const int kbase = kt * 64;
    if (MODE == 0) { ti.want = true; ti.near = false; ti.allow = true; ti.cinit = 0.f; }
    else if (MODE == 1) { ti.allow = (selmask >> (kt >> blkshift)) & 1u; ti.want = (kbase <= tw + 31) && __any(ti.allow); ti.near = !(tw - (kbase + 63) >= 128); ti.cinit = ti.near ? 0.f : (ti.allow ? b129 : NEG); }
    else { ti.allow = true; ti.want = (kbase <= tw + 31) && (kbase + 63 >= tw - (W - 1)); ti.near = !((tw - (kbase + 63) >= 128) && (tw + 31 - kbase < W)); ti.cinit = ti.near ? 0.f : b129; }
    return ti;
}
template <int MODE, bool QREG>
__device__ __forceinline__ void seg2(Acc (&A)[2], LAS unsigned char* lds, const bf16_t* Kg, const bf16_t* Vg, long ld, int rmax, int lo, int hi_t,
                                     const LAS unsigned char* qp  , int t0  , int tw0, unsigned sel0, unsigned sel1, int blkshift, int W, const LAS float* tab, int tid) {
    const int lane = tid & 63, r32 = lane & 31, hi = lane >> 5;
    if (lo >= hi_t) return;
    {
        const u32x4 k0 = tile_ld(Kg, ld, lo * 64, 0, rmax, tid), v0 = tile_ld(Vg, ld, lo * 64, 0, rmax, tid);
        __syncthreads();
        tile_st(lds + L_K0, k0, tid); tile_stv(lds + L_V0, v0, tid);
        __syncthreads();
    }
    const float b129 = (MODE == 0) ? 0.f : tab[129];
    const int g1 = (lane >> 4) & 1, i16 = lane & 15, q_ = i16 >> 2, p_ = i16 & 3;
    bf16x8 qra[4], qrb[4];
    if (QREG) {
#pragma unroll
        for (int d0 = 0; d0 < 4; ++d0) { qra[d0] = *(const LAS bf16x8*)(qp + d0 * 1024); qrb[d0] = *(const LAS bf16x8*)(qp + 4096 + d0 * 1024); }
    }
    int cur = 0;
    for (int kt = lo; kt < hi_t; ++kt) {
        const bool more1 = kt + 1 < hi_t;
        u32x4 kreg, vreg;
        if (more1) { kreg = tile_ld(Kg, ld, (kt + 1) * 64, 0, rmax, tid); vreg = tile_ld(Vg, ld, (kt + 1) * 64, 0, rmax, tid); }
        TileInfo<MODE> ta = classify<MODE>(kt, tw0, sel0, blkshift, W, b129), tb = classify<MODE>(kt, tw0 + 32, sel1, blkshift, W, b129);
        if (ta.want || tb.want) {
            if (!ta.want) { ta.cinit = NEG; ta.near = false; }
            if (!tb.want) { tb.cinit = NEG; tb.near = false; }
            const LAS unsigned char* Kt = lds + (cur ? L_K1 : L_K0); const LAS unsigned char* Vt = lds + (cur ? L_V1 : L_V0);
            f32x16 a0, a1, b0, b1;
#pragma unroll
            for (int i = 0; i < 16; ++i) { a0[i] = ta.cinit; a1[i] = ta.cinit; b0[i] = tb.cinit; b1[i] = tb.cinit; }
            const LAS unsigned char* kb = Kt + r32 * ROWB + hi * 16;
#pragma unroll
            for (int d0 = 0; d0 < 4; ++d0) {
                const bf16x8 k0 = *(const LAS bf16x8*)(kb + d0 * 32);
                const bf16x8 k1 = *(const LAS bf16x8*)(kb + 32 * ROWB + d0 * 32);
                const bf16x8 qa = QREG ? qra[d0] : *(const LAS bf16x8*)(qp + d0 * 1024), qb_ = QREG ? qrb[d0] : *(const LAS bf16x8*)(qp + 4096 + d0 * 1024);
                a0 = __builtin_amdgcn_mfma_f32_32x32x16_bf16(k0, qa, a0, 0, 0, 0);
                b0 = __builtin_amdgcn_mfma_f32_32x32x16_bf16(k0, qb_, b0, 0, 0, 0);
                a1 = __builtin_amdgcn_mfma_f32_32x32x16_bf16(k1, qa, a1, 0, 0, 0);
                b1 = __builtin_amdgcn_mfma_f32_32x32x16_bf16(k1, qb_, b1, 0, 0, 0);
            }
            if (MODE != 0) {
                if (ta.near) apply_general(a0, a1, t0 - kt * 64 - 4 * hi, tab, ta.allow, W);
                if (tb.near) apply_general(b0, b1, t0 + 32 - kt * 64 - 4 * hi, tab, tb.allow, W);
            }
            sm_update2(A[0], A[1], a0, a1, b0, b1);
            const LAS unsigned char* vb = Vt + (4 * hi + q_) * VROWB + (16 * g1 + 4 * p_) * 2;
#pragma unroll
            for (int s = 0; s < 4; ++s) {
                const int bs = 8 * (s & 1);
                u32x4 wa, wb;
                if (s < 2) { wa.x = cvt_pk_bf16(a0[bs + 0], a0[bs + 1]); wa.y = cvt_pk_bf16(a0[bs + 2], a0[bs + 3]); wa.z = cvt_pk_bf16(a0[bs + 4], a0[bs + 5]); wa.w = cvt_pk_bf16(a0[bs + 6], a0[bs + 7]);
                             wb.x = cvt_pk_bf16(b0[bs + 0], b0[bs + 1]); wb.y = cvt_pk_bf16(b0[bs + 2], b0[bs + 3]); wb.z = cvt_pk_bf16(b0[bs + 4], b0[bs + 5]); wb.w = cvt_pk_bf16(b0[bs + 6], b0[bs + 7]); }
                else       { wa.x = cvt_pk_bf16(a1[bs + 0], a1[bs + 1]); wa.y = cvt_pk_bf16(a1[bs + 2], a1[bs + 3]); wa.z = cvt_pk_bf16(a1[bs + 4], a1[bs + 5]); wa.w = cvt_pk_bf16(a1[bs + 6], a1[bs + 7]);
                             wb.x = cvt_pk_bf16(b1[bs + 0], b1[bs + 1]); wb.y = cvt_pk_bf16(b1[bs + 2], b1[bs + 3]); wb.z = cvt_pk_bf16(b1[bs + 4], b1[bs + 5]); wb.w = cvt_pk_bf16(b1[bs + 6], b1[bs + 7]); }
                const bf16x8 pfa = __builtin_bit_cast(bf16x8, wa), pfb = __builtin_bit_cast(bf16x8, wb);
#pragma unroll
                for (int dh = 0; dh < 2; ++dh) {
                    const s16x4 lo4 = vtr(vb + (16 * s) * VROWB + dh * 64);
                    const s16x4 h4 = vtr(vb + (16 * s + 8) * VROWB + dh * 64);
                    const bf16x8 vf = (bf16x8){lo4[0], lo4[1], lo4[2], lo4[3], h4[0], h4[1], h4[2], h4[3]};
                    if (dh == 0) { A[0].o0 = __builtin_amdgcn_mfma_f32_32x32x16_bf16(vf, pfa, A[0].o0, 0, 0, 0); A[1].o0 = __builtin_amdgcn_mfma_f32_32x32x16_bf16(vf, pfb, A[1].o0, 0, 0, 0); }
                    else         { A[0].o1 = __builtin_amdgcn_mfma_f32_32x32x16_bf16(vf, pfa, A[0].o1, 0, 0, 0); A[1].o1 = __builtin_amdgcn_mfma_f32_32x32x16_bf16(vf, pfb, A[1].o1, 0, 0, 0); }
                }
            }
        }
        if (more1) { tile_st(lds + (cur ? L_K0 : L_K1), kreg, tid); tile_stv(lds + (cur ? L_V0 : L_V1), vreg, tid); }
        __syncthreads();
        cur ^= 1;
    }
}
}

struct Ctx { int tid, lane, wid, gtid, gsz, gw, ngw; };

template <int MAP>
__device__ __forceinline__ void xpose_w(const Ctx& c, const float* W, int K, int N, bf16_t* WT, int Ndst, int dst_off = 0) {
    const int nk = K >> 6; const long total = (long)Ndst * nk;
    for (long i = c.gtid; i < total; i += c.gsz) {
        const int n = (int)(i % Ndst), kc = (int)(i / Ndst);
        int src = n;
        if (MAP == 1) { if (n >= 1152 && n < 1408) src = 1188 + (n - 1152); else if (n >= 1408 && n < 1444) src = 1152 + (n - 1408); else if (n >= 1444) src = -1; }
        else if (MAP == 2) { const int tl = n >> 8, wi = n & 255; src = wi < 128 ? tl * 128 + wi : 2816 + tl * 128 + (wi - 128); }
        else if (n >= N) src = -1;
        bf16_t* dst = WT + (size_t)(dst_off + n) * K + kc * 64;
        if (src < 0) {
#pragma unroll
            for (int q = 0; q < 8; ++q) *(u32x4*)(dst + q * 8) = (u32x4){0u, 0u, 0u, 0u};
        } else {
            const float* s = W + (size_t)(kc * 64) * N + src;
            float v[64];
#pragma unroll
            for (int k = 0; k < 64; ++k) v[k] = s[(size_t)k * N];
#pragma unroll
            for (int q = 0; q < 8; ++q) {
                u32x4 w; w.x = cvt_pk_bf16(v[8 * q], v[8 * q + 1]); w.y = cvt_pk_bf16(v[8 * q + 2], v[8 * q + 3]); w.z = cvt_pk_bf16(v[8 * q + 4], v[8 * q + 5]); w.w = cvt_pk_bf16(v[8 * q + 6], v[8 * q + 7]);
                *(u32x4*)(dst + q * 8) = w;
            }
        }
    }
}
__device__ __forceinline__ void cvt_rows(const Ctx& c, const float* X, bf16_t* XB, long nelem) {
    const long n8 = nelem >> 3;
    for (long i0 = c.gtid; i0 < n8; i0 += 4l * c.gsz) {
        f32x4 a[4], b[4];
#pragma unroll
        for (int u = 0; u < 4; ++u) { const long i = i0 + (long)u * c.gsz; if (i < n8) { a[u] = __builtin_nontemporal_load((const f32x4*)(X + i * 8)); b[u] = __builtin_nontemporal_load((const f32x4*)(X + i * 8 + 4)); } }
#pragma unroll
        for (int u = 0; u < 4; ++u) { const long i = i0 + (long)u * c.gsz; if (i < n8) {
            u32x4 w; w.x = cvt_pk_bf16(a[u][0], a[u][1]); w.y = cvt_pk_bf16(a[u][2], a[u][3]); w.z = cvt_pk_bf16(b[u][0], b[u][1]); w.w = cvt_pk_bf16(b[u][2], b[u][3]);
            *(u32x4*)(XB + i * 8) = w; } }
    }
}
__device__ __forceinline__ void prep_late(const Params& p, const Ctx& c) {
    unsigned char* ws = p.ws;
    xpose_w<0>(c, p.in[I_AWOUT], DM, DM, (bf16_t*)(ws + WS_WAOUT), DM);
    xpose_w<0>(c, p.in[I_SWKV], DM, 1536, (bf16_t*)(ws + WS_WSKV), 1536);
    xpose_w<0>(c, p.in[I_BWIN], DM, DM, (bf16_t*)(ws + WS_WBIN), DM);
    xpose_w<0>(c, p.in[I_BWOUT], DM, DM, (bf16_t*)(ws + WS_WBOUT), DM);
    for (int l = 0; l < 2; ++l) {
        xpose_w<2>(c, p.in[I_FWIN] + (size_t)l * DM * 2 * DFF, DM, 2 * DFF, (bf16_t*)(ws + WS_WFIN) + (size_t)l * 2 * DFF * DM, 2 * DFF);
        xpose_w<0>(c, p.in[I_FWOUT] + (size_t)l * DFF * DM, DFF, DM, (bf16_t*)(ws + WS_WFOUT) + (size_t)l * DM * DFF, DM);
    }
}
constexpr int LATE_FIRST_WG = 160;
__device__ __forceinline__ void phase_prep(const Params& p, const Ctx& c) {
    unsigned char* ws = p.ws;
    xpose_w<1>(c, p.in[I_AWIN], DM, AIN, (bf16_t*)(ws + WS_WAIN), AINP);
    xpose_w<0>(c, p.in[I_AWMKV], DM, 512, (bf16_t*)(ws + WS_WMKV), 512, 0);
    xpose_w<0>(c, p.in[I_BWMKV], DM, 512, (bf16_t*)(ws + WS_WMKV), 512, 512);
    xpose_w<0>(c, p.in[I_W1K], 2048, 256, (bf16_t*)(ws + WS_WC1K), 256);
    xpose_w<0>(c, p.in[I_W1V], 2048, 256, (bf16_t*)(ws + WS_WC1V), 256);
    if ((int)gridDim.x < LATE_FIRST_WG + 32) prep_late(p, c);
    cvt_rows(c, p.in[I_X], (bf16_t*)(ws + WS_XB), (long)NTOK * DM);
    cvt_rows(c, p.in[I_MEM], (bf16_t*)(ws + WS_MEMB), (long)BATCH * NMEM * DM);
    for (int o = c.gw; o < 512; o += c.ngw) {
        const int which = o >> 8, j = o & 255;
        const float* pe = p.in[which ? I_PEV : I_PEK]; const float* w1 = p.in[which ? I_W1V : I_W1K];
        float s = 0.f;
#pragma unroll 8
        for (int k = c.lane; k < 2048; k += 64) s += pe[k] * w1[(size_t)k * 256 + j];
#pragma unroll
        for (int sh = 1; sh < 64; sh <<= 1) s += __shfl_xor(s, sh);
        if (c.lane == 0) ((float*)(ws + WS_CBIAS))[which * 256 + j] = s;
    }
}
__device__ __forceinline__ void phase_cmp2(const Params& p, const Ctx& c) {
    unsigned char* ws = p.ws;
    for (int i = c.gtid; i < 2 * 4096 * 64; i += c.gsz) {
        const int which = i >> 18, m = (i >> 6) & 4095, d = i & 63;
        const float* hid = (const float*)(ws + WS_CMPH) + ((size_t)which * 4096 + m) * 256; const float* w2 = p.in[which ? I_W2V : I_W2K];
        float s = 0.f;
#pragma unroll 8
        for (int j = 0; j < 256; ++j) s += hid[j] * w2[j * 64 + d];
        if ((m & 127) == 127) s = 0.f;
        unsigned u = __float_as_uint(s); u = (u + 0x7fffu + ((u >> 16) & 1u)) >> 16;
        ((bf16_t*)(ws + (which ? WS_VCMP : WS_KCMP)))[(size_t)m * 64 + d] = (bf16_t)u;
    }
}
__device__ __forceinline__ void phase_ln(const Ctx& c, const float* y, const float* g, const float* bta, float* xf, bf16_t* xb) {
    for (int row = c.gw; row < NTOK; row += c.ngw) {
        const float* yr = y + (size_t)row * DM + c.lane * 4;
        f32x4 v[4]; float s = 0.f;
#pragma unroll
        for (int j = 0; j < 4; ++j) { v[j] = *(const f32x4*)(yr + 256 * j); s += (v[j][0] + v[j][1]) + (v[j][2] + v[j][3]); }
#pragma unroll
        for (int o = 1; o < 64; o <<= 1) s += __shfl_xor(s, o);
        const float mean = s * (1.0f / DM); float q = 0.f;
#pragma unroll
        for (int j = 0; j < 4; ++j) { v[j] = v[j] - mean; q += (v[j][0] * v[j][0] + v[j][1] * v[j][1]) + (v[j][2] * v[j][2] + v[j][3] * v[j][3]); }
#pragma unroll
        for (int o = 1; o < 64; o <<= 1) q += __shfl_xor(q, o);
        const float rstd = 1.0f / sqrtf(q * (1.0f / DM) + LN_EPS);
#pragma unroll
        for (int j = 0; j < 4; ++j) {
            const f32x4 gg = *(const f32x4*)(g + c.lane * 4 + 256 * j), bb = *(const f32x4*)(bta + c.lane * 4 + 256 * j);
            const f32x4 o = v[j] * rstd * gg + bb;
            if (xf) *(f32x4*)(xf + (size_t)row * DM + c.lane * 4 + 256 * j) = o;
            if (xb) { u32x2 w; w.x = cvt_pk_bf16(o[0], o[1]); w.y = cvt_pk_bf16(o[2], o[3]); *(u32x2*)(xb + (size_t)row * DM + c.lane * 4 + 256 * j) = w; }
        }
    }
}
__device__ __forceinline__ void unpack8(const u32x4 w, float (&f)[8]) {
    f[0] = __uint_as_float(w.x << 16); f[1] = __uint_as_float(w.x & 0xffff0000u); f[2] = __uint_as_float(w.y << 16); f[3] = __uint_as_float(w.y & 0xffff0000u);
    f[4] = __uint_as_float(w.z << 16); f[5] = __uint_as_float(w.z & 0xffff0000u); f[6] = __uint_as_float(w.w << 16); f[7] = __uint_as_float(w.w & 0xffff0000u);
}
__device__ __forceinline__ void ffn_fixup(const Ctx& c, unsigned char* big, const float* cw, const float* cbias, int pm) {
    const float* TAILA = (const float*)(big + BIG_TAILA); const float* HEADA = (const float*)(big + BIG_HEADA); const float* HEADB = (const float*)(big + BIG_HEADB); bf16_t* H = (bf16_t*)(big + BIG_H);
    constexpr int NCH = DFF / 8;
    for (int it = c.tid; it < 4 * 2 * NCH; it += NTHR) {
        const int ch = it % NCH, gi = it / NCH, i = gi & 1, G = pm * 4 + (gi >> 1), col = ch * 8;
        const bool first = ((G * 64) & (SEQ - 1)) == 0;
        float p0[8], p1[8], a0[8], a1[8], b[8], h[8];
#pragma unroll
        for (int j = 0; j < 8; ++j) { p0[j] = 0.f; p1[j] = 0.f; }
        if (!first) {
            const float* t0 = TAILA + ((size_t)(G - 1) * 2) * DFF + col;
#pragma unroll
            for (int j = 0; j < 8; ++j) { p0[j] = t0[j]; p1[j] = t0[DFF + j]; }
        }
        const float* ha = HEADA + ((size_t)G * 2) * DFF + col; const float* hb = HEADB + ((size_t)G * 2 + i) * DFF + col;
#pragma unroll
        for (int j = 0; j < 8; ++j) { a0[j] = ha[j]; a1[j] = ha[DFF + j]; b[j] = hb[j]; }
#pragma unroll
        for (int j = 0; j < 8; ++j) {
            const float am2 = i ? p1[j] : p0[j], am1 = i ? a0[j] : p1[j], a = i ? a1[j] : a0[j];
            const float pre = cw[col + j] * am2 + cw[DFF + col + j] * am1 + cw[2 * DFF + col + j] * a + cbias[col + j];
            h[j] = gelu_tanh(pre) * b[j];
        }
        u32x4 w; w.x = cvt_pk_bf16(h[0], h[1]); w.y = cvt_pk_bf16(h[2], h[3]); w.z = cvt_pk_bf16(h[4], h[5]); w.w = cvt_pk_bf16(h[6], h[7]);
        *(u32x4*)(H + (size_t)(G * 64 + i) * DFF + col) = w;
    }
}
__device__ __forceinline__ void phase_kmean(const Ctx& c, const bf16_t* KV, float* KM) {
    for (int it = c.gw; it < BATCH * 8 * 12; it += c.ngw) {
        const int cg_ = it % 12, bn = it / 12, ch = c.lane & 7, rs = c.lane >> 3;
        float s[8];
#pragma unroll
        for (int j = 0; j < 8; ++j) s[j] = 0.f;
        const bf16_t* src = KV + (size_t)bn * 256 * 1536 + cg_ * 64 + ch * 8;
#pragma unroll 4
        for (int r = rs; r < 256; r += 8) { float v[8]; unpack8(*(const u32x4*)(src + (size_t)r * 1536), v);
#pragma unroll
            for (int j = 0; j < 8; ++j) s[j] += v[j]; }
#pragma unroll
        for (int j = 0; j < 8; ++j) { s[j] += __shfl_xor(s[j], 8); s[j] += __shfl_xor(s[j], 16); s[j] += __shfl_xor(s[j], 32); }
        if (rs == 0) {
#pragma unroll
            for (int j = 0; j < 8; ++j) KM[(size_t)bn * 768 + cg_ * 64 + ch * 8 + j] = s[j] * (1.0f / 256.0f);
        }
    }
}

__device__ __forceinline__ void nsa1_unit(const Params& p, LAS unsigned char* lds, int b, int qb) {
    using namespace att;
    int tid_ = threadIdx.x; asm volatile("" : "+v"(tid_));
    const int tid = tid_, lane = tid & 63, r32 = lane & 31, hi = lane >> 5, wid = tid >> 6;
    unsigned char* ws = p.ws;
    const bf16_t* P = (const bf16_t*)(ws + WS_BIG + BIG_P); bf16_t* O = (bf16_t*)(ws + WS_BIG + BIG_O0);
    const bf16_t* KC = (const bf16_t*)(ws + WS_KCMP) + (size_t)b * 128 * 64; const bf16_t* VC = (const bf16_t*)(ws + WS_VCMP) + (size_t)b * 128 * 64;
    __syncthreads();
    tile_st(lds + L_K0, tile_ld(KC, 64, 0, 0, 127, tid), tid); tile_st(lds + L_K1, tile_ld(KC, 64, 64, 0, 127, tid), tid);
    tile_stv(lds + L_V0, tile_ld(VC, 64, 0, 0, 127, tid), tid); tile_stv(lds + L_V1, tile_ld(VC, 64, 64, 0, 127, tid), tid);
    fill_tab(lds, p.in[I_RELB], 0, NH, tid);
    __syncthreads();
    const int t = qb * 256 + wid * 32 + r32; const size_t row = (size_t)b * SEQ + t;
    LAS float* simp = (LAS float*)(lds + L_SIMP) + (wid * 32 + r32) * 33;
#pragma unroll
    for (int i = 0; i < 16; ++i) simp[2 * i + hi] = 0.f;
#pragma nounroll
    for (int h = 0; h < NH; ++h) {
        bf16x8 qr[4]; load_q(qr, P + row * AINP + P_Q + h * 64, hi);
        f32x16 pp[4];
        qk_tile(pp[0], pp[1], lds + L_K0, qr, r32, hi); qk_tile(pp[2], pp[3], lds + L_K1, qr, r32, hi);
        const LAS float* tab = (const LAS float*)(lds + L_TAB) + h * 132;
        float mx = NEG;
        const int tws = __builtin_amdgcn_readfirstlane(t - r32);
#pragma unroll
        for (int a = 0; a < 4; ++a) {
            if (tws >= 512 * a + 655) { const float bb = tab[129];
#pragma unroll
                for (int r = 0; r < 16; ++r) { const float s = pp[a][r] + bb; pp[a][r] = s; mx = fmaxf(mx, s); } }
            else if (tws < 512 * a) {
#pragma unroll
                for (int r = 0; r < 16; ++r) pp[a][r] = NEG; }
            else {
#pragma unroll
                for (int r = 0; r < 16; ++r) { const int n = (r & 3) + 8 * (r >> 2) + 4 * hi + 32 * a; const int d = t - 30 - 16 * n;
                    const float s = pp[a][r] + tab[min(max(d, 0), 129)]; pp[a][r] = s; mx = fmaxf(mx, s); } }
        }
        mx = fmaxf(mx, __shfl_xor(mx, 32));
        const bool dead = mx < -5e29f;
        const float msc = (dead ? 0.f : mx) * SC2;
        float sum = 0.f;
#pragma unroll
        for (int a = 0; a < 4; ++a)
#pragma unroll
            for (int r = 0; r < 16; ++r) { const float e = __builtin_amdgcn_exp2f(pp[a][r] * SC2 - msc); pp[a][r] = e; sum += e; }
        sum += __shfl_xor(sum, 32);
        const float inv = dead ? 0.f : 1.0f / fmaxf(sum, 1e-30f);
#pragma unroll
        for (int a = 0; a < 4; ++a)
#pragma unroll
            for (int r = 0; r < 16; ++r) pp[a][r] *= inv;
#pragma unroll
        for (int a = 0; a < 4; ++a)
#pragma unroll
            for (int g = 0; g < 4; ++g) {
                const float gs = (pp[a][4 * g] + pp[a][4 * g + 1]) + (pp[a][4 * g + 2] + pp[a][4 * g + 3]);
                const float lastv = pp[a][4 * g + 3];
                const float shifted = (g >= 1) ? pp[a][4 * (g - 1) + 3] : ((a >= 1) ? pp[(a >= 1) ? a - 1 : 0][15] : 0.f);
                const float snd = hi ? shifted : lastv;
                const float rcv = __shfl_xor(snd, 32);
                simp[8 * a + 2 * g + hi] += gs + rcv;
            }
        f32x16 o0 = zero16(), o1 = zero16();
        pv_tile(o0, o1, lds + L_V0, pp[0], pp[1], lane); pv_tile(o0, o1, lds + L_V1, pp[2], pp[3], lane);
        const float gate = sigmoidf(bf2f(P[row * AINP + P_G + h * 3 + 0]));
#pragma unroll
        for (int r = 0; r < 16; ++r) { o0[r] *= gate; o1[r] *= gate; }
        store_o(O + row * DM + h * 64, o0, o1, hi);
    }
    __syncthreads();
    const int cur = t >> 6; unsigned mask;
    if (cur < 16) mask = (2u << cur) - 1u;
    else {
        mask = 1u | (1u << cur) | (1u << (cur - 1));
        unsigned cand = ((1u << (cur - 1)) - 1u) & ~1u;
#pragma nounroll
        for (int k = 0; k < 13; ++k) {
            float best = -3e38f; int bi = 0;
#pragma nounroll
            for (int s = 1; s <= 29; ++s) { const float v = simp[s]; const bool take = ((cand >> s) & 1u) && (v > best); best = take ? v : best; bi = take ? s : bi; }
            mask |= 1u << bi; cand &= ~(1u << bi);
        }
    }
    if (hi == 0) ((unsigned*)(ws + WS_SEL))[row] = mask;
}
__device__ __forceinline__ void nsa2_unit(const Params& p, LAS unsigned char* lds, int b, int h0, int qb) {
    using namespace att;
    int tid_ = threadIdx.x; asm volatile("" : "+v"(tid_));
    const int tid = tid_, lane = tid & 63, r32 = lane & 31, hi = lane >> 5, wid = tid >> 6;
    unsigned char* ws = p.ws;
    const bf16_t* P = (const bf16_t*)(ws + WS_BIG + BIG_P); bf16_t* O = (bf16_t*)(ws + WS_BIG + BIG_O0);
    __syncthreads();
    fill_tab(lds, p.in[I_RELB], h0, 2, tid);
    const int h = h0 + (wid >> 2);
    const LAS float* tab = (const LAS float*)(lds + L_TAB) + (wid >> 2) * 132;
    const int tw0 = qb * 256 + (wid & 3) * 64, t0 = tw0 + r32; const size_t row0 = (size_t)b * SEQ + t0, row1 = row0 + 32;
    const LAS unsigned char* qp = park_q(lds, P + row0 * AINP + P_Q + h * 64, P + row1 * AINP + P_Q + h * 64, wid, lane, hi);
    const unsigned sel0 = ((const unsigned*)(ws + WS_SEL))[row0], sel1 = ((const unsigned*)(ws + WS_SEL))[row1];
    const bf16_t* Pb = P + (size_t)b * SEQ * AINP;
    Acc A[2]; acc_init(A[0]); acc_init(A[1]);
    seg2<1, false>(A, lds, Pb + P_KS, Pb + P_VS, AINP, SEQ - 1, 0, qb * 4 + 4, qp, t0, tw0, sel0, sel1, 0, 1 << 30, tab, tid);
#pragma unroll
    for (int s = 0; s < 2; ++s) {
        const size_t row = s ? row1 : row0;
        const float gs = sigmoidf(bf2f(P[row * AINP + P_G + h * 3 + 1])) * acc_inv(A[s]);
#pragma unroll
        for (int r = 0; r < 16; ++r) { A[s].o0[r] *= gs; A[s].o1[r] *= gs; }
        bf16_t* orow = O + row * DM + h * 64;
        add_prev_o(orow, A[s].o0, A[s].o1, hi); store_o(orow, A[s].o0, A[s].o1, hi);
        acc_init(A[s]);
    }
    const int wlo = qb * 4 - 8 < 0 ? 0 : qb * 4 - 8;
    seg2<2, false>(A, lds, Pb + P_KW, Pb + P_VW, AINP, SEQ - 1, wlo, qb * 4 + 4, qp, t0, tw0, 0u, 0u, 0, 512, tab, tid);
#pragma unroll
    for (int s = 0; s < 2; ++s) {
        const size_t row = s ? row1 : row0;
        const float gw = sigmoidf(bf2f(P[row * AINP + P_G + h * 3 + 2])) * acc_inv(A[s]);
#pragma unroll
        for (int r = 0; r < 16; ++r) { A[s].o0[r] *= gw; A[s].o1[r] *= gw; }
        bf16_t* orow = O + row * DM + h * 64;
        add_prev_o(orow, A[s].o0, A[s].o1, hi); store_o(orow, A[s].o0, A[s].o1, hi);
    }
}
__device__ __forceinline__ unsigned moba_select(const float* KM, const bf16x8 (&qr)[4], int b, int h, int qb, int hi) {
    float gt[7];
#pragma unroll
    for (int n = 0; n < 7; ++n) {
        float s = 0.f;
        if (n < qb) {
            const float* km = KM + ((size_t)(b * 8 + n) * NH + h) * 64 + hi * 8;
#pragma unroll
            for (int d0 = 0; d0 < 4; ++d0) { const f32x4 k0 = *(const f32x4*)(km + d0 * 16), k1 = *(const f32x4*)(km + d0 * 16 + 4);
                s += bf2f((unsigned short)qr[d0][0]) * k0[0] + bf2f((unsigned short)qr[d0][1]) * k0[1] + bf2f((unsigned short)qr[d0][2]) * k0[2] + bf2f((unsigned short)qr[d0][3]) * k0[3]
                   + bf2f((unsigned short)qr[d0][4]) * k1[0] + bf2f((unsigned short)qr[d0][5]) * k1[1] + bf2f((unsigned short)qr[d0][6]) * k1[2] + bf2f((unsigned short)qr[d0][7]) * k1[3]; }
        }
        s += __shfl_xor(s, 32);
        gt[n] = s;
    }
    unsigned sel = 1u << qb, cand = (1u << qb) - 1u;
#pragma nounroll
    for (int k = 0; k < 3; ++k) {
        float best = -3e38f; int bi = -1;
#pragma unroll
        for (int n = 0; n < 7; ++n) { const bool take = ((cand >> n) & 1u) && (gt[n] > best); best = take ? gt[n] : best; bi = take ? n : bi; }
        if (bi >= 0) { sel |= 1u << bi; cand &= ~(1u << bi); }
    }
    return sel;
}
__device__ __forceinline__ void moba_unit(const Params& p, LAS unsigned char* lds, int b, int h, int qp) {
    using namespace att;
    int tid_ = threadIdx.x; asm volatile("" : "+v"(tid_));
    const int tid = tid_, lane = tid & 63, r32 = lane & 31, hi = lane >> 5, wid = tid >> 6;
    unsigned char* ws = p.ws;
    const bf16_t* KV = (const bf16_t*)(ws + WS_BIG + BIG_KV); const bf16_t* Q = (const bf16_t*)(ws + WS_BIG + BIG_Q1); bf16_t* O = (bf16_t*)(ws + WS_BIG + BIG_O1);
    const float* KM = (const float*)(ws + WS_KMEAN);
    __syncthreads();
    fill_tab(lds, p.in[I_RELB], h, 1, tid);
    const LAS float* tab = (const LAS float*)(lds + L_TAB);
    const int qb = 2 * qp + (wid >> 2);
    const int tw0 = qb * 256 + (wid & 3) * 64, t0 = tw0 + r32; const size_t row0 = (size_t)b * SEQ + t0, row1 = row0 + 32;
    unsigned sel0, sel1;
    { bf16x8 qr[4]; load_q(qr, Q + row0 * DM + h * 64, hi); sel0 = moba_select(KM, qr, b, h, qb, hi); }
    { bf16x8 qr[4]; load_q(qr, Q + row1 * DM + h * 64, hi); sel1 = moba_select(KM, qr, b, h, qb, hi); }
    const LAS unsigned char* qp_ = park_q(lds, Q + row0 * DM + h * 64, Q + row1 * DM + h * 64, wid, lane, hi);
    const bf16_t* Kb = KV + (size_t)b * SEQ * 1536 + h * 64;
    Acc A[2]; acc_init(A[0]); acc_init(A[1]);
    seg2<1, true>(A, lds, Kb, Kb + MAINW, 1536, SEQ - 1, 0, qp * 8 + 8, qp_, t0, tw0, sel0, sel1, 2, 1 << 30, tab, tid);
#pragma unroll
    for (int s = 0; s < 2; ++s) {
        const float inv = acc_inv(A[s]);
#pragma unroll
        for (int r = 0; r < 16; ++r) { A[s].o0[r] *= inv; A[s].o1[r] *= inv; }
        store_o(O + (s ? row1 : row0) * DM + h * 64, A[s].o0, A[s].o1, hi);
    }
}
__device__ __forceinline__ void mem_unit(const Params& p, LAS unsigned char* lds, const bf16_t* Q, int ldq, int qcol, bf16_t* O, int kvcol, int b, int mh, int qq) {
    using namespace att;
    int tid_ = threadIdx.x; asm volatile("" : "+v"(tid_));
    const int tid = tid_, lane = tid & 63, r32 = lane & 31, hi = lane >> 5, wid = tid >> 6;
    const bf16_t* MKV = (const bf16_t*)(p.ws + WS_MKV) + (size_t)b * NMEM * 1024 + kvcol + mh * 64;
    const int tw0 = qq * 512 + wid * 64, t0 = tw0 + r32; const size_t row0 = (size_t)b * SEQ + t0, row1 = row0 + 32;
    __syncthreads();
    const LAS unsigned char* qp = park_q(lds, Q + row0 * ldq + qcol + mh * 64, Q + row1 * ldq + qcol + mh * 64, wid, lane, hi);
    Acc A[2]; acc_init(A[0]); acc_init(A[1]);
    seg2<0, true>(A, lds, MKV, MKV + 256, 1024, NMEM - 1, 0, 4, qp, t0, tw0, 0u, 0u, 0, 1 << 30, (const LAS float*)(lds + L_TAB), tid);
#pragma unroll
    for (int s = 0; s < 2; ++s) {
        const float inv = acc_inv(A[s]);
#pragma unroll
        for (int r = 0; r < 16; ++r) { A[s].o0[r] *= inv; A[s].o1[r] *= inv; }
        store_o(O + (s ? row1 : row0) * DM + MAINW + mh * 64, A[s].o0, A[s].o1, hi);
    }
}

#define XB_TMO      128
#define XB_XCNT(j)  (256  + 64 * (j))
#define XB_XSUB(j)  (1280 + 64 * (j))
#define XB_XGEN(j)  (2304 + 64 * (j))
#define XB_TOP      3328
#define XB_TOPGEN   3392
#define XCD_BAR_WORDS 3456
#define XB_SPIN_CAP (1u << 18)
__device__ __forceinline__ unsigned xb_ld(unsigned* p)              { return __hip_atomic_load(p, __ATOMIC_RELAXED, __HIP_MEMORY_SCOPE_AGENT); }
__device__ __forceinline__ unsigned xb_add(unsigned* p, unsigned v) { return __hip_atomic_fetch_add(p, v, __ATOMIC_RELAXED, __HIP_MEMORY_SCOPE_AGENT); }
__device__ __forceinline__ unsigned xb_xcc_id() { return (unsigned)__builtin_amdgcn_s_getreg((3 << 11) | 20) & 0xFu; }
#define XB_SPIN(cond, bar) do { unsigned _sp = 0; while (cond) { __builtin_amdgcn_s_sleep(1); \
    if ((++_sp & 255u) == 0u) { if (xb_ld(&(bar)[XB_TMO])) break; if (_sp > XB_SPIN_CAP) { atomicAdd(&(bar)[XB_TMO], 1u); break; } } } } while (0)
struct XcdBarrier { unsigned* bar; unsigned x; volatile LAS unsigned* st; };
__device__ __forceinline__ XcdBarrier xcd_barrier_post(unsigned* bar, volatile LAS unsigned* st) {
    XcdBarrier b; b.bar = bar; b.x = xb_xcc_id(); b.st = st;
    if (threadIdx.x == 0) (void)xb_add(&bar[XB_XCNT(b.x)], 1u);
    return b;
}
__device__ __forceinline__ void xcd_barrier_complete(unsigned* bar, unsigned x, unsigned& nloc, unsigned& nx) {
    const unsigned G = gridDim.x * gridDim.y * gridDim.z;
    unsigned sum, cnt, mine, sp = 0u;
    for (;;) {
        sum = 0u; cnt = 0u; mine = 0u;
#pragma unroll
        for (unsigned j = 0; j < 16; ++j) { const unsigned c = xb_ld(&bar[XB_XCNT(j)]); sum += c; cnt += (c > 0u) ? 1u : 0u; mine = (j == x) ? c : mine; }
        if (sum == G) break;
        __builtin_amdgcn_s_sleep(1);
        if ((++sp & 255u) == 0u) { if (xb_ld(&bar[XB_TMO])) break; if (sp > XB_SPIN_CAP) { atomicAdd(&bar[XB_TMO], 1u); break; } }
    }
    nloc = mine > 0u ? mine : 1u; nx = cnt > 0u ? cnt : 1u;
}
__device__ __forceinline__ void xcd_barrier(const XcdBarrier& b) {
    asm volatile("s_waitcnt vmcnt(0)" ::: "memory");
    __syncthreads();
    if (threadIdx.x == 0) {
        unsigned* bar = b.bar;
        __builtin_amdgcn_s_waitcnt(0);
        unsigned nloc = b.st[0], nx = b.st[1];
        if (nloc == 0u) { xcd_barrier_complete(bar, b.x, nloc, nx); b.st[0] = nloc; b.st[1] = nx; }
        const unsigned old = xb_add(&bar[XB_XSUB(b.x)], 1u);
        const unsigned gen = old / nloc;
        if (old + 1u == (gen + 1u) * nloc) {
            __builtin_amdgcn_fence(__ATOMIC_RELEASE, "agent");
            asm volatile("s_waitcnt vmcnt(0)" ::: "memory");
            const unsigned og = xb_add(&bar[XB_TOP], 1u);
            const unsigned tg = og / nx;
            if (og + 1u == (tg + 1u) * nx) xb_add(&bar[XB_TOPGEN], 1u);
            else XB_SPIN(xb_ld(&bar[XB_TOPGEN]) == tg, bar);
            __builtin_amdgcn_fence(__ATOMIC_ACQUIRE, "agent");
            xb_add(&bar[XB_XGEN(b.x)], 1u);
            asm volatile("s_waitcnt vmcnt(0)" ::: "memory");
        } else {
            XB_SPIN(xb_ld(&bar[XB_XGEN(b.x)]) == gen, bar);
            __builtin_amdgcn_fence(__ATOMIC_ACQUIRE, "agent");
            asm volatile("s_waitcnt vmcnt(0)" ::: "memory");
        }
    }
    __syncthreads();
}

enum { PH_PREP = 0, PH_A_GEMM, PH_A_CMP1, PH_A_CMP2, PH_A_NSA1, PH_A_NSA2, PH_A_OUT, PH_A_LN1, PH_A_F0, PH_A_FIX, PH_A_F1, PH_A_LN2,
       PH_B_GEMM, PH_B_KMEAN, PH_B_ATT, PH_B_OUT, PH_B_LN1, PH_B_F0, PH_B_FIX, PH_B_F1, PH_B_LN2, PH_COUNT };

struct GemmJob { pg8::Gemm g; int epi; void* O; const float* aux; const float* aux2; int ldc; int coff; };
__device__ __forceinline__ void set_job(GemmJob& J, const bf16_t* A, const bf16_t* Bt, int M, int N, int K, int lda, int epi, void* O, const float* aux, int ldc) {
    J.g.A = A; J.g.Bt = Bt; J.g.M = M; J.g.N = N; J.g.K = K; J.g.lda = lda; J.g.kstepA = 128; J.epi = epi; J.O = O; J.aux = aux; J.aux2 = nullptr; J.ldc = ldc; J.coff = 0;
}
__device__ __forceinline__ bool gemm_job(const Params& p, int ph, int j, GemmJob& J) {
    unsigned char* ws = p.ws;
    const bf16_t* XB = (const bf16_t*)(ws + WS_XB); const float* XF = (const float*)XB;
    unsigned char* big = ws + WS_BIG;
    const int layer = ph >= PH_B_GEMM ? 1 : 0;
    const bf16_t* Win = (const bf16_t*)(ws + WS_WFIN) + (size_t)layer * 2 * DFF * DM; const bf16_t* Wout = (const bf16_t*)(ws + WS_WFOUT) + (size_t)layer * DM * DFF;
    if (ph == PH_A_GEMM) {
        if (j == 0) { set_job(J, XB, (const bf16_t*)(ws + WS_WAIN), NTOK, AINP, DM, DM, 0, big + BIG_P, nullptr, AINP); return true; }
        return false;
    }
    if (ph == PH_A_CMP1) {
        if (j == 2) { set_job(J, (const bf16_t*)(ws + WS_MEMB), (const bf16_t*)(ws + WS_WMKV), BATCH * NMEM, 1024, DM, DM, 0, ws + WS_MKV, nullptr, 1024); J.coff = 32; return true; }
        if (j >= 3) return false;
        const bf16_t* P = (const bf16_t*)(big + BIG_P);
        set_job(J, P + (j ? P_VC : P_KC), (const bf16_t*)(ws + (j ? WS_WC1V : WS_WC1K)), 4096, 256, 2048, 16 * AINP, 1, (float*)(ws + WS_CMPH) + (size_t)j * 4096 * 256, (const float*)(ws + WS_CBIAS) + j * 256, 256);
        J.g.kstepA = AINP * 2; J.coff = j * 16; return true;
    }
    if (ph == PH_A_OUT) { if (j) return false; set_job(J, (const bf16_t*)(big + BIG_O0), (const bf16_t*)(ws + WS_WAOUT), NTOK, DM, DM, DM, 2, p.out, p.in[I_X], DM); return true; }
    if (ph == PH_B_OUT) { if (j) return false; set_job(J, (const bf16_t*)(big + BIG_O1), (const bf16_t*)(ws + WS_WBOUT), NTOK, DM, DM, DM, 4, p.out, XF, DM); return true; }
    if (ph == PH_B_GEMM) {
        if (j == 0) { set_job(J, XB, (const bf16_t*)(ws + WS_WSKV), NTOK, 1536, DM, DM, 0, big + BIG_KV, nullptr, 1536); return true; }
        if (j == 1) { set_job(J, XB, (const bf16_t*)(ws + WS_WBIN), NTOK, DM, DM, DM, 0, big + BIG_Q1, nullptr, DM); return true; }
        return false;
    }
    const int f = layer ? ph - PH_B_F0 : ph - PH_A_F0;
    if (j) return false;
    if (f == 0) { set_job(J, XB, Win, NTOK, 2 * DFF, DM, DM, 3, big + BIG_H, p.in[I_FCW] + (size_t)layer * 3 * DFF, DFF); J.aux2 = p.in[I_FCB] + (size_t)layer * DFF; return true; }
    if (f == 2) { set_job(J, (const bf16_t*)(big + BIG_H), Wout, NTOK, DM, DFF, DFF, 4, p.out, XF, DM); return true; }
    return false;
}
__device__ __forceinline__ bool is_gemm_phase(int ph) {
    return ph == PH_A_GEMM || ph == PH_A_CMP1 || ph == PH_A_OUT || ph == PH_B_OUT || ph == PH_B_GEMM || ph == PH_A_F0 || ph == PH_A_F1 || ph == PH_B_F0 || ph == PH_B_F1;
}
template <int JJ>
__device__ __forceinline__ void run_gemm_job(const Params& p, LAS unsigned char* lds, int ph) {
    GemmJob J;
    if (!gemm_job(p, ph, JJ, J)) return;
    pg8::StaticOrder S; S.init(J.g.M, J.g.N, (int)gridDim.x, (int)blockIdx.x - J.coff);
    if (J.epi == 0) { pg8::EpiBf16 E{(bf16_t*)J.O, J.ldc}; pg8::gemm_phase<pg8::EpiBf16>(lds, J.g, S, E); }
    else if (J.epi == 1) { pg8::EpiF32BiasGelu E{(float*)J.O, J.ldc, J.aux}; pg8::gemm_phase<pg8::EpiF32BiasGelu>(lds, J.g, S, E); }
    else if (J.epi == 3) { unsigned char* big = p.ws + WS_BIG; pg8::EpiConvGate E{(bf16_t*)J.O, J.aux, J.aux2, (float*)(big + BIG_TAILA), (float*)(big + BIG_HEADA), (float*)(big + BIG_HEADB)}; pg8::gemm_phase<pg8::EpiConvGate>(lds, J.g, S, E); }
    else if (J.epi == 2) { pg8::EpiResF32<true> E{J.aux, (float*)J.O, J.ldc, ALPHA}; pg8::gemm_phase<pg8::EpiResF32<true>>(lds, J.g, S, E); }
    else { pg8::EpiResF32<false> E{J.aux, (float*)J.O, J.ldc, ALPHA}; pg8::gemm_phase<pg8::EpiResF32<false>>(lds, J.g, S, E); }
}
__device__ __forceinline__ void run_gemm_phase(const Params& p, LAS unsigned char* lds, int ph) {
    run_gemm_job<0>(p, lds, ph); run_gemm_job<1>(p, lds, ph); run_gemm_job<2>(p, lds, ph);
}

__device__ __forceinline__ void run_phase(const Params& p, LAS unsigned char* lds, const Ctx& c, int ph) {
    unsigned char* ws = p.ws;
    bf16_t* XB = (bf16_t*)(ws + WS_XB);
    const int G = (int)gridDim.x, bid = (int)blockIdx.x;
    const int vid = (G % 8 == 0) ? (bid % 8) * (G / 8) + bid / 8 : bid;
    if (ph == PH_A_FIX || ph == PH_B_FIX) {
        const int layer = ph == PH_B_FIX ? 1 : 0;
        for (int pm = bid; pm < NTOK / 256; pm += G) ffn_fixup(c, ws + WS_BIG, p.in[I_FCW] + (size_t)layer * 3 * DFF, p.in[I_FCB] + (size_t)layer * DFF, pm);
        return;
    }
    if (ph == PH_A_CMP1 && G >= LATE_FIRST_WG + 32 && bid >= LATE_FIRST_WG) {
        Ctx c2 = c; c2.gtid = (bid - LATE_FIRST_WG) * NTHR + c.tid; c2.gsz = (G - LATE_FIRST_WG) * NTHR;
        prep_late(p, c2);
    }
    if (is_gemm_phase(ph)) { run_gemm_phase(p, lds, ph); return; }
    switch (ph) {
    case PH_PREP: phase_prep(p, c); break;
    case PH_A_CMP2: phase_cmp2(p, c); break;
    case PH_A_NSA1: {
        for (int u = vid; u < BATCH * 8; u += G) nsa1_unit(p, lds, u >> 3, u & 7);
    } break;
    case PH_A_NSA2: {
        for (int u = vid; u < BATCH * (NH / 2) * 4; u += G) { const int b = u / 24, r = u % 24, hp = r >> 2, s = (r + u / G) & 3;
#pragma nounroll
            for (int k = 0; k < 2; ++k) nsa2_unit(p, lds, b, 2 * hp, k ? s : 7 - s); }
    } break;
    case PH_B_ATT: {
        for (int u = vid; u < BATCH * NH * 2; u += G) { const int b = u / 24, r = u % 24, h = r >> 1, s = r & 1;
#pragma nounroll
            for (int k = 0; k < 2; ++k) moba_unit(p, lds, b, h, k ? s : 3 - s); }
    } break;
    case PH_A_LN1: case PH_B_LN1: case PH_A_LN2: case PH_B_LN2: {
        const int layer = ph >= PH_B_GEMM ? 1 : 0; const bool second = (ph == PH_A_LN2 || ph == PH_B_LN2); const bool fin = (ph == PH_B_LN2);
        phase_ln(c, p.out, p.in[second ? I_LN2G : I_LN1G] + layer * DM, p.in[second ? I_LN2B : I_LN1B] + layer * DM, fin ? p.out : nullptr, fin ? nullptr : XB);
    } break;
    case PH_B_KMEAN: phase_kmean(c, (const bf16_t*)(ws + WS_BIG + BIG_KV), (float*)(ws + WS_KMEAN)); break;
    default: break;
    }
    if (ph == PH_A_NSA1 || ph == PH_B_ATT) {
        const bool la = (ph == PH_A_NSA1);
        const bf16_t* Q = (const bf16_t*)(ws + WS_BIG + (la ? BIG_P : BIG_Q1)); bf16_t* O = (bf16_t*)(ws + WS_BIG + (la ? BIG_O0 : BIG_O1));
        for (int u = vid; u < BATCH * 4 * 4; u += G) mem_unit(p, lds, Q, la ? AINP : DM, la ? P_QM : MAINW, O, la ? 0 : 512, u >> 4, (u >> 2) & 3, u & 3);
    }
}

template <int PH>
__device__ __forceinline__ void phase_seq(const Params& p, LAS unsigned char* lds, const Ctx& c, cg::grid_group& grid, const XcdBarrier& bar) {
    if constexpr (PH < PH_COUNT) {
        if (PH >= p.ph_lo && PH < p.ph_hi) {
            Ctx cc; { int t_ = threadIdx.x; asm volatile("" : "+v"(t_)); cc.tid = t_; cc.lane = t_ & 63; cc.wid = t_ >> 6; cc.gtid = blockIdx.x * NTHR + t_; cc.gsz = gridDim.x * NTHR; cc.gw = blockIdx.x * (NTHR / 64) + cc.wid; cc.ngw = gridDim.x * (NTHR / 64); }
            run_phase(p, lds, cc, PH); if (PH + 1 < p.ph_hi) { if (PH == 0) grid.sync(); else xcd_barrier(bar); } }
        phase_seq<PH + 1>(p, lds, c, grid, bar);
    }
}
__global__ void __launch_bounds__(NTHR) yoco_mega(Params p) {
    extern __shared__ __attribute__((aligned(16))) unsigned char lds_raw[];
    LAS unsigned char* lds = (LAS unsigned char*)lds_raw;
    cg::grid_group grid = cg::this_grid();
    Ctx c; c.tid = threadIdx.x; c.lane = c.tid & 63; c.wid = c.tid >> 6; c.gtid = blockIdx.x * NTHR + c.tid; c.gsz = gridDim.x * NTHR; c.gw = blockIdx.x * (NTHR / 64) + c.wid; c.ngw = gridDim.x * (NTHR / 64);
    if (c.tid < 130) ((LAS int*)(lds + att::L_BKT))[c.tid] = c.tid == 0 ? 0 : att::rel_bucket(c.tid - 1);
    if (c.tid < 2) ((LAS unsigned*)(lds + att::L_MISC))[c.tid] = 0u;
    __syncthreads();
    const XcdBarrier bar = xcd_barrier_post((unsigned*)(p.ws + WS_CTL), (volatile LAS unsigned*)(lds + att::L_MISC));
    phase_seq<0>(p, lds, c, grid, bar);
}

extern "C" void kernel_launch(void* const* d_in, const int* in_sizes, int n_in, void* d_out, int out_size, void* d_ws, size_t ws_size, hipStream_t stream) {
    static int grid = 0;
    if (grid == 0) {
        if (n_in != 24 || ws_size < WS_NEED) { fprintf(stderr, "kernel_launch: unexpected n_in %d / ws_size %zu (need %zu)\n", n_in, ws_size, (size_t)WS_NEED); grid = -1; return; }
        int dev = 0, cus = 0, per_cu = 0;
        hipGetDevice(&dev); hipDeviceGetAttribute(&cus, hipDeviceAttributeMultiprocessorCount, dev);
        if (hipFuncSetAttribute((const void*)yoco_mega, hipFuncAttributeMaxDynamicSharedMemorySize, LDS_BYTES) != hipSuccess) { fprintf(stderr, "kernel_launch: hipFuncSetAttribute failed\n"); grid = -1; return; }
        if (hipOccupancyMaxActiveBlocksPerMultiprocessor(&per_cu, (const void*)yoco_mega, NTHR, LDS_BYTES) != hipSuccess || per_cu < 1) { fprintf(stderr, "kernel_launch: occupancy query says %d\n", per_cu); per_cu = 1; }
        (void)hipGetLastError();
        grid = cus * per_cu;
        fprintf(stderr, "kernel_launch: grid %d (cus %d x %d)\n", grid, cus, per_cu);
    }
    if (grid < 0) return;
    if (hipMemsetAsync((char*)d_ws + WS_CTL, 0, CTL_BYTES, stream) != hipSuccess) { fprintf(stderr, "kernel_launch: memset failed\n"); return; }
    Params p{};
    for (int i = 0; i < 24; ++i) p.in[i] = (const float*)d_in[i];
    p.out = (float*)d_out; p.ws = (unsigned char*)d_ws; p.ph_lo = 0; p.ph_hi = PH_COUNT;
    void* args[] = {&p};
    hipError_t e = hipLaunchCooperativeKernel((const void*)yoco_mega, dim3(grid), dim3(NTHR), args, LDS_BYTES, stream);
    if (e != hipSuccess) fprintf(stderr, "kernel_launch: cooperative launch failed: %s (grid %d)\n", hipGetErrorString(e), grid);
}
```

```cpp
#include <hip/hip_runtime.h>
#include <hip/hip_cooperative_groups.h>
#include <cstdio>
#include <cstdint>
namespace cg = cooperative_groups;

#define LAS __attribute__((address_space(3)))
typedef unsigned short bf16_t;
typedef short bf16x8 __attribute__((ext_vector_type(8)));
typedef short s16x4 __attribute__((ext_vector_type(4)));
typedef float f32x4 __attribute__((ext_vector_type(4)));
typedef float f32x2 __attribute__((ext_vector_type(2)));
typedef float f32x16 __attribute__((ext_vector_type(16)));
typedef unsigned u32x4 __attribute__((ext_vector_type(4)));
typedef unsigned u32x2 __attribute__((ext_vector_type(2)));

__device__ __forceinline__ unsigned cvt_pk_bf16(float lo, float hi) { unsigned r; asm volatile("v_cvt_pk_bf16_f32 %0, %1, %2" : "=v"(r) : "v"(lo), "v"(hi)); return r; }
__device__ __forceinline__ float bf2f(unsigned short b) { return __uint_as_float(((unsigned)b) << 16); }
__device__ __forceinline__ float gelu_tanh(float x) {
    const float x2 = x * x;
    const float w = x * (-2.302208198f - 0.1029432397f * x2);
    return x * __builtin_amdgcn_rcpf(1.0f + __builtin_amdgcn_exp2f(w));
}

namespace pg8 {
constexpr int BM = 256, BK = 64, HALF = 128, HTB = HALF * BK * 2, STAGE_BYTES = 8 * HTB, NXCD = 8, WGM = 8;
__host__ __device__ __forceinline__ int lds_byte(int r, int c) { const int st = (r >> 4) * 2 + (c >> 5), rr = r & 15, cc = c & 31, ob = rr * 64 + cc * 2; return st * 1024 + (ob ^ (((ob >> 9) & 1) << 5)); }
__host__ __device__ __forceinline__ void stage_rc(int b, int& R, int& C) { const int st = b / 1024, sb = b % 1024, swz = sb ^ (((sb >> 9) & 1) << 5); R = (st >> 1) * 16 + swz / 64; C = (st & 1) * 32 + (swz % 64) / 2; }
__host__ __device__ __forceinline__ int perm32(int rho) { const int n = rho >> 4, i = rho & 15; return 8 * (i >> 2) + 4 * n + (i & 3); }

struct Unit { int pm, pn; };
struct Gemm { const bf16_t* A; const bf16_t* Bt; int M, N, K; int lda; int kstepA; };

struct StaticOrder {
    int nM, nN, nwg, G, c;
    __host__ __device__ void init(int M, int N, int G_, int c_) { nM = M / BM; nN = N / BM; nwg = nM * nN; G = G_; c = c_; }
    __host__ __device__ bool next(int i, Unit& u) const {
        if (c < 0) return false;
        const long L = (long)i * G + c; if (L >= nwg) return false;
        int wgid = (int)L; { const int q = nwg / NXCD, r = nwg % NXCD, xcd = wgid % NXCD, off = wgid / NXCD; wgid = (xcd < r ? xcd * (q + 1) : r * (q + 1) + (xcd - r) * q) + off; }
        const int nig = WGM * nN, gid = wgid / nig, fm = gid * WGM, gsz = (nM - fm) < WGM ? (nM - fm) : WGM;
        u.pm = fm + ((wgid % nig) % gsz); u.pn = (wgid % nig) / gsz; return true;
    }
};

struct EpiBf16 {
    static constexpr bool PERM = true;
    bf16_t* O; int ldc;
    __device__ __forceinline__ void operator()(const f32x4 (&acc)[2][2][4][2], const Unit& u, int wr, int wc, int fr, int fq) const {
        const int row0 = u.pm * BM + wr * 64 + fr; const int col0 = u.pn * BM + wc * 32 + 8 * fq;
#pragma unroll
        for (int ai = 0; ai < 2; ++ai)
#pragma unroll
            for (int m = 0; m < 4; ++m) { bf16_t* rowp = O + (size_t)(row0 + ai * HALF + m * 16) * ldc + col0;
#pragma unroll
                for (int bj = 0; bj < 2; ++bj) { const f32x4 v0 = acc[ai][bj][m][0], v1 = acc[ai][bj][m][1];
                    u32x4 w; w.x = cvt_pk_bf16(v0[0], v0[1]); w.y = cvt_pk_bf16(v0[2], v0[3]); w.z = cvt_pk_bf16(v1[0], v1[1]); w.w = cvt_pk_bf16(v1[2], v1[3]);
                    *(u32x4*)(rowp + bj * HALF) = w; } }
    }
};
struct EpiF32BiasGelu {
    static constexpr bool PERM = false;
    float* O; int ldc; const float* bias;
    __device__ __forceinline__ void operator()(const f32x4 (&acc)[2][2][4][2], const Unit& u, int wr, int wc, int fr, int fq) const {
        const int row0 = u.pm * BM + wr * 64 + fr; const int col0 = u.pn * BM + wc * 32 + 4 * fq;
#pragma unroll
        for (int bj = 0; bj < 2; ++bj)
#pragma unroll
            for (int n = 0; n < 2; ++n) { const f32x4 bv = *(const f32x4*)(bias + col0 + bj * HALF + n * 16);
#pragma unroll
                for (int ai = 0; ai < 2; ++ai)
#pragma unroll
                    for (int m = 0; m < 4; ++m) { f32x4 v = acc[ai][bj][m][n] + bv; v[0] = gelu_tanh(v[0]); v[1] = gelu_tanh(v[1]); v[2] = gelu_tanh(v[2]); v[3] = gelu_tanh(v[3]);
                        *(f32x4*)(O + (size_t)(row0 + ai * HALF + m * 16) * ldc + col0 + bj * HALF + n * 16) = v; } }
    }
};
template <int CTRL> __device__ __forceinline__ float dppf(float old, float src) {
    return __int_as_float(__builtin_amdgcn_update_dpp(__float_as_int(old), __float_as_int(src), CTRL, 0xf, 0xf, false));
}
struct EpiConvGate {
    static constexpr bool PERM = true;
    bf16_t* H; const float* cw; const float* cb; float* TAILA; float* HEADA; float* HEADB;
    __device__ __forceinline__ void operator()(const f32x4 (&acc)[2][2][4][2], const Unit& u, int wr, int wc, int fr, int fq) const {
        constexpr int DFF_ = 2816;
        const int cf0 = u.pn * 128 + wc * 32 + 8 * fq;
        f32x4 w0[2], w1[2], w2[2], cv[2];
#pragma unroll
        for (int n = 0; n < 2; ++n) { w0[n] = *(const f32x4*)(cw + cf0 + 4 * n); w1[n] = *(const f32x4*)(cw + DFF_ + cf0 + 4 * n); w2[n] = *(const f32x4*)(cw + 2 * DFF_ + cf0 + 4 * n); cv[n] = *(const f32x4*)(cb + cf0 + 4 * n); }
#pragma unroll
        for (int ai = 0; ai < 2; ++ai) {
            const int G = u.pm * 4 + ai * 2 + wr;
#pragma unroll
            for (int m = 0; m < 4; ++m) {
                const int row = u.pm * BM + ai * HALF + wr * 64 + m * 16 + fr;
                f32x4 hv[2];
#pragma unroll
                for (int n = 0; n < 2; ++n) {
                    const f32x4 a = acc[ai][0][m][n], b = acc[ai][1][m][n];
                    const f32x4 pv = acc[ai][0][m > 0 ? m - 1 : 0][n];
#pragma unroll
                    for (int j = 0; j < 4; ++j) {
                        const float am1 = dppf<0x111>(dppf<0x121>(0.f, pv[j]), a[j]);
                        const float am2 = dppf<0x112>(dppf<0x122>(0.f, pv[j]), a[j]);
                        const float pre = w0[n][j] * am2 + w1[n][j] * am1 + w2[n][j] * a[j] + cv[n][j];
                        hv[n][j] = gelu_tanh(pre) * b[j];
                    }
                }
                if (m > 0 || fr >= 2) {
                    u32x4 w; w.x = cvt_pk_bf16(hv[0][0], hv[0][1]); w.y = cvt_pk_bf16(hv[0][2], hv[0][3]); w.z = cvt_pk_bf16(hv[1][0], hv[1][1]); w.w = cvt_pk_bf16(hv[1][2], hv[1][3]);
                    *(u32x4*)(H + (size_t)row * DFF_ + cf0) = w;
                } else {
                    float* ha = HEADA + ((size_t)G * 2 + fr) * DFF_ + cf0; float* hb = HEADB + ((size_t)G * 2 + fr) * DFF_ + cf0;
                    *(f32x4*)ha = acc[ai][0][0][0]; *(f32x4*)(ha + 4) = acc[ai][0][0][1]; *(f32x4*)hb = acc[ai][1][0][0]; *(f32x4*)(hb + 4) = acc[ai][1][0][1];
                }
                if (m == 3 && fr >= 14) { float* ta = TAILA + ((size_t)G * 2 + (fr - 14)) * DFF_ + cf0; *(f32x4*)ta = acc[ai][0][3][0]; *(f32x4*)(ta + 4) = acc[ai][0][3][1]; }
            }
        }
    }
};
template <bool BASE_F32>
struct EpiResF32 {
    static constexpr bool PERM = false;
    const void* basev; float* O; int ldc; float alpha;
    __device__ __forceinline__ void operator()(const f32x4 (&acc)[2][2][4][2], const Unit& u, int wr, int wc, int fr, int fq) const {
        const int row0 = u.pm * BM + wr * 64 + fr; const int col0 = u.pn * BM + wc * 32 + 4 * fq;
#pragma unroll
        for (int ai = 0; ai < 2; ++ai)
#pragma unroll
            for (int m = 0; m < 4; ++m) { const size_t off = (size_t)(row0 + ai * HALF + m * 16) * ldc + col0;
#pragma unroll
                for (int bj = 0; bj < 2; ++bj)
#pragma unroll
                    for (int n = 0; n < 2; ++n) { f32x4 bs;
                        if (BASE_F32) bs = *(const f32x4*)((const float*)basev + off + bj * HALF + n * 16);
                        else { const u32x2 w = *(const u32x2*)((const bf16_t*)basev + off + bj * HALF + n * 16); bs[0] = __uint_as_float(w.x << 16); bs[1] = __uint_as_float(w.x & 0xffff0000u); bs[2] = __uint_as_float(w.y << 16); bs[3] = __uint_as_float(w.y & 0xffff0000u); }
                        *(f32x4*)(O + off + bj * HALF + n * 16) = bs * alpha + acc[ai][bj][m][n]; } }
    }
};

template <class Epi>
__device__ __forceinline__ void gemm_phase(LAS unsigned char* lds, const Gemm g, const StaticOrder& S, const Epi& E) {
    const int tid = threadIdx.x, wid = __builtin_amdgcn_readfirstlane(tid >> 6), lane = tid & 63, wr = wid >> 2, wc = wid & 3, fr = lane & 15, fq = lane >> 4;
    const int K = g.K, nt = K / BK;
    unsigned voffA[2], voffB[2];
#pragma unroll
    for (int i = 0; i < 2; ++i) { int R, C; stage_rc(tid * 16 + i * 8192, R, C); const int Rb = Epi::PERM ? ((R & ~31) + perm32(R & 31)) : R;
        voffA[i] = (unsigned)(R * g.lda + C) * 2u; voffB[i] = (unsigned)(Rb * K + C) * 2u; }
    const size_t kstepA = (size_t)g.kstepA, kstepB = (size_t)(BK * 2);
    const size_t hstepA = (size_t)HALF * g.lda * 2, hstepB = (size_t)HALF * K * 2;
    const size_t tstepA = 2 * hstepA, tstepB = 2 * hstepB;
    const unsigned ldsw = (unsigned)wid * 1024u;
    const int aoff = lds_byte(wr * 64 + fr, fq * 8), boff = lds_byte(wc * 32 + fr, fq * 8);
#define PG8_SA(b, h) (((b) * 2 + (h)) * HTB)
#define PG8_SB(b, h) ((4 + (b) * 2 + (h)) * HTB)
#define PG8_STAGE(bufoff, gbase, voff) do { _Pragma("unroll") for (int _i = 0; _i < 2; ++_i) \
        __builtin_amdgcn_global_load_lds((const unsigned*)((const char*)(gbase) + (voff)[_i]), (LAS unsigned*)(lds + (bufoff) + ldsw + _i * 8192), 16, 0, 0); } while (0)
#define PG8_LDA(dst, b, h) do { _Pragma("unroll") for (int m = 0; m < 4; ++m) _Pragma("unroll") for (int k = 0; k < 2; ++k) dst[m][k] = *(const LAS bf16x8*)(lds + PG8_SA(b, h) + aoff + m * 2048 + k * 1024); } while (0)
#define PG8_LDB(dst, b, h) do { _Pragma("unroll") for (int n = 0; n < 2; ++n) _Pragma("unroll") for (int k = 0; k < 2; ++k) dst[n][k] = *(const LAS bf16x8*)(lds + PG8_SB(b, h) + boff + n * 2048 + k * 1024); } while (0)
#define PG8_MMA(ai, bj, At, Bt) do { __builtin_amdgcn_s_setprio(1); _Pragma("unroll") for (int m = 0; m < 4; ++m) _Pragma("unroll") for (int n = 0; n < 2; ++n) _Pragma("unroll") for (int k = 0; k < 2; ++k) \
        acc[ai][bj][m][n] = __builtin_amdgcn_mfma_f32_16x16x32_bf16(Bt[n][k], At[m][k], acc[ai][bj][m][n], 0, 0, 0); __builtin_amdgcn_s_setprio(0); } while (0)
#define PG8_WAIT_V(n) asm volatile("s_waitcnt vmcnt(" #n ")" ::: "memory")
#define PG8_WAIT_L(n) asm volatile("s_waitcnt lgkmcnt(" #n ")" ::: "memory")
#define PG8_BAR __builtin_amdgcn_s_barrier()
#define PG8_SCHED __builtin_amdgcn_sched_barrier(0)
    Unit cur, nxt; int ui = 0;
    if (!S.next(0, cur)) return;
    f32x4 acc[2][2][4][2];
#pragma unroll
    for (int a = 0; a < 2; ++a)
#pragma unroll
        for (int b = 0; b < 2; ++b)
#pragma unroll
            for (int m = 0; m < 4; ++m)
#pragma unroll
                for (int n = 0; n < 2; ++n) acc[a][b][m][n] = (f32x4){0.f, 0.f, 0.f, 0.f};
    bf16x8 At[4][2], B0[2][2], B1[2][2];
    const char* cA = (const char*)g.A + (size_t)cur.pm * tstepA; const char* cB = (const char*)g.Bt + (size_t)cur.pn * tstepB;
    PG8_STAGE(PG8_SB(0, 0), cB, voffB); PG8_STAGE(PG8_SB(0, 1), cB + hstepB, voffB); PG8_STAGE(PG8_SA(0, 0), cA, voffA); PG8_STAGE(PG8_SA(0, 1), cA + hstepA, voffA);
    if (wr == 1) PG8_BAR;
    PG8_WAIT_V(2); PG8_BAR;
    PG8_STAGE(PG8_SB(1, 0), cB + kstepB, voffB); PG8_STAGE(PG8_SA(1, 0), cA + kstepA, voffA); PG8_STAGE(PG8_SB(1, 1), cB + hstepB + kstepB, voffB);
    PG8_WAIT_V(6); PG8_BAR;
    for (;;) {
        const bool has_next = S.next(ui + 1, nxt);
        const char* nA = has_next ? (const char*)g.A + (size_t)nxt.pm * tstepA : cA; const char* nB = has_next ? (const char*)g.Bt + (size_t)nxt.pn * tstepB : cB;
        for (int t = 0; t < nt; t += 2) {
            const bool last = (t == nt - 2);
            const char* a1 = cA + (size_t)(t + 1) * kstepA;
            const char* a2 = last ? nA : cA + (size_t)(t + 2) * kstepA; const char* b2 = last ? nB : cB + (size_t)(t + 2) * kstepB;
            const char* a3 = a2 + kstepA; const char* b3 = b2 + kstepB;
            PG8_LDB(B0, 0, 0); PG8_LDB(B1, 0, 1); PG8_SCHED; PG8_LDA(At, 0, 0); PG8_STAGE(PG8_SA(1, 1), a1 + hstepA, voffA);
            PG8_WAIT_V(8); PG8_WAIT_L(0); PG8_BAR; PG8_MMA(0, 0, At, B0); PG8_MMA(0, 1, At, B1); PG8_BAR; PG8_SCHED;
            PG8_LDA(At, 0, 1); PG8_STAGE(PG8_SB(0, 0), b2, voffB); PG8_STAGE(PG8_SB(0, 1), b2 + hstepB, voffB); PG8_STAGE(PG8_SA(0, 0), a2, voffA);
            PG8_WAIT_V(8); PG8_WAIT_L(0); PG8_BAR; PG8_MMA(1, 0, At, B0); PG8_MMA(1, 1, At, B1); PG8_BAR; PG8_SCHED;
            PG8_LDB(B0, 1, 0); PG8_LDB(B1, 1, 1); PG8_SCHED; PG8_LDA(At, 1, 0); PG8_STAGE(PG8_SA(0, 1), a2 + hstepA, voffA);
            PG8_WAIT_V(8); PG8_WAIT_L(0); PG8_BAR; PG8_MMA(0, 0, At, B0); PG8_MMA(0, 1, At, B1); PG8_BAR; PG8_SCHED;
            PG8_LDA(At, 1, 1); PG8_STAGE(PG8_SB(1, 0), b3, voffB); PG8_STAGE(PG8_SB(1, 1), b3 + hstepB, voffB); PG8_STAGE(PG8_SA(1, 0), a3, voffA);
            PG8_WAIT_V(8); PG8_WAIT_L(0); PG8_BAR; PG8_MMA(1, 0, At, B0); PG8_MMA(1, 1, At, B1); PG8_BAR; PG8_SCHED;
        }
        if (wr == 0) PG8_BAR;
        E(acc, cur, wr, wc, fr, fq);
        if (!has_next) break;
#pragma unroll
        for (int a = 0; a < 2; ++a)
#pragma unroll
            for (int b = 0; b < 2; ++b)
#pragma unroll
                for (int m = 0; m < 4; ++m)
#pragma unroll
                    for (int n = 0; n < 2; ++n) acc[a][b][m][n] = (f32x4){0.f, 0.f, 0.f, 0.f};
        cur = nxt; cA = nA; cB = nB; ++ui;
        if (wr == 1) PG8_BAR;
    }
    PG8_WAIT_V(0);
    PG8_BAR;
#undef PG8_SA
#undef PG8_SB
#undef PG8_STAGE
#undef PG8_LDA
#undef PG8_LDB
#undef PG8_MMA
#undef PG8_WAIT_V
#undef PG8_WAIT_L
#undef PG8_BAR
#undef PG8_SCHED
}
}

constexpr int BATCH = 32, SEQ = 2048, DM = 1024, NTOK = BATCH * SEQ, NMEM = 256, NH = 12, HD = 64, MAINW = 768;
constexpr int AIN = 1444, AINP = 1536, DFF = 2816, NCMP = 127;
constexpr int HALF_TOK = NTOK / 2;
constexpr float ALPHA = 1.4142135623730951f;
constexpr float LN_EPS = 1e-5f;
constexpr int P_Q = 0, P_KC = 768, P_VC = 832, P_KS = 896, P_VS = 960, P_KW = 1024, P_VW = 1088, P_QM = 1152, P_G = 1408;
constexpr size_t MiB = 1u << 20;
constexpr size_t WS_WAIN = 0 * MiB, WS_WAMKV = 3 * MiB, WS_WAOUT = 4 * MiB, WS_WSKV = 6 * MiB, WS_WBIN = 9 * MiB, WS_WBMKV = 11 * MiB, WS_WBOUT = 12 * MiB;
constexpr size_t WS_WFIN = 14 * MiB  , WS_WFOUT = 36 * MiB  , WS_WC1K = 47 * MiB, WS_WC1V = 48 * MiB, WS_WMKV = 49 * MiB  ;
constexpr size_t WS_CTL = 51 * MiB, CTL_BYTES = 16384;
constexpr size_t WS_MEMB = 52 * MiB, WS_MKV = 68 * MiB  , WS_CMPH = 84 * MiB, WS_KCMP = 92 * MiB, WS_VCMP = 93 * MiB, WS_CBIAS = 94 * MiB, WS_SEL = 94 * MiB + 65536, WS_KMEAN = 95 * MiB;
constexpr size_t WS_XB = 96 * MiB, WS_BIG = 226 * MiB;
constexpr size_t BIG_P = 0, BIG_O0 = 193 * MiB, BIG_H = 0, BIG_TAILA = 352 * MiB, BIG_HEADA = 374 * MiB, BIG_HEADB = 396 * MiB, BIG_KV = 0, BIG_Q1 = 193 * MiB, BIG_O1 = 321 * MiB;
constexpr size_t WS_NEED = WS_BIG + 449 * MiB;

constexpr int LDS_BYTES = 147456;
constexpr int NTHR = 512;

struct Params {
    const float* in[24];
    float* out;
    unsigned char* ws;
    int ph_lo, ph_hi;
};
enum { I_X = 0, I_MEM, I_RELB, I_AWIN, I_PEK, I_W1K, I_W2K, I_PEV, I_W1V, I_W2V, I_AWMKV, I_AWOUT, I_SWKV, I_BWIN, I_BWMKV, I_BWOUT, I_LN1G, I_LN1B, I_LN2G, I_LN2B, I_FWIN, I_FCW, I_FCB, I_FWOUT };

namespace att {
constexpr int ROWB = 144, TILEB = 64 * ROWB, VROWB = 192, VTILEB = 64 * VROWB;
constexpr float NEG = -1e30f;
constexpr float LOG2E = 1.4426950408889634f;
constexpr float SC2 = 0.125f * LOG2E;
typedef short v4i16_t __attribute__((ext_vector_type(4)));

__device__ __forceinline__ f32x16 zero16() { f32x16 z;
#pragma unroll
    for (int i = 0; i < 16; ++i) z[i] = 0.f; return z; }

__device__ __forceinline__ void qk_tile(f32x16& p0, f32x16& p1, const LAS unsigned char* Kt, const bf16x8 (&qr)[4], int r32, int hi, float cinit = 0.f) {
    const LAS unsigned char* kb = Kt + r32 * ROWB + hi * 16;
#pragma unroll
    for (int i = 0; i < 16; ++i) { p0[i] = cinit; p1[i] = cinit; }
#pragma unroll
    for (int d0 = 0; d0 < 4; ++d0) {
        const bf16x8 k0 = *(const LAS bf16x8*)(kb + d0 * 32);
        const bf16x8 k1 = *(const LAS bf16x8*)(kb + 32 * ROWB + d0 * 32);
        p0 = __builtin_amdgcn_mfma_f32_32x32x16_bf16(k0, qr[d0], p0, 0, 0, 0);
        p1 = __builtin_amdgcn_mfma_f32_32x32x16_bf16(k1, qr[d0], p1, 0, 0, 0);
    }
}
__device__ __forceinline__ s16x4 vtr(const LAS unsigned char* p) { return __builtin_bit_cast(s16x4, __builtin_amdgcn_ds_read_tr16_b64_v4i16((LAS v4i16_t*)p)); }
__device__ __forceinline__ void pv_tile(f32x16& o0, f32x16& o1, const LAS unsigned char* Vt, const f32x16& p0, const f32x16& p1, int lane) {
    const int hi = lane >> 5, g1 = (lane >> 4) & 1, i = lane & 15, q_ = i >> 2, p_ = i & 3;
    const LAS unsigned char* vb = Vt + (4 * hi + q_) * VROWB + (16 * g1 + 4 * p_) * 2;
#pragma unroll
    for (int s = 0; s < 4; ++s) {
        u32x4 w;
        if (s < 2) { const int b = 8 * (s & 1); w.x = cvt_pk_bf16(p0[b + 0], p0[b + 1]); w.y = cvt_pk_bf16(p0[b + 2], p0[b + 3]); w.z = cvt_pk_bf16(p0[b + 4], p0[b + 5]); w.w = cvt_pk_bf16(p0[b + 6], p0[b + 7]); }
        else       { const int b = 8 * (s & 1); w.x = cvt_pk_bf16(p1[b + 0], p1[b + 1]); w.y = cvt_pk_bf16(p1[b + 2], p1[b + 3]); w.z = cvt_pk_bf16(p1[b + 4], p1[b + 5]); w.w = cvt_pk_bf16(p1[b + 6], p1[b + 7]); }
        const bf16x8 pf = __builtin_bit_cast(bf16x8, w);
#pragma unroll
        for (int dh = 0; dh < 2; ++dh) {
            const s16x4 lo = vtr(vb + (16 * s) * VROWB + dh * 64);
            const s16x4 h4 = vtr(vb + (16 * s + 8) * VROWB + dh * 64);
            const bf16x8 vf = (bf16x8){lo[0], lo[1], lo[2], lo[3], h4[0], h4[1], h4[2], h4[3]};
            if (dh == 0) o0 = __builtin_amdgcn_mfma_f32_32x32x16_bf16(vf, pf, o0, 0, 0, 0);
            else         o1 = __builtin_amdgcn_mfma_f32_32x32x16_bf16(vf, pf, o1, 0, 0, 0);
        }
    }
}
struct Acc { float m, l; f32x16 o0, o1; };
__device__ __forceinline__ void acc_init(Acc& A) { A.m = NEG; A.l = 0.f; A.o0 = zero16(); A.o1 = zero16(); }
constexpr float THR_RAW = 8.0f / SC2;
__device__ __forceinline__ void sm_update(Acc& A, f32x16& p0, f32x16& p1) {
    float m0 = fmaxf(p0[0], p1[0]), m1 = fmaxf(p0[1], p1[1]);
#pragma unroll
    for (int r = 2; r < 16; r += 2) { m0 = fmaxf(fmaxf(m0, p0[r]), p1[r]); m1 = fmaxf(fmaxf(m1, p0[r + 1]), p1[r + 1]); }
    float mx = fmaxf(m0, m1);
    mx = fmaxf(mx, __shfl_xor(mx, 32));
    if (__any(mx > A.m + THR_RAW)) {
        const float mn = fmaxf(A.m, mx);
        const float alpha = __builtin_amdgcn_exp2f((A.m - (mn < -5e29f ? 0.f : mn)) * SC2);
        A.l *= alpha; A.m = mn;
#pragma unroll
        for (int r = 0; r < 16; ++r) { A.o0[r] *= alpha; A.o1[r] *= alpha; }
    }
    const float msc = (A.m < -5e29f ? 0.f : A.m) * SC2;
    float rs0 = 0.f, rs1 = 0.f;
#pragma unroll
    for (int r = 0; r < 16; ++r) {
        const float e0 = __builtin_amdgcn_exp2f(p0[r] * SC2 - msc);
        const float e1 = __builtin_amdgcn_exp2f(p1[r] * SC2 - msc);
        p0[r] = e0; p1[r] = e1; rs0 += e0; rs1 += e1;
    }
    A.l += rs0 + rs1;
}
__device__ __forceinline__ float rowmax32(const f32x16& p0, const f32x16& p1) {
    float m0 = fmaxf(p0[0], p1[0]), m1 = fmaxf(p0[1], p1[1]), m2 = fmaxf(p0[2], p1[2]), m3 = fmaxf(p0[3], p1[3]);
#pragma unroll
    for (int r = 4; r < 16; r += 4) { m0 = fmaxf(fmaxf(m0, p0[r]), p1[r]); m1 = fmaxf(fmaxf(m1, p0[r + 1]), p1[r + 1]); m2 = fmaxf(fmaxf(m2, p0[r + 2]), p1[r + 2]); m3 = fmaxf(fmaxf(m3, p0[r + 3]), p1[r + 3]); }
    return fmaxf(fmaxf(m0, m1), fmaxf(m2, m3));
}
__device__ __forceinline__ void sm_update2(Acc& A, Acc& B, f32x16& a0, f32x16& a1, f32x16& b0, f32x16& b1) {
    float mxa = rowmax32(a0, a1), mxb = rowmax32(b0, b1);
    mxa = fmaxf(mxa, __shfl_xor(mxa, 32)); mxb = fmaxf(mxb, __shfl_xor(mxb, 32));
    if (__any((mxa > A.m + THR_RAW) || (mxb > B.m + THR_RAW))) {
        const float mna = fmaxf(A.m, mxa), mnb = fmaxf(B.m, mxb);
        const float ala = __builtin_amdgcn_exp2f((A.m - (mna < -5e29f ? 0.f : mna)) * SC2), alb = __builtin_amdgcn_exp2f((B.m - (mnb < -5e29f ? 0.f : mnb)) * SC2);
        A.l *= ala; A.m = mna; B.l *= alb; B.m = mnb;
#pragma unroll
        for (int r = 0; r < 16; ++r) { A.o0[r] *= ala; B.o0[r] *= alb; A.o1[r] *= ala; B.o1[r] *= alb; }
    }
    const float msa = (A.m < -5e29f ? 0.f : A.m) * SC2, msb = (B.m < -5e29f ? 0.f : B.m) * SC2;
    float ra0 = 0.f, ra1 = 0.f, rb0 = 0.f, rb1 = 0.f;
#pragma unroll
    for (int r = 0; r < 16; ++r) {
        const float ea0 = __builtin_amdgcn_exp2f(a0[r] * SC2 - msa), eb0 = __builtin_amdgcn_exp2f(b0[r] * SC2 - msb);
        const float ea1 = __builtin_amdgcn_exp2f(a1[r] * SC2 - msa), eb1 = __builtin_amdgcn_exp2f(b1[r] * SC2 - msb);
        a0[r] = ea0; b0[r] = eb0; a1[r] = ea1; b1[r] = eb1; ra0 += ea0; rb0 += eb0; ra1 += ea1; rb1 += eb1;
    }
    A.l += ra0 + ra1; B.l += rb0 + rb1;
}
__device__ __forceinline__ float acc_inv(const Acc& A) { const float lt = A.l + __shfl_xor(A.l, 32); return 1.0f / fmaxf(lt, 1e-30f); }

__device__ __forceinline__ void apply_general(f32x16& p0, f32x16& p1, int dist0, const LAS float* tab, bool allow, int W) {
    const unsigned We = allow ? (unsigned)W : 0u;
#pragma unroll
    for (int r = 0; r < 16; ++r) {
        const int d_0 = dist0 - ((r & 3) + 8 * (r >> 2)), d_1 = d_0 - 32;
        const int i0 = ((unsigned)d_0 < We) ? min(d_0, 128) + 1 : 0, i1 = ((unsigned)d_1 < We) ? min(d_1, 128) + 1 : 0;
        p0[r] += tab[i0];
        p1[r] += tab[i1];
        if ((r & 3) == 3) __builtin_amdgcn_sched_barrier(0);
    }
}
__device__ __forceinline__ int rel_bucket(int n) {
    if (n < 16) return n;
    const float v = logf((float)n / 16.0f) / 2.0794415416798357f * 16.0f;
    int l = 16 + (int)v; return l < 31 ? l : 31;
}
__device__ __forceinline__ u32x4 tile_ld(const bf16_t* base, long ld, int row0, int rmin, int rmax, int tid) {
    int r = row0 + (tid >> 3); r = r < rmin ? rmin : (r > rmax ? rmax : r);
    return *(const u32x4*)(base + (long)r * ld + (tid & 7) * 8);
}
__device__ __forceinline__ void tile_st(LAS unsigned char* buf, u32x4 v, int tid) { *(LAS u32x4*)(buf + (tid >> 3) * ROWB + (tid & 7) * 16) = v; }
__device__ __forceinline__ void tile_stv(LAS unsigned char* buf, u32x4 v, int tid) { *(LAS u32x4*)(buf + (tid >> 3) * VROWB + (tid & 7) * 16) = v; }
__device__ __forceinline__ void load_q(bf16x8 (&qr)[4], const bf16_t* qrow, int hi) {
#pragma unroll
    for (int d0 = 0; d0 < 4; ++d0) qr[d0] = *(const bf16x8*)(qrow + d0 * 16 + hi * 8);
}
__device__ __forceinline__ void store_o(bf16_t* orow, const f32x16& o0, const f32x16& o1, int hi) {
#pragma unroll
    for (int g = 0; g < 4; ++g) {
        u32x2 w0, w1; w0.x = cvt_pk_bf16(o0[4 * g], o0[4 * g + 1]); w0.y = cvt_pk_bf16(o0[4 * g + 2], o0[4 * g + 3]);
        w1.x = cvt_pk_bf16(o1[4 * g], o1[4 * g + 1]); w1.y = cvt_pk_bf16(o1[4 * g + 2], o1[4 * g + 3]);
        *(u32x2*)(orow + 8 * g + 4 * hi) = w0; *(u32x2*)(orow + 32 + 8 * g + 4 * hi) = w1;
    }
}
__device__ __forceinline__ void add_prev_o(const bf16_t* orow, f32x16& o0, f32x16& o1, int hi) {
#pragma unroll
    for (int g = 0; g < 4; ++g) {
        const u32x2 w0 = *(const u32x2*)(orow + 8 * g + 4 * hi), w1 = *(const u32x2*)(orow + 32 + 8 * g + 4 * hi);
        o0[4 * g] += __uint_as_float(w0.x << 16); o0[4 * g + 1] += __uint_as_float(w0.x & 0xffff0000u); o0[4 * g + 2] += __uint_as_float(w0.y << 16); o0[4 * g + 3] += __uint_as_float(w0.y & 0xffff0000u);
        o1[4 * g] += __uint_as_float(w1.x << 16); o1[4 * g + 1] += __uint_as_float(w1.x & 0xffff0000u); o1[4 * g + 2] += __uint_as_float(w1.y << 16); o1[4 * g + 3] += __uint_as_float(w1.y & 0xffff0000u);
    }
}
__device__ __forceinline__ float sigmoidf(float x) { return 1.0f / (1.0f + __expf(-x)); }

constexpr int L_K0 = 0, L_K1 = TILEB, L_V0 = 2 * TILEB, L_V1 = 2 * TILEB + VTILEB, L_TAB = 2 * TILEB + 2 * VTILEB  , L_SIMP = 53248  , L_Q = 53248  , L_BKT = 131072  , L_MISC = 131072 + 1024  ;

__device__ __forceinline__ const LAS unsigned char* park_q(LAS unsigned char* lds, const bf16_t* q0, const bf16_t* q1, int wid, int lane, int hi) {
    LAS unsigned char* qp = lds + L_Q + wid * 8192 + lane * 16;
#pragma unroll
    for (int d0 = 0; d0 < 4; ++d0) { *(LAS bf16x8*)(qp + d0 * 1024) = *(const bf16x8*)(q0 + d0 * 16 + hi * 8); *(LAS bf16x8*)(qp + 4096 + d0 * 1024) = *(const bf16x8*)(q1 + d0 * 16 + hi * 8); }
    return qp;
}
__device__ __forceinline__ void fill_tab(LAS unsigned char* lds, const float* relb, int h0, int nh, int tid) {
    LAS float* tab = (LAS float*)(lds + L_TAB);
    const LAS int* bkt = (const LAS int*)(lds + L_BKT);
    for (int i = tid; i < nh * 130; i += NTHR) { const int hh = i / 130, d = i % 130; tab[hh * 132 + d] = d == 0 ? NEG : relb[bkt[d] * NH + h0 + hh] * 8.0f; }
}

template <int MODE>
struct TileInfo { bool want, near, allow; float cinit; };
template <int MODE>
__device__ __forceinline__ TileInfo<MODE> classify(int kt, int tw, unsigned selmask, int blkshift, int W, float b129) {
    TileInfo<MODE> ti; const int kbase = kt * 64;
    if (MODE == 0) { ti.want = true; ti.near = false; ti.allow = true; ti.cinit = 0.f; }
    else if (MODE == 1) { ti.allow = (selmask >> (kt >> blkshift)) & 1u; ti.want = (kbase <= tw + 31) && __any(ti.allow); ti.near = !(tw - (kbase + 63) >= 128); ti.cinit = ti.near ? 0.f : (ti.allow ? b129 : NEG); }
    else { ti.allow = true; ti.want = (kbase <= tw + 31) && (kbase + 63 >= tw - (W - 1)); ti.near = !((tw - (kbase + 63) >= 128) && (tw + 31 - kbase < W)); ti.cinit = ti.near ? 0.f : b129; }
    return ti;
}
template <int MODE, bool QREG>
__device__ __forceinline__ void seg2(Acc (&A)[2], LAS unsigned char* lds, const bf16_t* Kg, const bf16_t* Vg, long ld, int rmax, int lo, int hi_t,
                                     const LAS unsigned char* qp  , int t0  , int tw0, unsigned sel0, unsigned sel1, int blkshift, int W, const LAS float* tab, int tid) {
    const int lane = tid & 63, r32 = lane & 31, hi = lane >> 5;
    if (lo >= hi_t) return;
    {
        const u32x4 k0 = tile_ld(Kg, ld, lo * 64, 0, rmax, tid), v0 = tile_ld(Vg, ld, lo * 64, 0, rmax, tid);
        __syncthreads();
        tile_st(lds + L_K0, k0, tid); tile_stv(lds + L_V0, v0, tid);
        __syncthreads();
    }
    const float b129 = (MODE == 0) ? 0.f : tab[129];
    const int g1 = (lane >> 4) & 1, i16 = lane & 15, q_ = i16 >> 2, p_ = i16 & 3;
    bf16x8 qra[4], qrb[4];
    if (QREG) {
#pragma unroll
        for (int d0 = 0; d0 < 4; ++d0) { qra[d0] = *(const LAS bf16x8*)(qp + d0 * 1024); qrb[d0] = *(const LAS bf16x8*)(qp + 4096 + d0 * 1024); }
    }
    int cur = 0;
    for (int kt = lo; kt < hi_t; ++kt) {
        const bool more1 = kt + 1 < hi_t;
        u32x4 kreg, vreg;
        if (more1) { kreg = tile_ld(Kg, ld, (kt + 1) * 64, 0, rmax, tid); vreg = tile_ld(Vg, ld, (kt + 1) * 64, 0, rmax, tid); }
        TileInfo<MODE> ta = classify<MODE>(kt, tw0, sel0, blkshift, W, b129), tb = classify<MODE>(kt, tw0 + 32, sel1, blkshift, W, b129);
        if (ta.want || tb.want) {
            if (!ta.want) { ta.cinit = NEG; ta.near = false; }
            if (!tb.want) { tb.cinit = NEG; tb.near = false; }
            const LAS unsigned char* Kt = lds + (cur ? L_K1 : L_K0); const LAS unsigned char* Vt = lds + (cur ? L_V1 : L_V0);
            f32x16 a0, a1, b0, b1;
#pragma unroll
            for (int i = 0; i < 16; ++i) { a0[i] = ta.cinit; a1[i] = ta.cinit; b0[i] = tb.cinit; b1[i] = tb.cinit; }
            const LAS unsigned char* kb = Kt + r32 * ROWB + hi * 16;
#pragma unroll
            for (int d0 = 0; d0 < 4; ++d0) {
                const bf16x8 k0 = *(const LAS bf16x8*)(kb + d0 * 32);
                const bf16x8 k1 = *(const LAS bf16x8*)(kb + 32 * ROWB + d0 * 32);
                const bf16x8 qa = QREG ? qra[d0] : *(const LAS bf16x8*)(qp + d0 * 1024), qb_ = QREG ? qrb[d0] : *(const LAS bf16x8*)(qp + 4096 + d0 * 1024);
                a0 = __builtin_amdgcn_mfma_f32_32x32x16_bf16(k0, qa, a0, 0, 0, 0);
                b0 = __builtin_amdgcn_mfma_f32_32x32x16_bf16(k0, qb_, b0, 0, 0, 0);
                a1 = __builtin_amdgcn_mfma_f32_32x32x16_bf16(k1, qa, a1, 0, 0, 0);
                b1 = __builtin_amdgcn_mfma_f32_32x32x16_bf16(k1, qb_, b1, 0, 0, 0);
            }
            if (MODE != 0) {
                if (ta.near) apply_general(a0, a1, t0 - kt * 64 - 4 * hi, tab, ta.allow, W);
                if (tb.near) apply_general(b0, b1, t0 + 32 - kt * 64 - 4 * hi, tab, tb.allow, W);
            }
            sm_update2(A[0], A[1], a0, a1, b0, b1);
            const LAS unsigned char* vb = Vt + (4 * hi + q_) * VROWB + (16 * g1 + 4 * p_) * 2;
#pragma unroll
            for (int s = 0; s < 4; ++s) {
                const int bs = 8 * (s & 1);
                u32x4 wa, wb;
                if (s < 2) { wa.x = cvt_pk_bf16(a0[bs + 0], a0[bs + 1]); wa.y = cvt_pk_bf16(a0[bs + 2], a0[bs + 3]); wa.z = cvt_pk_bf16(a0[bs + 4], a0[bs + 5]); wa.w = cvt_pk_bf16(a0[bs + 6], a0[bs + 7]);
                             wb.x = cvt_pk_bf16(b0[bs + 0], b0[bs + 1]); wb.y = cvt_pk_bf16(b0[bs + 2], b0[bs + 3]); wb.z = cvt_pk_bf16(b0[bs + 4], b0[bs + 5]); wb.w = cvt_pk_bf16(b0[bs + 6], b0[bs + 7]); }
                else       { wa.x = cvt_pk_bf16(a1[bs + 0], a1[bs + 1]); wa.y = cvt_pk_bf16(a1[bs + 2], a1[bs + 3]); wa.z = cvt_pk_bf16(a1[bs + 4], a1[bs + 5]); wa.w = cvt_pk_bf16(a1[bs + 6], a1[bs + 7]);
                             wb.x = cvt_pk_bf16(b1[bs + 0], b1[bs + 1]); wb.y = cvt_pk_bf16(b1[bs + 2], b1[bs + 3]); wb.z = cvt_pk_bf16(b1[bs + 4], b1[bs + 5]); wb.w = cvt_pk_bf16(b1[bs + 6], b1[bs + 7]); }
                const bf16x8 pfa = __builtin_bit_cast(bf16x8, wa), pfb = __builtin_bit_cast(bf16x8, wb);
#pragma unroll
                for (int dh = 0; dh < 2; ++dh) {
                    const s16x4 lo4 = vtr(vb + (16 * s) * VROWB + dh * 64);
                    const s16x4 h4 = vtr(vb + (16 * s + 8) * VROWB + dh * 64);
                    const bf16x8 vf = (bf16x8){lo4[0], lo4[1], lo4[2], lo4[3], h4[0], h4[1], h4[2], h4[3]};
                    if (dh == 0) { A[0].o0 = __builtin_amdgcn_mfma_f32_32x32x16_bf16(vf, pfa, A[0].o0, 0, 0, 0); A[1].o0 = __builtin_amdgcn_mfma_f32_32x32x16_bf16(vf, pfb, A[1].o0, 0, 0, 0); }
                    else         { A[0].o1 = __builtin_amdgcn_mfma_f32_32x32x16_bf16(vf, pfa, A[0].o1, 0, 0, 0); A[1].o1 = __builtin_amdgcn_mfma_f32_32x32x16_bf16(vf, pfb, A[1].o1, 0, 0, 0); }
                }
            }
        }
        if (more1) { tile_st(lds + (cur ? L_K0 : L_K1), kreg, tid); tile_stv(lds + (cur ? L_V0 : L_V1), vreg, tid); }
        __syncthreads();
        cur ^= 1;
    }
}
}

struct Ctx { int tid, lane, wid, gtid, gsz, gw, ngw; };

template <int MAP>
__device__ __forceinline__ void xpose_w(const Ctx& c, const float* W, int K, int N, bf16_t* WT, int Ndst, int dst_off = 0) {
    const int nk = K >> 6; const long total = (long)Ndst * nk;
    for (long i = c.gtid; i < total; i += c.gsz) {
        const int n = (int)(i % Ndst), kc = (int)(i / Ndst);
        int src = n;
        if (MAP == 1) { if (n >= 1152 && n < 1408) src = 1188 + (n - 1152); else if (n >= 1408 && n < 1444) src = 1152 + (n - 1408); else if (n >= 1444) src = -1; }
        else if (MAP == 2) { const int tl = n >> 8, wi = n & 255; src = wi < 128 ? tl * 128 + wi : 2816 + tl * 128 + (wi - 128); }
        else if (n >= N) src = -1;
        bf16_t* dst = WT + (size_t)(dst_off + n) * K + kc * 64;
        if (src < 0) {
#pragma unroll
            for (int q = 0; q < 8; ++q) *(u32x4*)(dst + q * 8) = (u32x4){0u, 0u, 0u, 0u};
        } else {
            const float* s = W + (size_t)(kc * 64) * N + src;
            float v[64];
#pragma unroll
            for (int k = 0; k < 64; ++k) v[k] = s[(size_t)k * N];
#pragma unroll
            for (int q = 0; q < 8; ++q) {
                u32x4 w; w.x = cvt_pk_bf16(v[8 * q], v[8 * q + 1]); w.y = cvt_pk_bf16(v[8 * q + 2], v[8 * q + 3]); w.z = cvt_pk_bf16(v[8 * q + 4], v[8 * q + 5]); w.w = cvt_pk_bf16(v[8 * q + 6], v[8 * q + 7]);
                *(u32x4*)(dst + q * 8) = w;
            }
        }
    }
}
__device__ __forceinline__ void cvt_rows(const Ctx& c, const float* X, bf16_t* XB, long nelem) {
    const long n8 = nelem >> 3;
    for (long i0 = c.gtid; i0 < n8; i0 += 4l * c.gsz) {
        f32x4 a[4], b[4];
#pragma unroll
        for (int u = 0; u < 4; ++u) { const long i = i0 + (long)u * c.gsz; if (i < n8) { a[u] = __builtin_nontemporal_load((const f32x4*)(X + i * 8)); b[u] = __builtin_nontemporal_load((const f32x4*)(X + i * 8 + 4)); } }
#pragma unroll
        for (int u = 0; u < 4; ++u) { const long i = i0 + (long)u * c.gsz; if (i < n8) {
            u32x4 w; w.x = cvt_pk_bf16(a[u][0], a[u][1]); w.y = cvt_pk_bf16(a[u][2], a[u][3]); w.z = cvt_pk_bf16(b[u][0], b[u][1]); w.w = cvt_pk_bf16(b[u][2], b[u][3]);
            *(u32x4*)(XB + i * 8) = w; } }
    }
}
__device__ __forceinline__ void prep_late(const Params& p, const Ctx& c) {
    unsigned char* ws = p.ws;
    xpose_w<0>(c, p.in[I_AWOUT], DM, DM, (bf16_t*)(ws + WS_WAOUT), DM);
    xpose_w<0>(c, p.in[I_SWKV], DM, 1536, (bf16_t*)(ws + WS_WSKV), 1536);
    xpose_w<0>(c, p.in[I_BWIN], DM, DM, (bf16_t*)(ws + WS_WBIN), DM);
    xpose_w<0>(c, p.in[I_BWOUT], DM, DM, (bf16_t*)(ws + WS_WBOUT), DM);
    for (int l = 0; l < 2; ++l) {
        xpose_w<2>(c, p.in[I_FWIN] + (size_t)l * DM * 2 * DFF, DM, 2 * DFF, (bf16_t*)(ws + WS_WFIN) + (size_t)l * 2 * DFF * DM, 2 * DFF);
        xpose_w<0>(c, p.in[I_FWOUT] + (size_t)l * DFF * DM, DFF, DM, (bf16_t*)(ws + WS_WFOUT) + (size_t)l * DM * DFF, DM);
    }
}
constexpr int LATE_FIRST_WG = 160;
__device__ __forceinline__ void phase_prep(const Params& p, const Ctx& c) {
    unsigned char* ws = p.ws;
    xpose_w<1>(c, p.in[I_AWIN], DM, AIN, (bf16_t*)(ws + WS_WAIN), AINP);
    xpose_w<0>(c, p.in[I_AWMKV], DM, 512, (bf16_t*)(ws + WS_WMKV), 512, 0);
    xpose_w<0>(c, p.in[I_BWMKV], DM, 512, (bf16_t*)(ws + WS_WMKV), 512, 512);
    xpose_w<0>(c, p.in[I_W1K], 2048, 256, (bf16_t*)(ws + WS_WC1K), 256);
    xpose_w<0>(c, p.in[I_W1V], 2048, 256, (bf16_t*)(ws + WS_WC1V), 256);
    if ((int)gridDim.x < LATE_FIRST_WG + 32) prep_late(p, c);
    cvt_rows(c, p.in[I_X], (bf16_t*)(ws + WS_XB), (long)NTOK * DM);
    cvt_rows(c, p.in[I_MEM], (bf16_t*)(ws + WS_MEMB), (long)BATCH * NMEM * DM);
    for (int o = c.gw; o < 512; o += c.ngw) {
        const int which = o >> 8, j = o & 255;
        const float* pe = p.in[which ? I_PEV : I_PEK]; const float* w1 = p.in[which ? I_W1V : I_W1K];
        float s = 0.f;
#pragma unroll 8
        for (int k = c.lane; k < 2048; k += 64) s += pe[k] * w1[(size_t)k * 256 + j];
#pragma unroll
        for (int sh = 1; sh < 64; sh <<= 1) s += __shfl_xor(s, sh);
        if (c.lane == 0) ((float*)(ws + WS_CBIAS))[which * 256 + j] = s;
    }
}
__device__ __forceinline__ void phase_cmp2(const Params& p, const Ctx& c) {
    unsigned char* ws = p.ws;
    for (int i = c.gtid; i < 2 * 4096 * 64; i += c.gsz) {
        const int which = i >> 18, m = (i >> 6) & 4095, d = i & 63;
        const float* hid = (const float*)(ws + WS_CMPH) + ((size_t)which * 4096 + m) * 256; const float* w2 = p.in[which ? I_W2V : I_W2K];
        float s = 0.f;
#pragma unroll 8
        for (int j = 0; j < 256; ++j) s += hid[j] * w2[j * 64 + d];
        if ((m & 127) == 127) s = 0.f;
        unsigned u = __float_as_uint(s); u = (u + 0x7fffu + ((u >> 16) & 1u)) >> 16;
        ((bf16_t*)(ws + (which ? WS_VCMP : WS_KCMP)))[(size_t)m * 64 + d] = (bf16_t)u;
    }
}
__device__ __forceinline__ void phase_ln(const Ctx& c, const float* y, const float* g, const float* bta, float* xf, bf16_t* xb) {
    for (int row0 = c.gw; row0 < NTOK; row0 += 2 * c.ngw) {
        const int row1 = row0 + c.ngw; const bool has1 = row1 < NTOK;
        const float* y0 = y + (size_t)row0 * DM + c.lane * 4; const float* y1 = y + (size_t)(has1 ? row1 : row0) * DM + c.lane * 4;
        f32x4 v0[4], v1[4]; float s0 = 0.f, s1 = 0.f;
#pragma unroll
        for (int j = 0; j < 4; ++j) { v0[j] = *(const f32x4*)(y0 + 256 * j); v1[j] = *(const f32x4*)(y1 + 256 * j); }
#pragma unroll
        for (int j = 0; j < 4; ++j) { s0 += (v0[j][0] + v0[j][1]) + (v0[j][2] + v0[j][3]); s1 += (v1[j][0] + v1[j][1]) + (v1[j][2] + v1[j][3]); }
#pragma unroll
        for (int o = 1; o < 64; o <<= 1) { s0 += __shfl_xor(s0, o); s1 += __shfl_xor(s1, o); }
        const float m0 = s0 * (1.0f / DM), m1 = s1 * (1.0f / DM); float q0 = 0.f, q1 = 0.f;
#pragma unroll
        for (int j = 0; j < 4; ++j) { v0[j] = v0[j] - m0; v1[j] = v1[j] - m1;
            q0 += (v0[j][0] * v0[j][0] + v0[j][1] * v0[j][1]) + (v0[j][2] * v0[j][2] + v0[j][3] * v0[j][3]);
            q1 += (v1[j][0] * v1[j][0] + v1[j][1] * v1[j][1]) + (v1[j][2] * v1[j][2] + v1[j][3] * v1[j][3]); }
#pragma unroll
        for (int o = 1; o < 64; o <<= 1) { q0 += __shfl_xor(q0, o); q1 += __shfl_xor(q1, o); }
        const float r0 = 1.0f / sqrtf(q0 * (1.0f / DM) + LN_EPS), r1 = 1.0f / sqrtf(q1 * (1.0f / DM) + LN_EPS);
#pragma unroll
        for (int j = 0; j < 4; ++j) {
            const f32x4 gg = *(const f32x4*)(g + c.lane * 4 + 256 * j), bb = *(const f32x4*)(bta + c.lane * 4 + 256 * j);
            const f32x4 o0 = v0[j] * r0 * gg + bb, o1 = v1[j] * r1 * gg + bb;
            if (xf) { *(f32x4*)(xf + (size_t)row0 * DM + c.lane * 4 + 256 * j) = o0; if (has1) *(f32x4*)(xf + (size_t)row1 * DM + c.lane * 4 + 256 * j) = o1; }
            if (xb) { u32x2 w; w.x = cvt_pk_bf16(o0[0], o0[1]); w.y = cvt_pk_bf16(o0[2], o0[3]); *(u32x2*)(xb + (size_t)row0 * DM + c.lane * 4 + 256 * j) = w;
                if (has1) { u32x2 w1; w1.x = cvt_pk_bf16(o1[0], o1[1]); w1.y = cvt_pk_bf16(o1[2], o1[3]); *(u32x2*)(xb + (size_t)row1 * DM + c.lane * 4 + 256 * j) = w1; } }
        }
    }
}
__device__ __forceinline__ void unpack8(const u32x4 w, float (&f)[8]) {
    f[0] = __uint_as_float(w.x << 16); f[1] = __uint_as_float(w.x & 0xffff0000u); f[2] = __uint_as_float(w.y << 16); f[3] = __uint_as_float(w.y & 0xffff0000u);
    f[4] = __uint_as_float(w.z << 16); f[5] = __uint_as_float(w.z & 0xffff0000u); f[6] = __uint_as_float(w.w << 16); f[7] = __uint_as_float(w.w & 0xffff0000u);
}
__device__ __forceinline__ void ffn_fixup(const Ctx& c, unsigned char* big, const float* cw, const float* cbias, int pm) {
    const float* TAILA = (const float*)(big + BIG_TAILA); const float* HEADA = (const float*)(big + BIG_HEADA); const float* HEADB = (const float*)(big + BIG_HEADB); bf16_t* H = (bf16_t*)(big + BIG_H);
    constexpr int NCH = DFF / 8;
    for (int it = c.tid; it < 4 * 2 * NCH; it += NTHR) {
        const int ch = it % NCH, gi = it / NCH, i = gi & 1, G = pm * 4 + (gi >> 1), col = ch * 8;
        const bool first = ((G * 64) & (SEQ - 1)) == 0;
        float p0[8], p1[8], a0[8], a1[8], b[8], h[8];
#pragma unroll
        for (int j = 0; j < 8; ++j) { p0[j] = 0.f; p1[j] = 0.f; }
        if (!first) {
            const float* t0 = TAILA + ((size_t)(G - 1) * 2) * DFF + col;
#pragma unroll
            for (int j = 0; j < 8; ++j) { p0[j] = t0[j]; p1[j] = t0[DFF + j]; }
        }
        const float* ha = HEADA + ((size_t)G * 2) * DFF + col; const float* hb = HEADB + ((size_t)G * 2 + i) * DFF + col;
#pragma unroll
        for (int j = 0; j < 8; ++j) { a0[j] = ha[j]; a1[j] = ha[DFF + j]; b[j] = hb[j]; }
#pragma unroll
        for (int j = 0; j < 8; ++j) {
            const float am2 = i ? p1[j] : p0[j], am1 = i ? a0[j] : p1[j], a = i ? a1[j] : a0[j];
            const float pre = cw[col + j] * am2 + cw[DFF + col + j] * am1 + cw[2 * DFF + col + j] * a + cbias[col + j];
            h[j] = gelu_tanh(pre) * b[j];
        }
        u32x4 w; w.x = cvt_pk_bf16(h[0], h[1]); w.y = cvt_pk_bf16(h[2], h[3]); w.z = cvt_pk_bf16(h[4], h[5]); w.w = cvt_pk_bf16(h[6], h[7]);
        *(u32x4*)(H + (size_t)(G * 64 + i) * DFF + col) = w;
    }
}
__device__ __forceinline__ void phase_kmean(const Ctx& c, const bf16_t* KV, float* KM) {
    for (int it = c.gw; it < BATCH * 8 * 12; it += c.ngw) {
        const int cg_ = it % 12, bn = it / 12, ch = c.lane & 7, rs = c.lane >> 3;
        float s[8];
#pragma unroll
        for (int j = 0; j < 8; ++j) s[j] = 0.f;
        const bf16_t* src = KV + (size_t)bn * 256 * 1536 + cg_ * 64 + ch * 8;
#pragma unroll 4
        for (int r = rs; r < 256; r += 8) { float v[8]; unpack8(*(const u32x4*)(src + (size_t)r * 1536), v);
#pragma unroll
            for (int j = 0; j < 8; ++j) s[j] += v[j]; }
#pragma unroll
        for (int j = 0; j < 8; ++j) { s[j] += __shfl_xor(s[j], 8); s[j] += __shfl_xor(s[j], 16); s[j] += __shfl_xor(s[j], 32); }
        if (rs == 0) {
#pragma unroll
            for (int j = 0; j < 8; ++j) KM[(size_t)bn * 768 + cg_ * 64 + ch * 8 + j] = s[j] * (1.0f / 256.0f);
        }
    }
}

__device__ __forceinline__ void nsa1_unit(const Params& p, LAS unsigned char* lds, int b, int qb) {
    using namespace att;
    int tid_ = threadIdx.x; asm volatile("" : "+v"(tid_));
    const int tid = tid_, lane = tid & 63, r32 = lane & 31, hi = lane >> 5, wid = tid >> 6;
    unsigned char* ws = p.ws;
    const bf16_t* P = (const bf16_t*)(ws + WS_BIG + BIG_P); bf16_t* O = (bf16_t*)(ws + WS_BIG + BIG_O0);
    const bf16_t* KC = (const bf16_t*)(ws + WS_KCMP) + (size_t)b * 128 * 64; const bf16_t* VC = (const bf16_t*)(ws + WS_VCMP) + (size_t)b * 128 * 64;
    __syncthreads();
    tile_st(lds + L_K0, tile_ld(KC, 64, 0, 0, 127, tid), tid); tile_st(lds + L_K1, tile_ld(KC, 64, 64, 0, 127, tid), tid);
    tile_stv(lds + L_V0, tile_ld(VC, 64, 0, 0, 127, tid), tid); tile_stv(lds + L_V1, tile_ld(VC, 64, 64, 0, 127, tid), tid);
    fill_tab(lds, p.in[I_RELB], 0, NH, tid);
    __syncthreads();
    const int t = qb * 256 + wid * 32 + r32; const size_t row = (size_t)b * SEQ + t;
    LAS float* simp = (LAS float*)(lds + L_SIMP) + (wid * 32 + r32) * 33;
#pragma unroll
    for (int i = 0; i < 16; ++i) simp[2 * i + hi] = 0.f;
#pragma nounroll
    for (int h = 0; h < NH; ++h) {
        bf16x8 qr[4]; load_q(qr, P + row * AINP + P_Q + h * 64, hi);
        f32x16 pp[4];
        qk_tile(pp[0], pp[1], lds + L_K0, qr, r32, hi); qk_tile(pp[2], pp[3], lds + L_K1, qr, r32, hi);
        const LAS float* tab = (const LAS float*)(lds + L_TAB) + h * 132;
        float mx = NEG;
        const int tws = __builtin_amdgcn_readfirstlane(t - r32);
#pragma unroll
        for (int a = 0; a < 4; ++a) {
            if (tws >= 512 * a + 655) { const float bb = tab[129];
#pragma unroll
                for (int r = 0; r < 16; ++r) { const float s = pp[a][r] + bb; pp[a][r] = s; mx = fmaxf(mx, s); } }
            else if (tws < 512 * a) {
#pragma unroll
                for (int r = 0; r < 16; ++r) pp[a][r] = NEG; }
            else {
#pragma unroll
                for (int r = 0; r < 16; ++r) { const int n = (r & 3) + 8 * (r >> 2) + 4 * hi + 32 * a; const int d = t - 30 - 16 * n;
                    const float s = pp[a][r] + tab[min(max(d, 0), 129)]; pp[a][r] = s; mx = fmaxf(mx, s); } }
        }
        mx = fmaxf(mx, __shfl_xor(mx, 32));
        const bool dead = mx < -5e29f;
        const float msc = (dead ? 0.f : mx) * SC2;
        float sum = 0.f;
#pragma unroll
        for (int a = 0; a < 4; ++a)
#pragma unroll
            for (int r = 0; r < 16; ++r) { const float e = __builtin_amdgcn_exp2f(pp[a][r] * SC2 - msc); pp[a][r] = e; sum += e; }
        sum += __shfl_xor(sum, 32);
        const float inv = dead ? 0.f : 1.0f / fmaxf(sum, 1e-30f);
#pragma unroll
        for (int a = 0; a < 4; ++a)
#pragma unroll
            for (int r = 0; r < 16; ++r) pp[a][r] *= inv;
#pragma unroll
        for (int a = 0; a < 4; ++a)
#pragma unroll
            for (int g = 0; g < 4; ++g) {
                const float gs = (pp[a][4 * g] + pp[a][4 * g + 1]) + (pp[a][4 * g + 2] + pp[a][4 * g + 3]);
                const float lastv = pp[a][4 * g + 3];
                const float shifted = (g >= 1) ? pp[a][4 * (g - 1) + 3] : ((a >= 1) ? pp[(a >= 1) ? a - 1 : 0][15] : 0.f);
                const float snd = hi ? shifted : lastv;
                const float rcv = __shfl_xor(snd, 32);
                simp[8 * a + 2 * g + hi] += gs + rcv;
            }
        f32x16 o0 = zero16(), o1 = zero16();
        pv_tile(o0, o1, lds + L_V0, pp[0], pp[1], lane); pv_tile(o0, o1, lds + L_V1, pp[2], pp[3], lane);
        const float gate = sigmoidf(bf2f(P[row * AINP + P_G + h * 3 + 0]));
#pragma unroll
        for (int r = 0; r < 16; ++r) { o0[r] *= gate; o1[r] *= gate; }
        store_o(O + row * DM + h * 64, o0, o1, hi);
    }
    __syncthreads();
    const int cur = t >> 6; unsigned mask;
    if (cur < 16) mask = (2u << cur) - 1u;
    else {
        mask = 1u | (1u << cur) | (1u << (cur - 1));
        unsigned cand = ((1u << (cur - 1)) - 1u) & ~1u;
#pragma nounroll
        for (int k = 0; k < 13; ++k) {
            float best = -3e38f; int bi = 0;
#pragma nounroll
            for (int s = 1; s <= 29; ++s) { const float v = simp[s]; const bool take = ((cand >> s) & 1u) && (v > best); best = take ? v : best; bi = take ? s : bi; }
            mask |= 1u << bi; cand &= ~(1u << bi);
        }
    }
    if (hi == 0) ((unsigned*)(ws + WS_SEL))[row] = mask;
}
__device__ __forceinline__ void nsa2_unit(const Params& p, LAS unsigned char* lds, int b, int h0, int qb) {
    using namespace att;
    int tid_ = threadIdx.x; asm volatile("" : "+v"(tid_));
    const int tid = tid_, lane = tid & 63, r32 = lane & 31, hi = lane >> 5, wid = tid >> 6;
    unsigned char* ws = p.ws;
    const bf16_t* P = (const bf16_t*)(ws + WS_BIG + BIG_P); bf16_t* O = (bf16_t*)(ws + WS_BIG + BIG_O0);
    __syncthreads();
    fill_tab(lds, p.in[I_RELB], h0, 2, tid);
    const int h = h0 + (wid >> 2);
    const LAS float* tab = (const LAS float*)(lds + L_TAB) + (wid >> 2) * 132;
    const int tw0 = qb * 256 + (wid & 3) * 64, t0 = tw0 + r32; const size_t row0 = (size_t)b * SEQ + t0, row1 = row0 + 32;
    const LAS unsigned char* qp = park_q(lds, P + row0 * AINP + P_Q + h * 64, P + row1 * AINP + P_Q + h * 64, wid, lane, hi);
    const unsigned sel0 = ((const unsigned*)(ws + WS_SEL))[row0], sel1 = ((const unsigned*)(ws + WS_SEL))[row1];
    const bf16_t* Pb = P + (size_t)b * SEQ * AINP;
    Acc A[2]; acc_init(A[0]); acc_init(A[1]);
    seg2<1, false>(A, lds, Pb + P_KS, Pb + P_VS, AINP, SEQ - 1, 0, qb * 4 + 4, qp, t0, tw0, sel0, sel1, 0, 1 << 30, tab, tid);
#pragma unroll
    for (int s = 0; s < 2; ++s) {
        const size_t row = s ? row1 : row0;
        const float gs = sigmoidf(bf2f(P[row * AINP + P_G + h * 3 + 1])) * acc_inv(A[s]);
#pragma unroll
        for (int r = 0; r < 16; ++r) { A[s].o0[r] *= gs; A[s].o1[r] *= gs; }
        bf16_t* orow = O + row * DM + h * 64;
        add_prev_o(orow, A[s].o0, A[s].o1, hi); store_o(orow, A[s].o0, A[s].o1, hi);
        acc_init(A[s]);
    }
    const int wlo = qb * 4 - 8 < 0 ? 0 : qb * 4 - 8;
    seg2<2, false>(A, lds, Pb + P_KW, Pb + P_VW, AINP, SEQ - 1, wlo, qb * 4 + 4, qp, t0, tw0, 0u, 0u, 0, 512, tab, tid);
#pragma unroll
    for (int s = 0; s < 2; ++s) {
        const size_t row = s ? row1 : row0;
        const float gw = sigmoidf(bf2f(P[row * AINP + P_G + h * 3 + 2])) * acc_inv(A[s]);
#pragma unroll
        for (int r = 0; r < 16; ++r) { A[s].o0[r] *= gw; A[s].o1[r] *= gw; }
        bf16_t* orow = O + row * DM + h * 64;
        add_prev_o(orow, A[s].o0, A[s].o1, hi); store_o(orow, A[s].o0, A[s].o1, hi);
    }
}
__device__ __forceinline__ unsigned moba_select(const float* KM, const bf16x8 (&qr)[4], int b, int h, int qb, int hi) {
    float gt[7];
#pragma unroll
    for (int n = 0; n < 7; ++n) {
        float s = 0.f;
        if (n < qb) {
            const float* km = KM + ((size_t)(b * 8 + n) * NH + h) * 64 + hi * 8;
#pragma unroll
            for (int d0 = 0; d0 < 4; ++d0) { const f32x4 k0 = *(const f32x4*)(km + d0 * 16), k1 = *(const f32x4*)(km + d0 * 16 + 4);
                s += bf2f((unsigned short)qr[d0][0]) * k0[0] + bf2f((unsigned short)qr[d0][1]) * k0[1] + bf2f((unsigned short)qr[d0][2]) * k0[2] + bf2f((unsigned short)qr[d0][3]) * k0[3]
                   + bf2f((unsigned short)qr[d0][4]) * k1[0] + bf2f((unsigned short)qr[d0][5]) * k1[1] + bf2f((unsigned short)qr[d0][6]) * k1[2] + bf2f((unsigned short)qr[d0][7]) * k1[3]; }
        }
        s += __shfl_xor(s, 32);
        gt[n] = s;
    }
    unsigned sel = 1u << qb, cand = (1u << qb) - 1u;
#pragma nounroll
    for (int k = 0; k < 3; ++k) {
        float best = -3e38f; int bi = -1;
#pragma unroll
        for (int n = 0; n < 7; ++n) { const bool take = ((cand >> n) & 1u) && (gt[n] > best); best = take ? gt[n] : best; bi = take ? n : bi; }
        if (bi >= 0) { sel |= 1u << bi; cand &= ~(1u << bi); }
    }
    return sel;
}
__device__ __forceinline__ void moba_unit(const Params& p, LAS unsigned char* lds, int b, int h, int qp) {
    using namespace att;
    int tid_ = threadIdx.x; asm volatile("" : "+v"(tid_));
    const int tid = tid_, lane = tid & 63, r32 = lane & 31, hi = lane >> 5, wid = tid >> 6;
    unsigned char* ws = p.ws;
    const bf16_t* KV = (const bf16_t*)(ws + WS_BIG + BIG_KV); const bf16_t* Q = (const bf16_t*)(ws + WS_BIG + BIG_Q1); bf16_t* O = (bf16_t*)(ws + WS_BIG + BIG_O1);
    const float* KM = (const float*)(ws + WS_KMEAN);
    __syncthreads();
    fill_tab(lds, p.in[I_RELB], h, 1, tid);
    const LAS float* tab = (const LAS float*)(lds + L_TAB);
    const int qb = 2 * qp + (wid >> 2);
    const int tw0 = qb * 256 + (wid & 3) * 64, t0 = tw0 + r32; const size_t row0 = (size_t)b * SEQ + t0, row1 = row0 + 32;
    unsigned sel0, sel1;
    { bf16x8 qr[4]; load_q(qr, Q + row0 * DM + h * 64, hi); sel0 = moba_select(KM, qr, b, h, qb, hi); }
    { bf16x8 qr[4]; load_q(qr, Q + row1 * DM + h * 64, hi); sel1 = moba_select(KM, qr, b, h, qb, hi); }
    const LAS unsigned char* qp_ = park_q(lds, Q + row0 * DM + h * 64, Q + row1 * DM + h * 64, wid, lane, hi);
    const bf16_t* Kb = KV + (size_t)b * SEQ * 1536 + h * 64;
    Acc A[2]; acc_init(A[0]); acc_init(A[1]);
    seg2<1, true>(A, lds, Kb, Kb + MAINW, 1536, SEQ - 1, 0, qp * 8 + 8, qp_, t0, tw0, sel0, sel1, 2, 1 << 30, tab, tid);
#pragma unroll
    for (int s = 0; s < 2; ++s) {
        const float inv = acc_inv(A[s]);
#pragma unroll
        for (int r = 0; r < 16; ++r) { A[s].o0[r] *= inv; A[s].o1[r] *= inv; }
        store_o(O + (s ? row1 : row0) * DM + h * 64, A[s].o0, A[s].o1, hi);
    }
}
__device__ __forceinline__ void mem_unit(const Params& p, LAS unsigned char* lds, const bf16_t* Q, int ldq, int qcol, bf16_t* O, int kvcol, int b, int mh, int qq) {
    using namespace att;
    int tid_ = threadIdx.x; asm volatile("" : "+v"(tid_));
    const int tid = tid_, lane = tid & 63, r32 = lane & 31, hi = lane >> 5, wid = tid >> 6;
    const bf16_t* MKV = (const bf16_t*)(p.ws + WS_MKV) + (size_t)b * NMEM * 1024 + kvcol + mh * 64;
    const int tw0 = qq * 512 + wid * 64, t0 = tw0 + r32; const size_t row0 = (size_t)b * SEQ + t0, row1 = row0 + 32;
    __syncthreads();
    const LAS unsigned char* qp = park_q(lds, Q + row0 * ldq + qcol + mh * 64, Q + row1 * ldq + qcol + mh * 64, wid, lane, hi);
    Acc A[2]; acc_init(A[0]); acc_init(A[1]);
    seg2<0, true>(A, lds, MKV, MKV + 256, 1024, NMEM - 1, 0, 4, qp, t0, tw0, 0u, 0u, 0, 1 << 30, (const LAS float*)(lds + L_TAB), tid);
#pragma unroll
    for (int s = 0; s < 2; ++s) {
        const float inv = acc_inv(A[s]);
#pragma unroll
        for (int r = 0; r < 16; ++r) { A[s].o0[r] *= inv; A[s].o1[r] *= inv; }
        store_o(O + (s ? row1 : row0) * DM + MAINW + mh * 64, A[s].o0, A[s].o1, hi);
    }
}

#define XB_TMO      128
#define XB_XCNT(j)  (256  + 64 * (j))
#define XB_XSUB(j)  (1280 + 64 * (j))
#define XB_XGEN(j)  (2304 + 64 * (j))
#define XB_TOP      3328
#define XB_TOPGEN   3392
#define XCD_BAR_WORDS 3456
#define XB_SPIN_CAP (1u << 18)
__device__ __forceinline__ unsigned xb_ld(unsigned* p)              { return __hip_atomic_load(p, __ATOMIC_RELAXED, __HIP_MEMORY_SCOPE_AGENT); }
__device__ __forceinline__ unsigned xb_add(unsigned* p, unsigned v) { return __hip_atomic_fetch_add(p, v, __ATOMIC_RELAXED, __HIP_MEMORY_SCOPE_AGENT); }
__device__ __forceinline__ unsigned xb_xcc_id() { return (unsigned)__builtin_amdgcn_s_getreg((3 << 11) | 20) & 0xFu; }
#define XB_SPIN(cond, bar) do { unsigned _sp = 0; while (cond) { __builtin_amdgcn_s_sleep(1); \
    if ((++_sp & 255u) == 0u) { if (xb_ld(&(bar)[XB_TMO])) break; if (_sp > XB_SPIN_CAP) { atomicAdd(&(bar)[XB_TMO], 1u); break; } } } } while (0)
struct XcdBarrier { unsigned* bar; unsigned x; volatile LAS unsigned* st; };
__device__ __forceinline__ XcdBarrier xcd_barrier_post(unsigned* bar, volatile LAS unsigned* st) {
    XcdBarrier b; b.bar = bar; b.x = xb_xcc_id(); b.st = st;
    if (threadIdx.x == 0) (void)xb_add(&bar[XB_XCNT(b.x)], 1u);
    return b;
}
__device__ __forceinline__ void xcd_barrier_complete(unsigned* bar, unsigned x, unsigned& nloc, unsigned& nx) {
    const unsigned G = gridDim.x * gridDim.y * gridDim.z;
    unsigned sum, cnt, mine, sp = 0u;
    for (;;) {
        sum = 0u; cnt = 0u; mine = 0u;
#pragma unroll
        for (unsigned j = 0; j < 16; ++j) { const unsigned c = xb_ld(&bar[XB_XCNT(j)]); sum += c; cnt += (c > 0u) ? 1u : 0u; mine = (j == x) ? c : mine; }
        if (sum == G) break;
        __builtin_amdgcn_s_sleep(1);
        if ((++sp & 255u) == 0u) { if (xb_ld(&bar[XB_TMO])) break; if (sp > XB_SPIN_CAP) { atomicAdd(&bar[XB_TMO], 1u); break; } }
    }
    nloc = mine > 0u ? mine : 1u; nx = cnt > 0u ? cnt : 1u;
}
__device__ __forceinline__ void xcd_barrier(const XcdBarrier& b) {
    asm volatile("s_waitcnt vmcnt(0)" ::: "memory");
    __syncthreads();
    if (threadIdx.x == 0) {
        unsigned* bar = b.bar;
        __builtin_amdgcn_s_waitcnt(0);
        unsigned nloc = b.st[0], nx = b.st[1];
        if (nloc == 0u) { xcd_barrier_complete(bar, b.x, nloc, nx); b.st[0] = nloc; b.st[1] = nx; }
        const unsigned old = xb_add(&bar[XB_XSUB(b.x)], 1u);
        const unsigned gen = old / nloc;
        if (old + 1u == (gen + 1u) * nloc) {
            __builtin_amdgcn_fence(__ATOMIC_RELEASE, "agent");
            asm volatile("s_waitcnt vmcnt(0)" ::: "memory");
            const unsigned og = xb_add(&bar[XB_TOP], 1u);
            const unsigned tg = og / nx;
            if (og + 1u == (tg + 1u) * nx) xb_add(&bar[XB_TOPGEN], 1u);
            else XB_SPIN(xb_ld(&bar[XB_TOPGEN]) == tg, bar);
            __builtin_amdgcn_fence(__ATOMIC_ACQUIRE, "agent");
            xb_add(&bar[XB_XGEN(b.x)], 1u);
            asm volatile("s_waitcnt vmcnt(0)" ::: "memory");
        } else {
            XB_SPIN(xb_ld(&bar[XB_XGEN(b.x)]) == gen, bar);
            __builtin_amdgcn_fence(__ATOMIC_ACQUIRE, "agent");
            asm volatile("s_waitcnt vmcnt(0)" ::: "memory");
        }
    }
    __syncthreads();
}

enum { PH_PREP = 0, PH_A_GEMM, PH_A_CMP1, PH_A_CMP2, PH_A_NSA1, PH_A_NSA2, PH_A_OUT, PH_A_LN1, PH_A_F0, PH_A_FIX, PH_A_F1, PH_A_LN2,
       PH_B_GEMM, PH_B_KMEAN, PH_B_ATT, PH_B_OUT, PH_B_LN1, PH_B_F0, PH_B_FIX, PH_B_F1, PH_B_LN2, PH_COUNT };

struct GemmJob { pg8::Gemm g; int epi; void* O; const float* aux; const float* aux2; int ldc; int coff; };
__device__ __forceinline__ void set_job(GemmJob& J, const bf16_t* A, const bf16_t* Bt, int M, int N, int K, int lda, int epi, void* O, const float* aux, int ldc) {
    J.g.A = A; J.g.Bt = Bt; J.g.M = M; J.g.N = N; J.g.K = K; J.g.lda = lda; J.g.kstepA = 128; J.epi = epi; J.O = O; J.aux = aux; J.aux2 = nullptr; J.ldc = ldc; J.coff = 0;
}
__device__ __forceinline__ bool gemm_job(const Params& p, int ph, int j, GemmJob& J) {
    unsigned char* ws = p.ws;
    const bf16_t* XB = (const bf16_t*)(ws + WS_XB); const float* XF = (const float*)XB;
    unsigned char* big = ws + WS_BIG;
    const int layer = ph >= PH_B_GEMM ? 1 : 0;
    const bf16_t* Win = (const bf16_t*)(ws + WS_WFIN) + (size_t)layer * 2 * DFF * DM; const bf16_t* Wout = (const bf16_t*)(ws + WS_WFOUT) + (size_t)layer * DM * DFF;
    if (ph == PH_A_GEMM) {
        if (j == 0) { set_job(J, XB, (const bf16_t*)(ws + WS_WAIN), NTOK, AINP, DM, DM, 0, big + BIG_P, nullptr, AINP); return true; }
        return false;
    }
    if (ph == PH_A_CMP1) {
        if (j == 2) { set_job(J, (const bf16_t*)(ws + WS_MEMB), (const bf16_t*)(ws + WS_WMKV), BATCH * NMEM, 1024, DM, DM, 0, ws + WS_MKV, nullptr, 1024); J.coff = 32; return true; }
        if (j >= 3) return false;
        const bf16_t* P = (const bf16_t*)(big + BIG_P);
        set_job(J, P + (j ? P_VC : P_KC), (const bf16_t*)(ws + (j ? WS_WC1V : WS_WC1K)), 4096, 256, 2048, 16 * AINP, 1, (float*)(ws + WS_CMPH) + (size_t)j * 4096 * 256, (const float*)(ws + WS_CBIAS) + j * 256, 256);
        J.g.kstepA = AINP * 2; J.coff = j * 16; return true;
    }
    if (ph == PH_A_OUT) { if (j) return false; set_job(J, (const bf16_t*)(big + BIG_O0), (const bf16_t*)(ws + WS_WAOUT), NTOK, DM, DM, DM, 2, p.out, p.in[I_X], DM); return true; }
    if (ph == PH_B_OUT) { if (j) return false; set_job(J, (const bf16_t*)(big + BIG_O1), (const bf16_t*)(ws + WS_WBOUT), NTOK, DM, DM, DM, 4, p.out, XF, DM); return true; }
    if (ph == PH_B_GEMM) {
        if (j == 0) { set_job(J, XB, (const bf16_t*)(ws + WS_WSKV), NTOK, 1536, DM, DM, 0, big + BIG_KV, nullptr, 1536); return true; }
        if (j == 1) { set_job(J, XB, (const bf16_t*)(ws + WS_WBIN), NTOK, DM, DM, DM, 0, big + BIG_Q1, nullptr, DM); return true; }
        return false;
    }
    const int f = layer ? ph - PH_B_F0 : ph - PH_A_F0;
    if (j) return false;
    if (f == 0) { set_job(J, XB, Win, NTOK, 2 * DFF, DM, DM, 3, big + BIG_H, p.in[I_FCW] + (size_t)layer * 3 * DFF, DFF); J.aux2 = p.in[I_FCB] + (size_t)layer * DFF; return true; }
    if (f == 2) { set_job(J, (const bf16_t*)(big + BIG_H), Wout, NTOK, DM, DFF, DFF, 4, p.out, XF, DM); return true; }
    return false;
}
__device__ __forceinline__ bool is_gemm_phase(int ph) {
    return ph == PH_A_GEMM || ph == PH_A_CMP1 || ph == PH_A_OUT || ph == PH_B_OUT || ph == PH_B_GEMM || ph == PH_A_F0 || ph == PH_A_F1 || ph == PH_B_F0 || ph == PH_B_F1;
}
template <int JJ>
__device__ __forceinline__ void run_gemm_job(const Params& p, LAS unsigned char* lds, int ph) {
    GemmJob J;
    if (!gemm_job(p, ph, JJ, J)) return;
    pg8::StaticOrder S; S.init(J.g.M, J.g.N, (int)gridDim.x, (int)blockIdx.x - J.coff);
    if (J.epi == 0) { pg8::EpiBf16 E{(bf16_t*)J.O, J.ldc}; pg8::gemm_phase<pg8::EpiBf16>(lds, J.g, S, E); }
    else if (J.epi == 1) { pg8::EpiF32BiasGelu E{(float*)J.O, J.ldc, J.aux}; pg8::gemm_phase<pg8::EpiF32BiasGelu>(lds, J.g, S, E); }
    else if (J.epi == 3) { unsigned char* big = p.ws + WS_BIG; pg8::EpiConvGate E{(bf16_t*)J.O, J.aux, J.aux2, (float*)(big + BIG_TAILA), (float*)(big + BIG_HEADA), (float*)(big + BIG_HEADB)}; pg8::gemm_phase<pg8::EpiConvGate>(lds, J.g, S, E); }
    else if (J.epi == 2) { pg8::EpiResF32<true> E{J.aux, (float*)J.O, J.ldc, ALPHA}; pg8::gemm_phase<pg8::EpiResF32<true>>(lds, J.g, S, E); }
    else { pg8::EpiResF32<false> E{J.aux, (float*)J.O, J.ldc, ALPHA}; pg8::gemm_phase<pg8::EpiResF32<false>>(lds, J.g, S, E); }
}
__device__ __forceinline__ void run_gemm_phase(const Params& p, LAS unsigned char* lds, int ph) {
    run_gemm_job<0>(p, lds, ph); run_gemm_job<1>(p, lds, ph); run_gemm_job<2>(p, lds, ph);
}

__device__ __forceinline__ void run_phase(const Params& p, LAS unsigned char* lds, const Ctx& c, int ph) {
    unsigned char* ws = p.ws;
    bf16_t* XB = (bf16_t*)(ws + WS_XB);
    const int G = (int)gridDim.x, bid = (int)blockIdx.x;
    const int vid = (G % 8 == 0) ? (bid % 8) * (G / 8) + bid / 8 : bid;
    if (ph == PH_A_FIX || ph == PH_B_FIX) {
        const int layer = ph == PH_B_FIX ? 1 : 0;
        for (int pm = bid; pm < NTOK / 256; pm += G) ffn_fixup(c, ws + WS_BIG, p.in[I_FCW] + (size_t)layer * 3 * DFF, p.in[I_FCB] + (size_t)layer * DFF, pm);
        return;
    }
    if (ph == PH_A_CMP1 && G >= LATE_FIRST_WG + 32 && bid >= LATE_FIRST_WG) {
        Ctx c2 = c; c2.gtid = (bid - LATE_FIRST_WG) * NTHR + c.tid; c2.gsz = (G - LATE_FIRST_WG) * NTHR;
        prep_late(p, c2);
    }
    if (is_gemm_phase(ph)) { run_gemm_phase(p, lds, ph); return; }
    switch (ph) {
    case PH_PREP: phase_prep(p, c); break;
    case PH_A_CMP2: phase_cmp2(p, c); break;
    case PH_A_NSA1: {
        for (int u = vid; u < BATCH * 8; u += G) nsa1_unit(p, lds, u >> 3, u & 7);
    } break;
    case PH_A_NSA2: {
        for (int u = vid; u < BATCH * (NH / 2) * 4; u += G) { const int b = u / 24, r = u % 24, hp = r >> 2, s = (r + u / G) & 3;
#pragma nounroll
            for (int k = 0; k < 2; ++k) nsa2_unit(p, lds, b, 2 * hp, k ? s : 7 - s); }
    } break;
    case PH_B_ATT: {
        for (int u = vid; u < BATCH * NH * 2; u += G) { const int b = u / 24, r = u % 24, h = r >> 1, s = r & 1;
#pragma nounroll
            for (int k = 0; k < 2; ++k) moba_unit(p, lds, b, h, k ? s : 3 - s); }
    } break;
    case PH_A_LN1: case PH_B_LN1: case PH_A_LN2: case PH_B_LN2: {
        const int layer = ph >= PH_B_GEMM ? 1 : 0; const bool second = (ph == PH_A_LN2 || ph == PH_B_LN2); const bool fin = (ph == PH_B_LN2);
        phase_ln(c, p.out, p.in[second ? I_LN2G : I_LN1G] + layer * DM, p.in[second ? I_LN2B : I_LN1B] + layer * DM, fin ? p.out : nullptr, fin ? nullptr : XB);
    } break;
    case PH_B_KMEAN: phase_kmean(c, (const bf16_t*)(ws + WS_BIG + BIG_KV), (float*)(ws + WS_KMEAN)); break;
    default: break;
    }
    if (ph == PH_A_NSA1 || ph == PH_B_ATT) {
        const bool la = (ph == PH_A_NSA1);
        const bf16_t* Q = (const bf16_t*)(ws + WS_BIG + (la ? BIG_P : BIG_Q1)); bf16_t* O = (bf16_t*)(ws + WS_BIG + (la ? BIG_O0 : BIG_O1));
        for (int u = vid; u < BATCH * 4 * 4; u += G) mem_unit(p, lds, Q, la ? AINP : DM, la ? P_QM : MAINW, O, la ? 0 : 512, u >> 4, (u >> 2) & 3, u & 3);
    }
}

template <int PH>
__device__ __forceinline__ void phase_seq(const Params& p, LAS unsigned char* lds, const Ctx& c, cg::grid_group& grid, const XcdBarrier& bar) {
    if constexpr (PH < PH_COUNT) {
        if (PH >= p.ph_lo && PH < p.ph_hi) {
            Ctx cc; { int t_ = threadIdx.x; asm volatile("" : "+v"(t_)); cc.tid = t_; cc.lane = t_ & 63; cc.wid = t_ >> 6; cc.gtid = blockIdx.x * NTHR + t_; cc.gsz = gridDim.x * NTHR; cc.gw = blockIdx.x * (NTHR / 64) + cc.wid; cc.ngw = gridDim.x * (NTHR / 64); }
            run_phase(p, lds, cc, PH); if (PH + 1 < p.ph_hi) { if (PH == 0) grid.sync(); else xcd_barrier(bar); } }
        phase_seq<PH + 1>(p, lds, c, grid, bar);
    }
}
__global__ void __launch_bounds__(NTHR) yoco_mega(Params p) {
    extern __shared__ __attribute__((aligned(16))) unsigned char lds_raw[];
    LAS unsigned char* lds = (LAS unsigned char*)lds_raw;
    cg::grid_group grid = cg::this_grid();
    Ctx c; c.tid = threadIdx.x; c.lane = c.tid & 63; c.wid = c.tid >> 6; c.gtid = blockIdx.x * NTHR + c.tid; c.gsz = gridDim.x * NTHR; c.gw = blockIdx.x * (NTHR / 64) + c.wid; c.ngw = gridDim.x * (NTHR / 64);
    if (c.tid < 130) ((LAS int*)(lds + att::L_BKT))[c.tid] = c.tid == 0 ? 0 : att::rel_bucket(c.tid - 1);
    if (c.tid < 2) ((LAS unsigned*)(lds + att::L_MISC))[c.tid] = 0u;
    __syncthreads();
    const XcdBarrier bar = xcd_barrier_post((unsigned*)(p.ws + WS_CTL), (volatile LAS unsigned*)(lds + att::L_MISC));
    phase_seq<0>(p, lds, c, grid, bar);
}

extern "C" void kernel_launch(void* const* d_in, const int* in_sizes, int n_in, void* d_out, int out_size, void* d_ws, size_t ws_size, hipStream_t stream) {
    static int grid = 0;
    if (grid == 0) {
        if (n_in != 24 || ws_size < WS_NEED) { fprintf(stderr, "kernel_launch: unexpected n_in %d / ws_size %zu (need %zu)\n", n_in, ws_size, (size_t)WS_NEED); grid = -1; return; }
        int dev = 0, cus = 0, per_cu = 0;
        hipGetDevice(&dev); hipDeviceGetAttribute(&cus, hipDeviceAttributeMultiprocessorCount, dev);
        if (hipFuncSetAttribute((const void*)yoco_mega, hipFuncAttributeMaxDynamicSharedMemorySize, LDS_BYTES) != hipSuccess) { fprintf(stderr, "kernel_launch: hipFuncSetAttribute failed\n"); grid = -1; return; }
        if (hipOccupancyMaxActiveBlocksPerMultiprocessor(&per_cu, (const void*)yoco_mega, NTHR, LDS_BYTES) != hipSuccess || per_cu < 1) { fprintf(stderr, "kernel_launch: occupancy query says %d\n", per_cu); per_cu = 1; }
        (void)hipGetLastError();
        grid = cus * per_cu;
        fprintf(stderr, "kernel_launch: grid %d (cus %d x %d)\n", grid, cus, per_cu);
    }
    if (grid < 0) return;
    if (hipMemsetAsync((char*)d_ws + WS_CTL, 0, CTL_BYTES, stream) != hipSuccess) { fprintf(stderr, "kernel_launch: memset failed\n"); return; }
    Params p{};
    for (int i = 0; i < 24; ++i) p.in[i] = (const float*)d_in[i];
    p.out = (float*)d_out; p.ws = (unsigned char*)d_ws; p.ph_lo = 0; p.ph_hi = PH_COUNT;
    void* args[] = {&p};
    hipError_t e = hipLaunchCooperativeKernel((const void*)yoco_mega, dim3(grid), dim3(NTHR), args, LDS_BYTES, stream);
    if (e != hipSuccess) fprintf(stderr, "kernel_launch: cooperative launch failed: %s (grid %d)\n", hipGetErrorString(e), grid);
}
```

```cpp
#include <hip/hip_runtime.h>
#include <hip/hip_cooperative_groups.h>
#include <cstdio>
#include <cstdint>
namespace cg = cooperative_groups;

#define LAS __attribute__((address_space(3)))
typedef unsigned short bf16_t;
typedef short bf16x8 __attribute__((ext_vector_type(8)));
typedef short s16x4 __attribute__((ext_vector_type(4)));
typedef float f32x4 __attribute__((ext_vector_type(4)));
typedef float f32x2 __attribute__((ext_vector_type(2)));
typedef float f32x16 __attribute__((ext_vector_type(16)));
typedef unsigned u32x4 __attribute__((ext_vector_type(4)));
typedef unsigned u32x2 __attribute__((ext_vector_type(2)));

__device__ __forceinline__ unsigned cvt_pk_bf16(float lo, float hi) { unsigned r; asm volatile("v_cvt_pk_bf16_f32 %0, %1, %2" : "=v"(r) : "v"(lo), "v"(hi)); return r; }
__device__ __forceinline__ float bf2f(unsigned short b) { return __uint_as_float(((unsigned)b) << 16); }
__device__ __forceinline__ float gelu_tanh(float x) {
    const float x2 = x * x;
    const float w = x * (-2.302208198f - 0.1029432397f * x2);
    return x * __builtin_amdgcn_rcpf(1.0f + __builtin_amdgcn_exp2f(w));
}

namespace pg8 {
constexpr int BM = 256, BK = 64, HALF = 128, HTB = HALF * BK * 2, STAGE_BYTES = 8 * HTB, NXCD = 8, WGM = 8;
__host__ __device__ __forceinline__ int lds_byte(int r, int c) { const int st = (r >> 4) * 2 + (c >> 5), rr = r & 15, cc = c & 31, ob = rr * 64 + cc * 2; return st * 1024 + (ob ^ (((ob >> 9) & 1) << 5)); }
__host__ __device__ __forceinline__ void stage_rc(int b, int& R, int& C) { const int st = b / 1024, sb = b % 1024, swz = sb ^ (((sb >> 9) & 1) << 5); R = (st >> 1) * 16 + swz / 64; C = (st & 1) * 32 + (swz % 64) / 2; }
__host__ __device__ __forceinline__ int perm32(int rho) { const int n = rho >> 4, i = rho & 15; return 8 * (i >> 2) + 4 * n + (i & 3); }

struct Unit { int pm, pn; };
struct Gemm { const bf16_t* A; const bf16_t* Bt; int M, N, K; int lda; int kstepA; };

struct StaticOrder {
    int nM, nN, nwg, G, c;
    __host__ __device__ void init(int M, int N, int G_, int c_) { nM = M / BM; nN = N / BM; nwg = nM * nN; G = G_; c = c_; }
    __host__ __device__ bool next(int i, Unit& u) const {
        if (c < 0) return false;
        const long L = (long)i * G + c; if (L >= nwg) return false;
        int wgid = (int)L; { const int q = nwg / NXCD, r = nwg % NXCD, xcd = wgid % NXCD, off = wgid / NXCD; wgid = (xcd < r ? xcd * (q + 1) : r * (q + 1) + (xcd - r) * q) + off; }
        const int nig = WGM * nN, gid = wgid / nig, fm = gid * WGM, gsz = (nM - fm) < WGM ? (nM - fm) : WGM;
        u.pm = fm + ((wgid % nig) % gsz); u.pn = (wgid % nig) / gsz; return true;
    }
};

struct EpiBf16 {
    static constexpr bool PERM = true;
    bf16_t* O; int ldc;
    __device__ __forceinline__ void operator()(const f32x4 (&acc)[2][2][4][2], const Unit& u, int wr, int wc, int fr, int fq) const {
        const int row0 = u.pm * BM + wr * 64 + fr; const int col0 = u.pn * BM + wc * 32 + 8 * fq;
#pragma unroll
        for (int ai = 0; ai < 2; ++ai)
#pragma unroll
            for (int m = 0; m < 4; ++m) { bf16_t* rowp = O + (size_t)(row0 + ai * HALF + m * 16) * ldc + col0;
#pragma unroll
                for (int bj = 0; bj < 2; ++bj) { const f32x4 v0 = acc[ai][bj][m][0], v1 = acc[ai][bj][m][1];
                    u32x4 w; w.x = cvt_pk_bf16(v0[0], v0[1]); w.y = cvt_pk_bf16(v0[2], v0[3]); w.z = cvt_pk_bf16(v1[0], v1[1]); w.w = cvt_pk_bf16(v1[2], v1[3]);
                    *(u32x4*)(rowp + bj * HALF) = w; } }
    }
};
struct EpiF32BiasGelu {
    static constexpr bool PERM = false;
    float* O; int ldc; const float* bias;
    __device__ __forceinline__ void operator()(const f32x4 (&acc)[2][2][4][2], const Unit& u, int wr, int wc, int fr, int fq) const {
        const int row0 = u.pm * BM + wr * 64 + fr; const int col0 = u.pn * BM + wc * 32 + 4 * fq;
#pragma unroll
        for (int bj = 0; bj < 2; ++bj)
#pragma unroll
            for (int n = 0; n < 2; ++n) { const f32x4 bv = *(const f32x4*)(bias + col0 + bj * HALF + n * 16);
#pragma unroll
                for (int ai = 0; ai < 2; ++ai)
#pragma unroll
                    for (int m = 0; m < 4; ++m) { f32x4 v = acc[ai][bj][m][n] + bv; v[0] = gelu_tanh(v[0]); v[1] = gelu_tanh(v[1]); v[2] = gelu_tanh(v[2]); v[3] = gelu_tanh(v[3]);
                        *(f32x4*)(O + (size_t)(row0 + ai * HALF + m * 16) * ldc + col0 + bj * HALF + n * 16) = v; } }
    }
};
template <int CTRL> __device__ __forceinline__ float dppf(float old, float src) {
    return __int_as_float(__builtin_amdgcn_update_dpp(__float_as_int(old), __float_as_int(src), CTRL, 0xf, 0xf, false));
}
struct EpiConvGate {
    static constexpr bool PERM = true;
    bf16_t* H; const float* cw; const float* cb; float* TAILA; float* HEADA; float* HEADB;
    __device__ __forceinline__ void operator()(const f32x4 (&acc)[2][2][4][2], const Unit& u, int wr, int wc, int fr, int fq) const {
        constexpr int DFF_ = 2816;
        const int cf0 = u.pn * 128 + wc * 32 + 8 * fq;
        f32x4 w0[2], w1[2], w2[2], cv[2];
#pragma unroll
        for (int n = 0; n < 2; ++n) { w0[n] = *(const f32x4*)(cw + cf0 + 4 * n); w1[n] = *(const f32x4*)(cw + DFF_ + cf0 + 4 * n); w2[n] = *(const f32x4*)(cw + 2 * DFF_ + cf0 + 4 * n); cv[n] = *(const f32x4*)(cb + cf0 + 4 * n); }
#pragma unroll
        for (int ai = 0; ai < 2; ++ai) {
            const int G = u.pm * 4 + ai * 2 + wr;
#pragma unroll
            for (int m = 0; m < 4; ++m) {
                const int row = u.pm * BM + ai * HALF + wr * 64 + m * 16 + fr;
                f32x4 hv[2];
#pragma unroll
                for (int n = 0; n < 2; ++n) {
                    const f32x4 a = acc[ai][0][m][n], b = acc[ai][1][m][n];
                    const f32x4 pv = acc[ai][0][m > 0 ? m - 1 : 0][n];
#pragma unroll
                    for (int j = 0; j < 4; ++j) {
                        const float am1 = dppf<0x111>(dppf<0x121>(0.f, pv[j]), a[j]);
                        const float am2 = dppf<0x112>(dppf<0x122>(0.f, pv[j]), a[j]);
                        const float pre = w0[n][j] * am2 + w1[n][j] * am1 + w2[n][j] * a[j] + cv[n][j];
                        hv[n][j] = gelu_tanh(pre) * b[j];
                    }
                }
                if (m > 0 || fr >= 2) {
                    u32x4 w; w.x = cvt_pk_bf16(hv[0][0], hv[0][1]); w.y = cvt_pk_bf16(hv[0][2], hv[0][3]); w.z = cvt_pk_bf16(hv[1][0], hv[1][1]); w.w = cvt_pk_bf16(hv[1][2], hv[1][3]);
                    *(u32x4*)(H + (size_t)row * DFF_ + cf0) = w;
                } else {
                    float* ha = HEADA + ((size_t)G * 2 + fr) * DFF_ + cf0; float* hb = HEADB + ((size_t)G * 2 + fr) * DFF_ + cf0;
                    *(f32x4*)ha = acc[ai][0][0][0]; *(f32x4*)(ha + 4) = acc[ai][0][0][1]; *(f32x4*)hb = acc[ai][1][0][0]; *(f32x4*)(hb + 4) = acc[ai][1][0][1];
                }
                if (m == 3 && fr >= 14) { float* ta = TAILA + ((size_t)G * 2 + (fr - 14)) * DFF_ + cf0; *(f32x4*)ta = acc[ai][0][3][0]; *(f32x4*)(ta + 4) = acc[ai][0][3][1]; }
            }
        }
    }
};
template <bool BASE_F32>
struct EpiResF32 {
    static constexpr bool PERM = false;
    const void* basev; float* O; int ldc; float alpha;
    __device__ __forceinline__ void operator()(const f32x4 (&acc)[2][2][4][2], const Unit& u, int wr, int wc, int fr, int fq) const {
        const int row0 = u.pm * BM + wr * 64 + fr; const int col0 = u.pn * BM + wc * 32 + 4 * fq;
#pragma unroll
        for (int ai = 0; ai < 2; ++ai)
#pragma unroll
            for (int m = 0; m < 4; ++m) { const size_t off = (size_t)(row0 + ai * HALF + m * 16) * ldc + col0;
#pragma unroll
                for (int bj = 0; bj < 2; ++bj)
#pragma unroll
                    for (int n = 0; n < 2; ++n) { f32x4 bs;
                        if (BASE_F32) bs = *(const f32x4*)((const float*)basev + off + bj * HALF + n * 16);
                        else { const u32x2 w = *(const u32x2*)((const bf16_t*)basev + off + bj * HALF + n * 16); bs[0] = __uint_as_float(w.x << 16); bs[1] = __uint_as_float(w.x & 0xffff0000u); bs[2] = __uint_as_float(w.y << 16); bs[3] = __uint_as_float(w.y & 0xffff0000u); }
                        *(f32x4*)(O + off + bj * HALF + n * 16) = bs * alpha + acc[ai][bj][m][n]; } }
    }
};

template <class Epi>
__device__ __forceinline__ void gemm_phase(LAS unsigned char* lds, const Gemm g, const StaticOrder& S, const Epi& E) {
    const int tid = threadIdx.x, wid = __builtin_amdgcn_readfirstlane(tid >> 6), lane = tid & 63, wr = wid >> 2, wc = wid & 3, fr = lane & 15, fq = lane >> 4;
    const int K = g.K, nt = K / BK;
    unsigned voffA[2], voffB[2];
#pragma unroll
    for (int i = 0; i < 2; ++i) { int R, C; stage_rc(tid * 16 + i * 8192, R, C); const int Rb = Epi::PERM ? ((R & ~31) + perm32(R & 31)) : R;
        voffA[i] = (unsigned)(R * g.lda + C) * 2u; voffB[i] = (unsigned)(Rb * K + C) * 2u; }
    const size_t kstepA = (size_t)g.kstepA, kstepB = (size_t)(BK * 2);
    const size_t hstepA = (size_t)HALF * g.lda * 2, hstepB = (size_t)HALF * K * 2;
    const size_t tstepA = 2 * hstepA, tstepB = 2 * hstepB;
    const unsigned ldsw = (unsigned)wid * 1024u;
    const int aoff = lds_byte(wr * 64 + fr, fq * 8), boff = lds_byte(wc * 32 + fr, fq * 8);
#define PG8_SA(b, h) (((b) * 2 + (h)) * HTB)
#define PG8_SB(b, h) ((4 + (b) * 2 + (h)) * HTB)
#define PG8_STAGE(bufoff, gbase, voff) do { _Pragma("unroll") for (int _i = 0; _i < 2; ++_i) \
        __builtin_amdgcn_global_load_lds((const unsigned*)((const char*)(gbase) + (voff)[_i]), (LAS unsigned*)(lds + (bufoff) + ldsw + _i * 8192), 16, 0, 0); } while (0)
#define PG8_LDA(dst, b, h) do { _Pragma("unroll") for (int m = 0; m < 4; ++m) _Pragma("unroll") for (int k = 0; k < 2; ++k) dst[m][k] = *(const LAS bf16x8*)(lds + PG8_SA(b, h) + aoff + m * 2048 + k * 1024); } while (0)
#define PG8_LDB(dst, b, h) do { _Pragma("unroll") for (int n = 0; n < 2; ++n) _Pragma("unroll") for (int k = 0; k < 2; ++k) dst[n][k] = *(const LAS bf16x8*)(lds + PG8_SB(b, h) + boff + n * 2048 + k * 1024); } while (0)
#define PG8_MMA(ai, bj, At, Bt) do { __builtin_amdgcn_s_setprio(1); _Pragma("unroll") for (int m = 0; m < 4; ++m) _Pragma("unroll") for (int n = 0; n < 2; ++n) _Pragma("unroll") for (int k = 0; k < 2; ++k) \
        acc[ai][bj][m][n] = __builtin_amdgcn_mfma_f32_16x16x32_bf16(Bt[n][k], At[m][k], acc[ai][bj][m][n], 0, 0, 0); __builtin_amdgcn_s_setprio(0); } while (0)
#define PG8_WAIT_V(n) asm volatile("s_waitcnt vmcnt(" #n ")" ::: "memory")
#define PG8_WAIT_L(n) asm volatile("s_waitcnt lgkmcnt(" #n ")" ::: "memory")
#define PG8_BAR __builtin_amdgcn_s_barrier()
#define PG8_SCHED __builtin_amdgcn_sched_barrier(0)
    Unit cur, nxt; int ui = 0;
    if (!S.next(0, cur)) return;
    f32x4 acc[2][2][4][2];
#pragma unroll
    for (int a = 0; a < 2; ++a)
#pragma unroll
        for (int b = 0; b < 2; ++b)
#pragma unroll
            for (int m = 0; m < 4; ++m)
#pragma unroll
                for (int n = 0; n < 2; ++n) acc[a][b][m][n] = (f32x4){0.f, 0.f, 0.f, 0.f};
    bf16x8 At[4][2], B0[2][2], B1[2][2];
    const char* cA = (const char*)g.A + (size_t)cur.pm * tstepA; const char* cB = (const char*)g.Bt + (size_t)cur.pn * tstepB;
    PG8_STAGE(PG8_SB(0, 0), cB, voffB); PG8_STAGE(PG8_SB(0, 1), cB + hstepB, voffB); PG8_STAGE(PG8_SA(0, 0), cA, voffA); PG8_STAGE(PG8_SA(0, 1), cA + hstepA, voffA);
    if (wr == 1) PG8_BAR;
    PG8_WAIT_V(2); PG8_BAR;
    PG8_STAGE(PG8_SB(1, 0), cB + kstepB, voffB); PG8_STAGE(PG8_SA(1, 0), cA + kstepA, voffA); PG8_STAGE(PG8_SB(1, 1), cB + hstepB + kstepB, voffB);
    PG8_WAIT_V(6); PG8_BAR;
    for (;;) {
        const bool has_next = S.next(ui + 1, nxt);
        const char* nA = has_next ? (const char*)g.A + (size_t)nxt.pm * tstepA : cA; const char* nB = has_next ? (const char*)g.Bt + (size_t)nxt.pn * tstepB : cB;
        for (int t = 0; t < nt; t += 2) {
            const bool last = (t == nt - 2);
            const char* a1 = cA + (size_t)(t + 1) * kstepA;
            const char* a2 = last ? nA : cA + (size_t)(t + 2) * kstepA; const char* b2 = last ? nB : cB + (size_t)(t + 2) * kstepB;
            const char* a3 = a2 + kstepA; const char* b3 = b2 + kstepB;
            PG8_LDB(B0, 0, 0); PG8_LDB(B1, 0, 1); PG8_SCHED; PG8_LDA(At, 0, 0); PG8_STAGE(PG8_SA(1, 1), a1 + hstepA, voffA);
            PG8_WAIT_V(8); PG8_WAIT_L(0); PG8_BAR; PG8_MMA(0, 0, At, B0); PG8_MMA(0, 1, At, B1); PG8_BAR; PG8_SCHED;
            PG8_LDA(At, 0, 1); PG8_STAGE(PG8_SB(0, 0), b2, voffB); PG8_STAGE(PG8_SB(0, 1), b2 + hstepB, voffB); PG8_STAGE(PG8_SA(0, 0), a2, voffA);
            PG8_WAIT_V(8); PG8_WAIT_L(0); PG8_BAR; PG8_MMA(1, 0, At, B0); PG8_MMA(1, 1, At, B1); PG8_BAR; PG8_SCHED;
            PG8_LDB(B0, 1, 0); PG8_LDB(B1, 1, 1); PG8_SCHED; PG8_LDA(At, 1, 0); PG8_STAGE(PG8_SA(0, 1), a2 + hstepA, voffA);
            PG8_WAIT_V(8); PG8_WAIT_L(0); PG8_BAR; PG8_MMA(0, 0, At, B0); PG8_MMA(0, 1, At, B1); PG8_BAR; PG8_SCHED;
            PG8_LDA(At, 1, 1); PG8_STAGE(PG8_SB(1, 0), b3, voffB); PG8_STAGE(PG8_SB(1, 1), b3 + hstepB, voffB); PG8_STAGE(PG8_SA(1, 0), a3, voffA);
            PG8_WAIT_V(8); PG8_WAIT_L(0); PG8_BAR; PG8_MMA(1, 0, At, B0); PG8_MMA(1, 1, At, B1); PG8_BAR; PG8_SCHED;
        }
        if (wr == 0) PG8_BAR;
        E(acc, cur, wr, wc, fr, fq);
        if (!has_next) break;
#pragma unroll
        for (int a = 0; a < 2; ++a)
#pragma unroll
            for (int b = 0; b < 2; ++b)
#pragma unroll
                for (int m = 0; m < 4; ++m)
#pragma unroll
                    for (int n = 0; n < 2; ++n) acc[a][b][m][n] = (f32x4){0.f, 0.f, 0.f, 0.f};
        cur = nxt; cA = nA; cB = nB; ++ui;
        if (wr == 1) PG8_BAR;
    }
    PG8_WAIT_V(0);
    PG8_BAR;
#undef PG8_SA
#undef PG8_SB
#undef PG8_STAGE
#undef PG8_LDA
#undef PG8_LDB
#undef PG8_MMA
#undef PG8_WAIT_V
#undef PG8_WAIT_L
#undef PG8_BAR
#undef PG8_SCHED
}
}

constexpr int BATCH = 32, SEQ = 2048, DM = 1024, NTOK = BATCH * SEQ, NMEM = 256, NH = 12, HD = 64, MAINW = 768;
constexpr int AIN = 1444, AINP = 1536, DFF = 2816, NCMP = 127;
constexpr int HALF_TOK = NTOK / 2;
constexpr float ALPHA = 1.4142135623730951f;
constexpr float LN_EPS = 1e-5f;
constexpr int P_Q = 0, P_KC = 768, P_VC = 832, P_KS = 896, P_VS = 960, P_KW = 1024, P_VW = 1088, P_QM = 1152, P_G = 1408;
constexpr size_t MiB = 1u << 20;
constexpr size_t WS_WAIN = 0 * MiB, WS_WAMKV = 3 * MiB, WS_WAOUT = 4 * MiB, WS_WSKV = 6 * MiB, WS_WBIN = 9 * MiB, WS_WBMKV = 11 * MiB, WS_WBOUT = 12 * MiB;
constexpr size_t WS_WFIN = 14 * MiB  , WS_WFOUT = 36 * MiB  , WS_WC1K = 47 * MiB, WS_WC1V = 48 * MiB, WS_WMKV = 49 * MiB  ;
constexpr size_t WS_CTL = 51 * MiB, CTL_BYTES = 16384;
constexpr size_t WS_MEMB = 52 * MiB, WS_MKV = 68 * MiB  , WS_CMPH = 84 * MiB, WS_KCMP = 92 * MiB, WS_VCMP = 93 * MiB, WS_CBIAS = 94 * MiB, WS_SEL = 94 * MiB + 65536, WS_KMEAN = 95 * MiB;
constexpr size_t WS_XB = 96 * MiB, WS_BIG = 226 * MiB;
constexpr size_t BIG_P = 0, BIG_O0 = 193 * MiB, BIG_H = 0, BIG_TAILA = 352 * MiB, BIG_HEADA = 374 * MiB, BIG_HEADB = 396 * MiB, BIG_KV = 0  , BIG_O1 = 321 * MiB;
constexpr int KVP = 2560, KV_Q = 1536;
static_assert(WS_WBIN == WS_WSKV + (size_t)1536 * 1024 * 2, "layer-1 weight copies must be adjacent");
constexpr size_t WS_NEED = WS_BIG + 449 * MiB;

constexpr int LDS_BYTES = 147456;
constexpr int NTHR = 512;

struct Params {
    const float* in[24];
    float* out;
    unsigned char* ws;
    int ph_lo, ph_hi;
};
enum { I_X = 0, I_MEM, I_RELB, I_AWIN, I_PEK, I_W1K, I_W2K, I_PEV, I_W1V, I_W2V, I_AWMKV, I_AWOUT, I_SWKV, I_BWIN, I_BWMKV, I_BWOUT, I_LN1G, I_LN1B, I_LN2G, I_LN2B, I_FWIN, I_FCW, I_FCB, I_FWOUT };

namespace att {
constexpr int ROWB = 144, TILEB = 64 * ROWB, VROWB = 192, VTILEB = 64 * VROWB;
constexpr float NEG = -1e30f;
constexpr float LOG2E = 1.4426950408889634f;
constexpr float SC2 = 0.125f * LOG2E;
typedef short v4i16_t __attribute__((ext_vector_type(4)));

__device__ __forceinline__ f32x16 zero16() { f32x16 z;
#pragma unroll
    for (int i = 0; i < 16; ++i) z[i] = 0.f; return z; }

__device__ __forceinline__ void qk_tile(f32x16& p0, f32x16& p1, const LAS unsigned char* Kt, const bf16x8 (&qr)[4], int r32, int hi, float cinit = 0.f) {
    const LAS unsigned char* kb = Kt + r32 * ROWB + hi * 16;
#pragma unroll
    for (int i = 0; i < 16; ++i) { p0[i] = cinit; p1[i] = cinit; }
#pragma unroll
    for (int d0 = 0; d0 < 4; ++d0) {
        const bf16x8 k0 = *(const LAS bf16x8*)(kb + d0 * 32);
        const bf16x8 k1 = *(const LAS bf16x8*)(kb + 32 * ROWB + d0 * 32);
        p0 = __builtin_amdgcn_mfma_f32_32x32x16_bf16(k0, qr[d0], p0, 0, 0, 0);
        p1 = __builtin_amdgcn_mfma_f32_32x32x16_bf16(k1, qr[d0], p1, 0, 0, 0);
    }
}
__device__ __forceinline__ s16x4 vtr(const LAS unsigned char* p) { return __builtin_bit_cast(s16x4, __builtin_amdgcn_ds_read_tr16_b64_v4i16((LAS v4i16_t*)p)); }
__device__ __forceinline__ void pv_tile(f32x16& o0, f32x16& o1, const LAS unsigned char* Vt, const f32x16& p0, const f32x16& p1, int lane) {
    const int hi = lane >> 5, g1 = (lane >> 4) & 1, i = lane & 15, q_ = i >> 2, p_ = i & 3;
    const LAS unsigned char* vb = Vt + (4 * hi + q_) * VROWB + (16 * g1 + 4 * p_) * 2;
#pragma unroll
    for (int s = 0; s < 4; ++s) {
        u32x4 w;
        if (s < 2) { const int b = 8 * (s & 1); w.x = cvt_pk_bf16(p0[b + 0], p0[b + 1]); w.y = cvt_pk_bf16(p0[b + 2], p0[b + 3]); w.z = cvt_pk_bf16(p0[b + 4], p0[b + 5]); w.w = cvt_pk_bf16(p0[b + 6], p0[b + 7]); }
        else       { const int b = 8 * (s & 1); w.x = cvt_pk_bf16(p1[b + 0], p1[b + 1]); w.y = cvt_pk_bf16(p1[b + 2], p1[b + 3]); w.z = cvt_pk_bf16(p1[b + 4], p1[b + 5]); w.w = cvt_pk_bf16(p1[b + 6], p1[b + 7]); }
        const bf16x8 pf = __builtin_bit_cast(bf16x8, w);
#pragma unroll
        for (int dh = 0; dh < 2; ++dh) {
            const s16x4 lo = vtr(vb + (16 * s) * VROWB + dh * 64);
            const s16x4 h4 = vtr(vb + (16 * s + 8) * VROWB + dh * 64);
            const bf16x8 vf = (bf16x8){lo[0], lo[1], lo[2], lo[3], h4[0], h4[1], h4[2], h4[3]};
            if (dh == 0) o0 = __builtin_amdgcn_mfma_f32_32x32x16_bf16(vf, pf, o0, 0, 0, 0);
            else         o1 = __builtin_amdgcn_mfma_f32_32x32x16_bf16(vf, pf, o1, 0, 0, 0);
        }
    }
}
struct Acc { float m, l; f32x16 o0, o1; };
__device__ __forceinline__ void acc_init(Acc& A) { A.m = NEG; A.l = 0.f; A.o0 = zero16(); A.o1 = zero16(); }
constexpr float THR_RAW = 8.0f / SC2;
__device__ __forceinline__ void sm_update(Acc& A, f32x16& p0, f32x16& p1) {
    float m0 = fmaxf(p0[0], p1[0]), m1 = fmaxf(p0[1], p1[1]);
#pragma unroll
    for (int r = 2; r < 16; r += 2) { m0 = fmaxf(fmaxf(m0, p0[r]), p1[r]); m1 = fmaxf(fmaxf(m1, p0[r + 1]), p1[r + 1]); }
    float mx = fmaxf(m0, m1);
    mx = fmaxf(mx, __shfl_xor(mx, 32));
    if (__any(mx > A.m + THR_RAW)) {
        const float mn = fmaxf(A.m, mx);
        const float alpha = __builtin_amdgcn_exp2f((A.m - (mn < -5e29f ? 0.f : mn)) * SC2);
        A.l *= alpha; A.m = mn;
#pragma unroll
        for (int r = 0; r < 16; ++r) { A.o0[r] *= alpha; A.o1[r] *= alpha; }
    }
    const float msc = (A.m < -5e29f ? 0.f : A.m) * SC2;
    float rs0 = 0.f, rs1 = 0.f;
#pragma unroll
    for (int r = 0; r < 16; ++r) {
        const float e0 = __builtin_amdgcn_exp2f(p0[r] * SC2 - msc);
        const float e1 = __builtin_amdgcn_exp2f(p1[r] * SC2 - msc);
        p0[r] = e0; p1[r] = e1; rs0 += e0; rs1 += e1;
    }
    A.l += rs0 + rs1;
}
__device__ __forceinline__ float rowmax32(const f32x16& p0, const f32x16& p1) {
    float m0 = fmaxf(p0[0], p1[0]), m1 = fmaxf(p0[1], p1[1]), m2 = fmaxf(p0[2], p1[2]), m3 = fmaxf(p0[3], p1[3]);
#pragma unroll
    for (int r = 4; r < 16; r += 4) { m0 = fmaxf(fmaxf(m0, p0[r]), p1[r]); m1 = fmaxf(fmaxf(m1, p0[r + 1]), p1[r + 1]); m2 = fmaxf(fmaxf(m2, p0[r + 2]), p1[r + 2]); m3 = fmaxf(fmaxf(m3, p0[r + 3]), p1[r + 3]); }
    return fmaxf(fmaxf(m0, m1), fmaxf(m2, m3));
}
__device__ __forceinline__ void sm_update2(Acc& A, Acc& B, f32x16& a0, f32x16& a1, f32x16& b0, f32x16& b1) {
    float mxa = rowmax32(a0, a1), mxb = rowmax32(b0, b1);
    mxa = fmaxf(mxa, __shfl_xor(mxa, 32)); mxb = fmaxf(mxb, __shfl_xor(mxb, 32));
    if (__any((mxa > A.m + THR_RAW) || (mxb > B.m + THR_RAW))) {
        const float mna = fmaxf(A.m, mxa), mnb = fmaxf(B.m, mxb);
        const float ala = __builtin_amdgcn_exp2f((A.m - (mna < -5e29f ? 0.f : mna)) * SC2), alb = __builtin_amdgcn_exp2f((B.m - (mnb < -5e29f ? 0.f : mnb)) * SC2);
        A.l *= ala; A.m = mna; B.l *= alb; B.m = mnb;
#pragma unroll
        for (int r = 0; r < 16; ++r) { A.o0[r] *= ala; B.o0[r] *= alb; A.o1[r] *= ala; B.o1[r] *= alb; }
    }
    const float msa = (A.m < -5e29f ? 0.f : A.m) * SC2, msb = (B.m < -5e29f ? 0.f : B.m) * SC2;
    float ra0 = 0.f, ra1 = 0.f, rb0 = 0.f, rb1 = 0.f;
#pragma unroll
    for (int r = 0; r < 16; ++r) {
        const float ea0 = __builtin_amdgcn_exp2f(a0[r] * SC2 - msa), eb0 = __builtin_amdgcn_exp2f(b0[r] * SC2 - msb);
        const float ea1 = __builtin_amdgcn_exp2f(a1[r] * SC2 - msa), eb1 = __builtin_amdgcn_exp2f(b1[r] * SC2 - msb);
        a0[r] = ea0; b0[r] = eb0; a1[r] = ea1; b1[r] = eb1; ra0 += ea0; rb0 += eb0; ra1 += ea1; rb1 += eb1;
    }
    A.l += ra0 + ra1; B.l += rb0 + rb1;
}
__device__ __forceinline__ float acc_inv(const Acc& A) { const float lt = A.l + __shfl_xor(A.l, 32); return 1.0f / fmaxf(lt, 1e-30f); }

__device__ __forceinline__ void apply_general(f32x16& p0, f32x16& p1, int dist0, const LAS float* tab, bool allow, int W) {
    const unsigned We = allow ? (unsigned)W : 0u;
#pragma unroll
    for (int r = 0; r < 16; ++r) {
        const int d_0 = dist0 - ((r & 3) + 8 * (r >> 2)), d_1 = d_0 - 32;
        const int i0 = ((unsigned)d_0 < We) ? min(d_0, 128) + 1 : 0, i1 = ((unsigned)d_1 < We) ? min(d_1, 128) + 1 : 0;
        p0[r] += tab[i0];
        p1[r] += tab[i1];
        if ((r & 3) == 3) __builtin_amdgcn_sched_barrier(0);
    }
}
__device__ __forceinline__ int rel_bucket(int n) {
    if (n < 16) return n;
    const float v = logf((float)n / 16.0f) / 2.0794415416798357f * 16.0f;
    int l = 16 + (int)v; return l < 31 ? l : 31;
}
__device__ __forceinline__ u32x4 tile_ld(const bf16_t* base, long ld, int row0, int rmin, int rmax, int tid) {
    int r = row0 + (tid >> 3); r = r < rmin ? rmin : (r > rmax ? rmax : r);
    return *(const u32x4*)(base + (long)r * ld + (tid & 7) * 8);
}
__device__ __forceinline__ void tile_st(LAS unsigned char* buf, u32x4 v, int tid) { *(LAS u32x4*)(buf + (tid >> 3) * ROWB + (tid & 7) * 16) = v; }
__device__ __forceinline__ void tile_stv(LAS unsigned char* buf, u32x4 v, int tid) { *(LAS u32x4*)(buf + (tid >> 3) * VROWB + (tid & 7) * 16) = v; }
__device__ __forceinline__ void load_q(bf16x8 (&qr)[4], const bf16_t* qrow, int hi) {
#pragma unroll
    for (int d0 = 0; d0 < 4; ++d0) qr[d0] = *(const bf16x8*)(qrow + d0 * 16 + hi * 8);
}
__device__ __forceinline__ void store_o(bf16_t* orow, const f32x16& o0, const f32x16& o1, int hi) {
#pragma unroll
    for (int g = 0; g < 4; ++g) {
        u32x2 w0, w1; w0.x = cvt_pk_bf16(o0[4 * g], o0[4 * g + 1]); w0.y = cvt_pk_bf16(o0[4 * g + 2], o0[4 * g + 3]);
        w1.x = cvt_pk_bf16(o1[4 * g], o1[4 * g + 1]); w1.y = cvt_pk_bf16(o1[4 * g + 2], o1[4 * g + 3]);
        *(u32x2*)(orow + 8 * g + 4 * hi) = w0; *(u32x2*)(orow + 32 + 8 * g + 4 * hi) = w1;
    }
}
__device__ __forceinline__ void add_prev_o(const bf16_t* orow, f32x16& o0, f32x16& o1, int hi) {
#pragma unroll
    for (int g = 0; g < 4; ++g) {
        const u32x2 w0 = *(const u32x2*)(orow + 8 * g + 4 * hi), w1 = *(const u32x2*)(orow + 32 + 8 * g + 4 * hi);
        o0[4 * g] += __uint_as_float(w0.x << 16); o0[4 * g + 1] += __uint_as_float(w0.x & 0xffff0000u); o0[4 * g + 2] += __uint_as_float(w0.y << 16); o0[4 * g + 3] += __uint_as_float(w0.y & 0xffff0000u);
        o1[4 * g] += __uint_as_float(w1.x << 16); o1[4 * g + 1] += __uint_as_float(w1.x & 0xffff0000u); o1[4 * g + 2] += __uint_as_float(w1.y << 16); o1[4 * g + 3] += __uint_as_float(w1.y & 0xffff0000u);
    }
}
__device__ __forceinline__ float sigmoidf(float x) { return 1.0f / (1.0f + __expf(-x)); }

constexpr int L_K0 = 0, L_K1 = TILEB, L_V0 = 2 * TILEB, L_V1 = 2 * TILEB + VTILEB, L_TAB = 2 * TILEB + 2 * VTILEB  , L_SIMP = 53248  , L_Q = 53248  , L_BKT = 131072  , L_MISC = 131072 + 1024  ;

__device__ __forceinline__ const LAS unsigned char* park_q(LAS unsigned char* lds, const bf16_t* q0, const bf16_t* q1, int wid, int lane, int hi) {
    LAS unsigned char* qp = lds + L_Q + wid * 8192 + lane * 16;
#pragma unroll
    for (int d0 = 0; d0 < 4; ++d0) { *(LAS bf16x8*)(qp + d0 * 1024) = *(const bf16x8*)(q0 + d0 * 16 + hi * 8); *(LAS bf16x8*)(qp + 4096 + d0 * 1024) = *(const bf16x8*)(q1 + d0 * 16 + hi * 8); }
    return qp;
}
__device__ __forceinline__ void fill_tab(LAS unsigned char* lds, const float* relb, int h0, int nh, int tid) {
    LAS float* tab = (LAS float*)(lds + L_TAB);
    const LAS int* bkt = (const LAS int*)(lds + L_BKT);
    for (int i = tid; i < nh * 130; i += NTHR) { const int hh = i / 130, d = i % 130; tab[hh * 132 + d] = d == 0 ? NEG : relb[bkt[d] * NH + h0 + hh] * 8.0f; }
}

template <int MODE>
struct TileInfo { bool want, near, allow; float cinit; };
template <int MODE>
__device__ __forceinline__ TileInfo<MODE> classify(int kt, int tw, unsigned selmask, int blkshift, int W, float b129) {
    TileInfo<MODE> ti; const int kbase = kt * 64;
    if (MODE == 0) { ti.want = true; ti.near = false; ti.allow = true; ti.cinit = 0.f; }
    else if (MODE == 1) { ti.allow = (selmask >> (kt >> blkshift)) & 1u; ti.want = (kbase <= tw + 31) && __any(ti.allow); ti.near = !(tw - (kbase + 63) >= 128); ti.cinit = ti.near ? 0.f : (ti.allow ? b129 : NEG); }
    else { ti.allow = true; ti.want = (kbase <= tw + 31) && (kbase + 63 >= tw - (W - 1)); ti.near = !((tw - (kbase + 63) >= 128) && (tw + 31 - kbase < W)); ti.cinit = ti.near ? 0.f : b129; }
    return ti;
}
template <int MODE, bool QREG>
__device__ __forceinline__ void seg2(Acc (&A)[2], LAS unsigned char* lds, const bf16_t* Kg, const bf16_t* Vg, long ld, int rmax, int lo, int hi_t,
                                     const LAS unsigned char* qp  , int t0  , int tw0, unsigned sel0, unsigned sel1, int blkshift, int W, const LAS float* tab, int tid) {
    const int lane = tid & 63, r32 = lane & 31, hi = lane >> 5;
    if (lo >= hi_t) return;
    {
        const u32x4 k0 = tile_ld(Kg, ld, lo * 64, 0, rmax, tid), v0 = tile_ld(Vg, ld, lo * 64, 0, rmax, tid);
        __syncthreads();
        tile_st(lds + L_K0, k0, tid); tile_stv(lds + L_V0, v0, tid);
        __syncthreads();
    }
    const float b129 = (MODE == 0) ? 0.f : tab[129];
    const int g1 = (lane >> 4) & 1, i16 = lane & 15, q_ = i16 >> 2, p_ = i16 & 3;
    bf16x8 qra[4], qrb[4];
    if (QREG) {
#pragma unroll
        for (int d0 = 0; d0 < 4; ++d0) { qra[d0] = *(const LAS bf16x8*)(qp + d0 * 1024); qrb[d0] = *(const LAS bf16x8*)(qp + 4096 + d0 * 1024); }
    }
    int cur = 0;
    for (int kt = lo; kt < hi_t; ++kt) {
        const bool more1 = kt + 1 < hi_t;
        u32x4 kreg, vreg;
        if (more1) { kreg = tile_ld(Kg, ld, (kt + 1) * 64, 0, rmax, tid); vreg = tile_ld(Vg, ld, (kt + 1) * 64, 0, rmax, tid); }
        TileInfo<MODE> ta = classify<MODE>(kt, tw0, sel0, blkshift, W, b129), tb = classify<MODE>(kt, tw0 + 32, sel1, blkshift, W, b129);
        if (ta.want || tb.want) {
            if (!ta.want) { ta.cinit = NEG; ta.near = false; }
            if (!tb.want) { tb.cinit = NEG; tb.near = false; }
            const LAS unsigned char* Kt = lds + (cur ? L_K1 : L_K0); const LAS unsigned char* Vt = lds + (cur ? L_V1 : L_V0);
            f32x16 a0, a1, b0, b1;
#pragma unroll
            for (int i = 0; i < 16; ++i) { a0[i] = ta.cinit; a1[i] = ta.cinit; b0[i] = tb.cinit; b1[i] = tb.cinit; }
            const LAS unsigned char* kb = Kt + r32 * ROWB + hi * 16;
#pragma unroll
            for (int d0 = 0; d0 < 4; ++d0) {
                const bf16x8 k0 = *(const LAS bf16x8*)(kb + d0 * 32);
                const bf16x8 k1 = *(const LAS bf16x8*)(kb + 32 * ROWB + d0 * 32);
                const bf16x8 qa = QREG ? qra[d0] : *(const LAS bf16x8*)(qp + d0 * 1024), qb_ = QREG ? qrb[d0] : *(const LAS bf16x8*)(qp + 4096 + d0 * 1024);
                a0 = __builtin_amdgcn_mfma_f32_32x32x16_bf16(k0, qa, a0, 0, 0, 0);
                b0 = __builtin_amdgcn_mfma_f32_32x32x16_bf16(k0, qb_, b0, 0, 0, 0);
                a1 = __builtin_amdgcn_mfma_f32_32x32x16_bf16(k1, qa, a1, 0, 0, 0);
                b1 = __builtin_amdgcn_mfma_f32_32x32x16_bf16(k1, qb_, b1, 0, 0, 0);
            }
            if (MODE != 0) {
                if (ta.near) apply_general(a0, a1, t0 - kt * 64 - 4 * hi, tab, ta.allow, W);
                if (tb.near) apply_general(b0, b1, t0 + 32 - kt * 64 - 4 * hi, tab, tb.allow, W);
            }
            sm_update2(A[0], A[1], a0, a1, b0, b1);
            const LAS unsigned char* vb = Vt + (4 * hi + q_) * VROWB + (16 * g1 + 4 * p_) * 2;
#pragma unroll
            for (int s = 0; s < 4; ++s) {
                const int bs = 8 * (s & 1);
                u32x4 wa, wb;
                if (s < 2) { wa.x = cvt_pk_bf16(a0[bs + 0], a0[bs + 1]); wa.y = cvt_pk_bf16(a0[bs + 2], a0[bs + 3]); wa.z = cvt_pk_bf16(a0[bs + 4], a0[bs + 5]); wa.w = cvt_pk_bf16(a0[bs + 6], a0[bs + 7]);
                             wb.x = cvt_pk_bf16(b0[bs + 0], b0[bs + 1]); wb.y = cvt_pk_bf16(b0[bs + 2], b0[bs + 3]); wb.z = cvt_pk_bf16(b0[bs + 4], b0[bs + 5]); wb.w = cvt_pk_bf16(b0[bs + 6], b0[bs + 7]); }
                else       { wa.x = cvt_pk_bf16(a1[bs + 0], a1[bs + 1]); wa.y = cvt_pk_bf16(a1[bs + 2], a1[bs + 3]); wa.z = cvt_pk_bf16(a1[bs + 4], a1[bs + 5]); wa.w = cvt_pk_bf16(a1[bs + 6], a1[bs + 7]);
                             wb.x = cvt_pk_bf16(b1[bs + 0], b1[bs + 1]); wb.y = cvt_pk_bf16(b1[bs + 2], b1[bs + 3]); wb.z = cvt_pk_bf16(b1[bs + 4], b1[bs + 5]); wb.w = cvt_pk_bf16(b1[bs + 6], b1[bs + 7]); }
                const bf16x8 pfa = __builtin_bit_cast(bf16x8, wa), pfb = __builtin_bit_cast(bf16x8, wb);
#pragma unroll
                for (int dh = 0; dh < 2; ++dh) {
                    const s16x4 lo4 = vtr(vb + (16 * s) * VROWB + dh * 64);
                    const s16x4 h4 = vtr(vb + (16 * s + 8) * VROWB + dh * 64);
                    const bf16x8 vf = (bf16x8){lo4[0], lo4[1], lo4[2], lo4[3], h4[0], h4[1], h4[2], h4[3]};
                    if (dh == 0) { A[0].o0 = __builtin_amdgcn_mfma_f32_32x32x16_bf16(vf, pfa, A[0].o0, 0, 0, 0); A[1].o0 = __builtin_amdgcn_mfma_f32_32x32x16_bf16(vf, pfb, A[1].o0, 0, 0, 0); }
                    else         { A[0].o1 = __builtin_amdgcn_mfma_f32_32x32x16_bf16(vf, pfa, A[0].o1, 0, 0, 0); A[1].o1 = __builtin_amdgcn_mfma_f32_32x32x16_bf16(vf, pfb, A[1].o1, 0, 0, 0); }
                }
            }
        }
        if (more1) { tile_st(lds + (cur ? L_K0 : L_K1), kreg, tid); tile_stv(lds + (cur ? L_V0 : L_V1), vreg, tid); }
        __syncthreads();
        cur ^= 1;
    }
}
}

struct Ctx { int tid, lane, wid, gtid, gsz, gw, ngw; };

template <int MAP>
__device__ __forceinline__ void xpose_w(const Ctx& c, const float* W, int K, int N, bf16_t* WT, int Ndst, int dst_off = 0) {
    const int nk = K >> 6; const long total = (long)Ndst * nk;
    for (long i = c.gtid; i < total; i += c.gsz) {
        const int n = (int)(i % Ndst), kc = (int)(i / Ndst);
        int src = n;
        if (MAP == 1) { if (n >= 1152 && n < 1408) src = 1188 + (n - 1152); else if (n >= 1408 && n < 1444) src = 1152 + (n - 1408); else if (n >= 1444) src = -1; }
        else if (MAP == 2) { const int tl = n >> 8, wi = n & 255; src = wi < 128 ? tl * 128 + wi : 2816 + tl * 128 + (wi - 128); }
        else if (n >= N) src = -1;
        bf16_t* dst = WT + (size_t)(dst_off + n) * K + kc * 64;
        if (src < 0) {
#pragma unroll
            for (int q = 0; q < 8; ++q) *(u32x4*)(dst + q * 8) = (u32x4){0u, 0u, 0u, 0u};
        } else {
            const float* s = W + (size_t)(kc * 64) * N + src;
            float v[64];
#pragma unroll
            for (int k = 0; k < 64; ++k) v[k] = s[(size_t)k * N];
#pragma unroll
            for (int q = 0; q < 8; ++q) {
                u32x4 w; w.x = cvt_pk_bf16(v[8 * q], v[8 * q + 1]); w.y = cvt_pk_bf16(v[8 * q + 2], v[8 * q + 3]); w.z = cvt_pk_bf16(v[8 * q + 4], v[8 * q + 5]); w.w = cvt_pk_bf16(v[8 * q + 6], v[8 * q + 7]);
                *(u32x4*)(dst + q * 8) = w;
            }
        }
    }
}
__device__ __forceinline__ void cvt_rows(const Ctx& c, const float* X, bf16_t* XB, long nelem) {
    const long n8 = nelem >> 3;
    for (long i0 = c.gtid; i0 < n8; i0 += 4l * c.gsz) {
        f32x4 a[4], b[4];
#pragma unroll
        for (int u = 0; u < 4; ++u) { const long i = i0 + (long)u * c.gsz; if (i < n8) { a[u] = __builtin_nontemporal_load((const f32x4*)(X + i * 8)); b[u] = __builtin_nontemporal_load((const f32x4*)(X + i * 8 + 4)); } }
#pragma unroll
        for (int u = 0; u < 4; ++u) { const long i = i0 + (long)u * c.gsz; if (i < n8) {
            u32x4 w; w.x = cvt_pk_bf16(a[u][0], a[u][1]); w.y = cvt_pk_bf16(a[u][2], a[u][3]); w.z = cvt_pk_bf16(b[u][0], b[u][1]); w.w = cvt_pk_bf16(b[u][2], b[u][3]);
            *(u32x4*)(XB + i * 8) = w; } }
    }
}
__device__ __forceinline__ void prep_late(const Params& p, const Ctx& c) {
    unsigned char* ws = p.ws;
    xpose_w<0>(c, p.in[I_AWOUT], DM, DM, (bf16_t*)(ws + WS_WAOUT), DM);
    xpose_w<0>(c, p.in[I_SWKV], DM, 1536, (bf16_t*)(ws + WS_WSKV), 1536);
    xpose_w<0>(c, p.in[I_BWIN], DM, DM, (bf16_t*)(ws + WS_WBIN), DM);
    xpose_w<0>(c, p.in[I_BWOUT], DM, DM, (bf16_t*)(ws + WS_WBOUT), DM);
    for (int l = 0; l < 2; ++l) {
        xpose_w<2>(c, p.in[I_FWIN] + (size_t)l * DM * 2 * DFF, DM, 2 * DFF, (bf16_t*)(ws + WS_WFIN) + (size_t)l * 2 * DFF * DM, 2 * DFF);
        xpose_w<0>(c, p.in[I_FWOUT] + (size_t)l * DFF * DM, DFF, DM, (bf16_t*)(ws + WS_WFOUT) + (size_t)l * DM * DFF, DM);
    }
}
constexpr int LATE_FIRST_WG = 160;
__device__ __forceinline__ void phase_prep(const Params& p, const Ctx& c) {
    unsigned char* ws = p.ws;
    xpose_w<1>(c, p.in[I_AWIN], DM, AIN, (bf16_t*)(ws + WS_WAIN), AINP);
    xpose_w<0>(c, p.in[I_AWMKV], DM, 512, (bf16_t*)(ws + WS_WMKV), 512, 0);
    xpose_w<0>(c, p.in[I_BWMKV], DM, 512, (bf16_t*)(ws + WS_WMKV), 512, 512);
    xpose_w<0>(c, p.in[I_W1K], 2048, 256, (bf16_t*)(ws + WS_WC1K), 256);
    xpose_w<0>(c, p.in[I_W1V], 2048, 256, (bf16_t*)(ws + WS_WC1V), 256);
    if ((int)gridDim.x < LATE_FIRST_WG + 32) prep_late(p, c);
    cvt_rows(c, p.in[I_X], (bf16_t*)(ws + WS_XB), (long)NTOK * DM);
    cvt_rows(c, p.in[I_MEM], (bf16_t*)(ws + WS_MEMB), (long)BATCH * NMEM * DM);
    for (int o = c.gw; o < 512; o += c.ngw) {
        const int which = o >> 8, j = o & 255;
        const float* pe = p.in[which ? I_PEV : I_PEK]; const float* w1 = p.in[which ? I_W1V : I_W1K];
        float s = 0.f;
#pragma unroll 8
        for (int k = c.lane; k < 2048; k += 64) s += pe[k] * w1[(size_t)k * 256 + j];
#pragma unroll
        for (int sh = 1; sh < 64; sh <<= 1) s += __shfl_xor(s, sh);
        if (c.lane == 0) ((float*)(ws + WS_CBIAS))[which * 256 + j] = s;
    }
}
__device__ __forceinline__ void phase_cmp2(const Params& p, const Ctx& c) {
    unsigned char* ws = p.ws;
    for (int i = c.gtid; i < 2 * 4096 * 64; i += c.gsz) {
        const int which = i >> 18, m = (i >> 6) & 4095, d = i & 63;
        const float* hid = (const float*)(ws + WS_CMPH) + ((size_t)which * 4096 + m) * 256; const float* w2 = p.in[which ? I_W2V : I_W2K];
        float s = 0.f;
#pragma unroll 8
        for (int j = 0; j < 256; ++j) s += hid[j] * w2[j * 64 + d];
        if ((m & 127) == 127) s = 0.f;
        unsigned u = __float_as_uint(s); u = (u + 0x7fffu + ((u >> 16) & 1u)) >> 16;
        ((bf16_t*)(ws + (which ? WS_VCMP : WS_KCMP)))[(size_t)m * 64 + d] = (bf16_t)u;
    }
}
__device__ __forceinline__ void phase_ln(const Ctx& c, const float* y, const float* g, const float* bta, float* xf, bf16_t* xb) {
    for (int row0 = c.gw; row0 < NTOK; row0 += 2 * c.ngw) {
        const int row1 = row0 + c.ngw; const bool has1 = row1 < NTOK;
        const float* y0 = y + (size_t)row0 * DM + c.lane * 4; const float* y1 = y + (size_t)(has1 ? row1 : row0) * DM + c.lane * 4;
        f32x4 v0[4], v1[4]; float s0 = 0.f, s1 = 0.f;
#pragma unroll
        for (int j = 0; j < 4; ++j) { v0[j] = *(const f32x4*)(y0 + 256 * j); v1[j] = *(const f32x4*)(y1 + 256 * j); }
#pragma unroll
        for (int j = 0; j < 4; ++j) { s0 += (v0[j][0] + v0[j][1]) + (v0[j][2] + v0[j][3]); s1 += (v1[j][0] + v1[j][1]) + (v1[j][2] + v1[j][3]); }
#pragma unroll
        for (int o = 1; o < 64; o <<= 1) { s0 += __shfl_xor(s0, o); s1 += __shfl_xor(s1, o); }
        const float m0 = s0 * (1.0f / DM), m1 = s1 * (1.0f / DM); float q0 = 0.f, q1 = 0.f;
#pragma unroll
        for (int j = 0; j < 4; ++j) { v0[j] = v0[j] - m0; v1[j] = v1[j] - m1;
            q0 += (v0[j][0] * v0[j][0] + v0[j][1] * v0[j][1]) + (v0[j][2] * v0[j][2] + v0[j][3] * v0[j][3]);
            q1 += (v1[j][0] * v1[j][0] + v1[j][1] * v1[j][1]) + (v1[j][2] * v1[j][2] + v1[j][3] * v1[j][3]); }
#pragma unroll
        for (int o = 1; o < 64; o <<= 1) { q0 += __shfl_xor(q0, o); q1 += __shfl_xor(q1, o); }
        const float r0 = 1.0f / sqrtf(q0 * (1.0f / DM) + LN_EPS), r1 = 1.0f / sqrtf(q1 * (1.0f / DM) + LN_EPS);
#pragma unroll
        for (int j = 0; j < 4; ++j) {
            const f32x4 gg = *(const f32x4*)(g + c.lane * 4 + 256 * j), bb = *(const f32x4*)(bta + c.lane * 4 + 256 * j);
            const f32x4 o0 = v0[j] * r0 * gg + bb, o1 = v1[j] * r1 * gg + bb;
            if (xf) { *(f32x4*)(xf + (size_t)row0 * DM + c.lane * 4 + 256 * j) = o0; if (has1) *(f32x4*)(xf + (size_t)row1 * DM + c.lane * 4 + 256 * j) = o1; }
            if (xb) { u32x2 w; w.x = cvt_pk_bf16(o0[0], o0[1]); w.y = cvt_pk_bf16(o0[2], o0[3]); *(u32x2*)(xb + (size_t)row0 * DM + c.lane * 4 + 256 * j) = w;
                if (has1) { u32x2 w1; w1.x = cvt_pk_bf16(o1[0], o1[1]); w1.y = cvt_pk_bf16(o1[2], o1[3]); *(u32x2*)(xb + (size_t)row1 * DM + c.lane * 4 + 256 * j) = w1; } }
        }
    }
}
__device__ __forceinline__ void unpack8(const u32x4 w, float (&f)[8]) {
    f[0] = __uint_as_float(w.x << 16); f[1] = __uint_as_float(w.x & 0xffff0000u); f[2] = __uint_as_float(w.y << 16); f[3] = __uint_as_float(w.y & 0xffff0000u);
    f[4] = __uint_as_float(w.z << 16); f[5] = __uint_as_float(w.z & 0xffff0000u); f[6] = __uint_as_float(w.w << 16); f[7] = __uint_as_float(w.w & 0xffff0000u);
}
__device__ __forceinline__ void ffn_fixup(const Ctx& c, unsigned char* big, const float* cw, const float* cbias, int pm) {
    const float* TAILA = (const float*)(big + BIG_TAILA); const float* HEADA = (const float*)(big + BIG_HEADA); const float* HEADB = (const float*)(big + BIG_HEADB); bf16_t* H = (bf16_t*)(big + BIG_H);
    constexpr int NCH = DFF / 8;
    for (int it = c.tid; it < 4 * 2 * NCH; it += NTHR) {
        const int ch = it % NCH, gi = it / NCH, i = gi & 1, G = pm * 4 + (gi >> 1), col = ch * 8;
        const bool first = ((G * 64) & (SEQ - 1)) == 0;
        float p0[8], p1[8], a0[8], a1[8], b[8], h[8];
#pragma unroll
        for (int j = 0; j < 8; ++j) { p0[j] = 0.f; p1[j] = 0.f; }
        if (!first) {
            const float* t0 = TAILA + ((size_t)(G - 1) * 2) * DFF + col;
#pragma unroll
            for (int j = 0; j < 8; ++j) { p0[j] = t0[j]; p1[j] = t0[DFF + j]; }
        }
        const float* ha = HEADA + ((size_t)G * 2) * DFF + col; const float* hb = HEADB + ((size_t)G * 2 + i) * DFF + col;
#pragma unroll
        for (int j = 0; j < 8; ++j) { a0[j] = ha[j]; a1[j] = ha[DFF + j]; b[j] = hb[j]; }
#pragma unroll
        for (int j = 0; j < 8; ++j) {
            const float am2 = i ? p1[j] : p0[j], am1 = i ? a0[j] : p1[j], a = i ? a1[j] : a0[j];
            const float pre = cw[col + j] * am2 + cw[DFF + col + j] * am1 + cw[2 * DFF + col + j] * a + cbias[col + j];
            h[j] = gelu_tanh(pre) * b[j];
        }
        u32x4 w; w.x = cvt_pk_bf16(h[0], h[1]); w.y = cvt_pk_bf16(h[2], h[3]); w.z = cvt_pk_bf16(h[4], h[5]); w.w = cvt_pk_bf16(h[6], h[7]);
        *(u32x4*)(H + (size_t)(G * 64 + i) * DFF + col) = w;
    }
}
__device__ __forceinline__ void phase_kmean(const Ctx& c, const bf16_t* KV, float* KM) {
    for (int it = c.gw; it < BATCH * 8 * 12; it += c.ngw) {
        const int cg_ = it % 12, bn = it / 12, ch = c.lane & 7, rs = c.lane >> 3;
        float s[8];
#pragma unroll
        for (int j = 0; j < 8; ++j) s[j] = 0.f;
        const bf16_t* src = KV + (size_t)bn * 256 * KVP + cg_ * 64 + ch * 8;
#pragma unroll 4
        for (int r = rs; r < 256; r += 8) { float v[8]; unpack8(*(const u32x4*)(src + (size_t)r * KVP), v);
#pragma unroll
            for (int j = 0; j < 8; ++j) s[j] += v[j]; }
#pragma unroll
        for (int j = 0; j < 8; ++j) { s[j] += __shfl_xor(s[j], 8); s[j] += __shfl_xor(s[j], 16); s[j] += __shfl_xor(s[j], 32); }
        if (rs == 0) {
#pragma unroll
            for (int j = 0; j < 8; ++j) KM[(size_t)bn * 768 + cg_ * 64 + ch * 8 + j] = s[j] * (1.0f / 256.0f);
        }
    }
}

__device__ __forceinline__ void nsa1_unit(const Params& p, LAS unsigned char* lds, int b, int qb) {
    using namespace att;
    int tid_ = threadIdx.x; asm volatile("" : "+v"(tid_));
    const int tid = tid_, lane = tid & 63, r32 = lane & 31, hi = lane >> 5, wid = tid >> 6;
    unsigned char* ws = p.ws;
    const bf16_t* P = (const bf16_t*)(ws + WS_BIG + BIG_P); bf16_t* O = (bf16_t*)(ws + WS_BIG + BIG_O0);
    const bf16_t* KC = (const bf16_t*)(ws + WS_KCMP) + (size_t)b * 128 * 64; const bf16_t* VC = (const bf16_t*)(ws + WS_VCMP) + (size_t)b * 128 * 64;
    __syncthreads();
    tile_st(lds + L_K0, tile_ld(KC, 64, 0, 0, 127, tid), tid); tile_st(lds + L_K1, tile_ld(KC, 64, 64, 0, 127, tid), tid);
    tile_stv(lds + L_V0, tile_ld(VC, 64, 0, 0, 127, tid), tid); tile_stv(lds + L_V1, tile_ld(VC, 64, 64, 0, 127, tid), tid);
    fill_tab(lds, p.in[I_RELB], 0, NH, tid);
    __syncthreads();
    const int t = qb * 256 + wid * 32 + r32; const size_t row = (size_t)b * SEQ + t;
    LAS float* simp = (LAS float*)(lds + L_SIMP) + (wid * 32 + r32) * 33;
#pragma unroll
    for (int i = 0; i < 16; ++i) simp[2 * i + hi] = 0.f;
#pragma nounroll
    for (int h = 0; h < NH; ++h) {
        bf16x8 qr[4]; load_q(qr, P + row * AINP + P_Q + h * 64, hi);
        f32x16 pp[4];
        qk_tile(pp[0], pp[1], lds + L_K0, qr, r32, hi); qk_tile(pp[2], pp[3], lds + L_K1, qr, r32, hi);
        const LAS float* tab = (const LAS float*)(lds + L_TAB) + h * 132;
        float mx = NEG;
        const int tws = __builtin_amdgcn_readfirstlane(t - r32);
#pragma unroll
        for (int a = 0; a < 4; ++a) {
            if (tws >= 512 * a + 655) { const float bb = tab[129];
#pragma unroll
                for (int r = 0; r < 16; ++r) { const float s = pp[a][r] + bb; pp[a][r] = s; mx = fmaxf(mx, s); } }
            else if (tws < 512 * a) {
#pragma unroll
                for (int r = 0; r < 16; ++r) pp[a][r] = NEG; }
            else {
#pragma unroll
                for (int r = 0; r < 16; ++r) { const int n = (r & 3) + 8 * (r >> 2) + 4 * hi + 32 * a; const int d = t - 30 - 16 * n;
                    const float s = pp[a][r] + tab[min(max(d, 0), 129)]; pp[a][r] = s; mx = fmaxf(mx, s); } }
        }
        mx = fmaxf(mx, __shfl_xor(mx, 32));
        const bool dead = mx < -5e29f;
        const float msc = (dead ? 0.f : mx) * SC2;
        float sum = 0.f;
#pragma unroll
        for (int a = 0; a < 4; ++a)
#pragma unroll
            for (int r = 0; r < 16; ++r) { const float e = __builtin_amdgcn_exp2f(pp[a][r] * SC2 - msc); pp[a][r] = e; sum += e; }
        sum += __shfl_xor(sum, 32);
        const float inv = dead ? 0.f : 1.0f / fmaxf(sum, 1e-30f);
#pragma unroll
        for (int a = 0; a < 4; ++a)
#pragma unroll
            for (int r = 0; r < 16; ++r) pp[a][r] *= inv;
#pragma unroll
        for (int a = 0; a < 4; ++a)
#pragma unroll
            for (int g = 0; g < 4; ++g) {
                const float gs = (pp[a][4 * g] + pp[a][4 * g + 1]) + (pp[a][4 * g + 2] + pp[a][4 * g + 3]);
                const float lastv = pp[a][4 * g + 3];
                const float shifted = (g >= 1) ? pp[a][4 * (g - 1) + 3] : ((a >= 1) ? pp[(a >= 1) ? a - 1 : 0][15] : 0.f);
                const float snd = hi ? shifted : lastv;
                const float rcv = __shfl_xor(snd, 32);
                simp[8 * a + 2 * g + hi] += gs + rcv;
            }
        f32x16 o0 = zero16(), o1 = zero16();
        pv_tile(o0, o1, lds + L_V0, pp[0], pp[1], lane); pv_tile(o0, o1, lds + L_V1, pp[2], pp[3], lane);
        const float gate = sigmoidf(bf2f(P[row * AINP + P_G + h * 3 + 0]));
#pragma unroll
        for (int r = 0; r < 16; ++r) { o0[r] *= gate; o1[r] *= gate; }
        store_o(O + row * DM + h * 64, o0, o1, hi);
    }
    __syncthreads();
    const int cur = t >> 6; unsigned mask;
    if (cur < 16) mask = (2u << cur) - 1u;
    else {
        mask = 1u | (1u << cur) | (1u << (cur - 1));
        unsigned cand = ((1u << (cur - 1)) - 1u) & ~1u;
#pragma nounroll
        for (int k = 0; k < 13; ++k) {
            float best = -3e38f; int bi = 0;
#pragma nounroll
            for (int s = 1; s <= 29; ++s) { const float v = simp[s]; const bool take = ((cand >> s) & 1u) && (v > best); best = take ? v : best; bi = take ? s : bi; }
            mask |= 1u << bi; cand &= ~(1u << bi);
        }
    }
    if (hi == 0) ((unsigned*)(ws + WS_SEL))[row] = mask;
}
__device__ __forceinline__ void nsa2_unit(const Params& p, LAS unsigned char* lds, int b, int h0, int qb) {
    using namespace att;
    int tid_ = threadIdx.x; asm volatile("" : "+v"(tid_));
    const int tid = tid_, lane = tid & 63, r32 = lane & 31, hi = lane >> 5, wid = tid >> 6;
    unsigned char* ws = p.ws;
    const bf16_t* P = (const bf16_t*)(ws + WS_BIG + BIG_P); bf16_t* O = (bf16_t*)(ws + WS_BIG + BIG_O0);
    __syncthreads();
    fill_tab(lds, p.in[I_RELB], h0, 2, tid);
    const int h = h0 + (wid >> 2);
    const LAS float* tab = (const LAS float*)(lds + L_TAB) + (wid >> 2) * 132;
    const int tw0 = qb * 256 + (wid & 3) * 64, t0 = tw0 + r32; const size_t row0 = (size_t)b * SEQ + t0, row1 = row0 + 32;
    const LAS unsigned char* qp = park_q(lds, P + row0 * AINP + P_Q + h * 64, P + row1 * AINP + P_Q + h * 64, wid, lane, hi);
    const unsigned sel0 = ((const unsigned*)(ws + WS_SEL))[row0], sel1 = ((const unsigned*)(ws + WS_SEL))[row1];
    const bf16_t* Pb = P + (size_t)b * SEQ * AINP;
    Acc A[2]; acc_init(A[0]); acc_init(A[1]);
    seg2<1, false>(A, lds, Pb + P_KS, Pb + P_VS, AINP, SEQ - 1, 0, qb * 4 + 4, qp, t0, tw0, sel0, sel1, 0, 1 << 30, tab, tid);
#pragma unroll
    for (int s = 0; s < 2; ++s) {
        const size_t row = s ? row1 : row0;
        const float gs = sigmoidf(bf2f(P[row * AINP + P_G + h * 3 + 1])) * acc_inv(A[s]);
#pragma unroll
        for (int r = 0; r < 16; ++r) { A[s].o0[r] *= gs; A[s].o1[r] *= gs; }
        bf16_t* orow = O + row * DM + h * 64;
        add_prev_o(orow, A[s].o0, A[s].o1, hi); store_o(orow, A[s].o0, A[s].o1, hi);
        acc_init(A[s]);
    }
    const int wlo = qb * 4 - 8 < 0 ? 0 : qb * 4 - 8;
    seg2<2, false>(A, lds, Pb + P_KW, Pb + P_VW, AINP, SEQ - 1, wlo, qb * 4 + 4, qp, t0, tw0, 0u, 0u, 0, 512, tab, tid);
#pragma unroll
    for (int s = 0; s < 2; ++s) {
        const size_t row = s ? row1 : row0;
        const float gw = sigmoidf(bf2f(P[row * AINP + P_G + h * 3 + 2])) * acc_inv(A[s]);
#pragma unroll
        for (int r = 0; r < 16; ++r) { A[s].o0[r] *= gw; A[s].o1[r] *= gw; }
        bf16_t* orow = O + row * DM + h * 64;
        add_prev_o(orow, A[s].o0, A[s].o1, hi); store_o(orow, A[s].o0, A[s].o1, hi);
    }
}
__device__ __forceinline__ unsigned moba_select(const float* KM, const bf16x8 (&qr)[4], int b, int h, int qb, int hi) {
    float gt[7];
#pragma unroll
    for (int n = 0; n < 7; ++n) {
        float s = 0.f;
        if (n < qb) {
            const float* km = KM + ((size_t)(b * 8 + n) * NH + h) * 64 + hi * 8;
#pragma unroll
            for (int d0 = 0; d0 < 4; ++d0) { const f32x4 k0 = *(const f32x4*)(km + d0 * 16), k1 = *(const f32x4*)(km + d0 * 16 + 4);
                s += bf2f((unsigned short)qr[d0][0]) * k0[0] + bf2f((unsigned short)qr[d0][1]) * k0[1] + bf2f((unsigned short)qr[d0][2]) * k0[2] + bf2f((unsigned short)qr[d0][3]) * k0[3]
                   + bf2f((unsigned short)qr[d0][4]) * k1[0] + bf2f((unsigned short)qr[d0][5]) * k1[1] + bf2f((unsigned short)qr[d0][6]) * k1[2] + bf2f((unsigned short)qr[d0][7]) * k1[3]; }
        }
        s += __shfl_xor(s, 32);
        gt[n] = s;
    }
    unsigned sel = 1u << qb, cand = (1u << qb) - 1u;
#pragma nounroll
    for (int k = 0; k < 3; ++k) {
        float best = -3e38f; int bi = -1;
#pragma unroll
        for (int n = 0; n < 7; ++n) { const bool take = ((cand >> n) & 1u) && (gt[n] > best); best = take ? gt[n] : best; bi = take ? n : bi; }
        if (bi >= 0) { sel |= 1u << bi; cand &= ~(1u << bi); }
    }
    return sel;
}
__device__ __forceinline__ void moba_unit(const Params& p, LAS unsigned char* lds, int b, int h, int qp) {
    using namespace att;
    int tid_ = threadIdx.x; asm volatile("" : "+v"(tid_));
    const int tid = tid_, lane = tid & 63, r32 = lane & 31, hi = lane >> 5, wid = tid >> 6;
    unsigned char* ws = p.ws;
    const bf16_t* KV = (const bf16_t*)(ws + WS_BIG + BIG_KV); const bf16_t* Q = KV + KV_Q; bf16_t* O = (bf16_t*)(ws + WS_BIG + BIG_O1);
    const float* KM = (const float*)(ws + WS_KMEAN);
    __syncthreads();
    fill_tab(lds, p.in[I_RELB], h, 1, tid);
    const LAS float* tab = (const LAS float*)(lds + L_TAB);
    const int qb = 2 * qp + (wid >> 2);
    const int tw0 = qb * 256 + (wid & 3) * 64, t0 = tw0 + r32; const size_t row0 = (size_t)b * SEQ + t0, row1 = row0 + 32;
    unsigned sel0, sel1;
    { bf16x8 qr[4]; load_q(qr, Q + row0 * KVP + h * 64, hi); sel0 = moba_select(KM, qr, b, h, qb, hi); }
    { bf16x8 qr[4]; load_q(qr, Q + row1 * KVP + h * 64, hi); sel1 = moba_select(KM, qr, b, h, qb, hi); }
    const LAS unsigned char* qp_ = park_q(lds, Q + row0 * KVP + h * 64, Q + row1 * KVP + h * 64, wid, lane, hi);
    const bf16_t* Kb = KV + (size_t)b * SEQ * KVP + h * 64;
    Acc A[2]; acc_init(A[0]); acc_init(A[1]);
    seg2<1, true>(A, lds, Kb, Kb + MAINW, KVP, SEQ - 1, 0, qp * 8 + 8, qp_, t0, tw0, sel0, sel1, 2, 1 << 30, tab, tid);
#pragma unroll
    for (int s = 0; s < 2; ++s) {
        const float inv = acc_inv(A[s]);
#pragma unroll
        for (int r = 0; r < 16; ++r) { A[s].o0[r] *= inv; A[s].o1[r] *= inv; }
        store_o(O + (s ? row1 : row0) * DM + h * 64, A[s].o0, A[s].o1, hi);
    }
}
__device__ __forceinline__ void mem_unit(const Params& p, LAS unsigned char* lds, const bf16_t* Q, int ldq, int qcol, bf16_t* O, int kvcol, int b, int mh, int qq) {
    using namespace att;
    int tid_ = threadIdx.x; asm volatile("" : "+v"(tid_));
    const int tid = tid_, lane = tid & 63, r32 = lane & 31, hi = lane >> 5, wid = tid >> 6;
    const bf16_t* MKV = (const bf16_t*)(p.ws + WS_MKV) + (size_t)b * NMEM * 1024 + kvcol + mh * 64;
    const int tw0 = qq * 512 + wid * 64, t0 = tw0 + r32; const size_t row0 = (size_t)b * SEQ + t0, row1 = row0 + 32;
    __syncthreads();
    const LAS unsigned char* qp = park_q(lds, Q + row0 * ldq + qcol + mh * 64, Q + row1 * ldq + qcol + mh * 64, wid, lane, hi);
    Acc A[2]; acc_init(A[0]); acc_init(A[1]);
    seg2<0, true>(A, lds, MKV, MKV + 256, 1024, NMEM - 1, 0, 4, qp, t0, tw0, 0u, 0u, 0, 1 << 30, (const LAS float*)(lds + L_TAB), tid);
#pragma unroll
    for (int s = 0; s < 2; ++s) {
        const float inv = acc_inv(A[s]);
#pragma unroll
        for (int r = 0; r < 16; ++r) { A[s].o0[r] *= inv; A[s].o1[r] *= inv; }
        store_o(O + (s ? row1 : row0) * DM + MAINW + mh * 64, A[s].o0, A[s].o1, hi);
    }
}

#define XB_TMO      128
#define XB_XCNT(j)  (256  + 64 * (j))
#define XB_XSUB(j)  (1280 + 64 * (j))
#define XB_XGEN(j)  (2304 + 64 * (j))
#define XB_TOP      3328
#define XB_TOPGEN   3392
#define XCD_BAR_WORDS 3456
#define XB_SPIN_CAP (1u << 18)
__device__ __forceinline__ unsigned xb_ld(unsigned* p)              { return __hip_atomic_load(p, __ATOMIC_RELAXED, __HIP_MEMORY_SCOPE_AGENT); }
__device__ __forceinline__ unsigned xb_add(unsigned* p, unsigned v) { return __hip_atomic_fetch_add(p, v, __ATOMIC_RELAXED, __HIP_MEMORY_SCOPE_AGENT); }
__device__ __forceinline__ unsigned xb_xcc_id() { return (unsigned)__builtin_amdgcn_s_getreg((3 << 11) | 20) & 0xFu; }
#define XB_SPIN(cond, bar) do { unsigned _sp = 0; while (cond) { __builtin_amdgcn_s_sleep(1); \
    if ((++_sp & 255u) == 0u) { if (xb_ld(&(bar)[XB_TMO])) break; if (_sp > XB_SPIN_CAP) { atomicAdd(&(bar)[XB_TMO], 1u); break; } } } } while (0)
struct XcdBarrier { unsigned* bar; unsigned x; volatile LAS unsigned* st; };
__device__ __forceinline__ XcdBarrier xcd_barrier_post(unsigned* bar, volatile LAS unsigned* st) {
    XcdBarrier b; b.bar = bar; b.x = xb_xcc_id(); b.st = st;
    if (threadIdx.x == 0) (void)xb_add(&bar[XB_XCNT(b.x)], 1u);
    return b;
}
__device__ __forceinline__ void xcd_barrier_complete(unsigned* bar, unsigned x, unsigned& nloc, unsigned& nx) {
    const unsigned G = gridDim.x * gridDim.y * gridDim.z;
    unsigned sum, cnt, mine, sp = 0u;
    for (;;) {
        sum = 0u; cnt = 0u; mine = 0u;
#pragma unroll
        for (unsigned j = 0; j < 16; ++j) { const unsigned c = xb_ld(&bar[XB_XCNT(j)]); sum += c; cnt += (c > 0u) ? 1u : 0u; mine = (j == x) ? c : mine; }
        if (sum == G) break;
        __builtin_amdgcn_s_sleep(1);
        if ((++sp & 255u) == 0u) { if (xb_ld(&bar[XB_TMO])) break; if (sp > XB_SPIN_CAP) { atomicAdd(&bar[XB_TMO], 1u); break; } }
    }
    nloc = mine > 0u ? mine : 1u; nx = cnt > 0u ? cnt : 1u;
}
__device__ __forceinline__ void xcd_barrier(const XcdBarrier& b) {
    asm volatile("s_waitcnt vmcnt(0)" ::: "memory");
    __syncthreads();
    if (threadIdx.x == 0) {
        unsigned* bar = b.bar;
        __builtin_amdgcn_s_waitcnt(0);
        unsigned nloc = b.st[0], nx = b.st[1];
        if (nloc == 0u) { xcd_barrier_complete(bar, b.x, nloc, nx); b.st[0] = nloc; b.st[1] = nx; }
        const unsigned old = xb_add(&bar[XB_XSUB(b.x)], 1u);
        const unsigned gen = old / nloc;
        if (old + 1u == (gen + 1u) * nloc) {
            __builtin_amdgcn_fence(__ATOMIC_RELEASE, "agent");
            asm volatile("s_waitcnt vmcnt(0)" ::: "memory");
            const unsigned og = xb_add(&bar[XB_TOP], 1u);
            const unsigned tg = og / nx;
            if (og + 1u == (tg + 1u) * nx) xb_add(&bar[XB_TOPGEN], 1u);
            else XB_SPIN(xb_ld(&bar[XB_TOPGEN]) == tg, bar);
            __builtin_amdgcn_fence(__ATOMIC_ACQUIRE, "agent");
            xb_add(&bar[XB_XGEN(b.x)], 1u);
            asm volatile("s_waitcnt vmcnt(0)" ::: "memory");
        } else {
            XB_SPIN(xb_ld(&bar[XB_XGEN(b.x)]) == gen, bar);
            __builtin_amdgcn_fence(__ATOMIC_ACQUIRE, "agent");
            asm volatile("s_waitcnt vmcnt(0)" ::: "memory");
        }
    }
    __syncthreads();
}

enum { PH_PREP = 0, PH_A_GEMM, PH_A_CMP1, PH_A_CMP2, PH_A_NSA1, PH_A_NSA2, PH_A_OUT, PH_A_LN1, PH_A_F0, PH_A_FIX, PH_A_F1, PH_A_LN2,
       PH_B_GEMM, PH_B_KMEAN, PH_B_ATT, PH_B_OUT, PH_B_LN1, PH_B_F0, PH_B_FIX, PH_B_F1, PH_B_LN2, PH_COUNT };

struct GemmJob { pg8::Gemm g; int epi; void* O; const float* aux; const float* aux2; int ldc; int coff; };
__device__ __forceinline__ void set_job(GemmJob& J, const bf16_t* A, const bf16_t* Bt, int M, int N, int K, int lda, int epi, void* O, const float* aux, int ldc) {
    J.g.A = A; J.g.Bt = Bt; J.g.M = M; J.g.N = N; J.g.K = K; J.g.lda = lda; J.g.kstepA = 128; J.epi = epi; J.O = O; J.aux = aux; J.aux2 = nullptr; J.ldc = ldc; J.coff = 0;
}
__device__ __forceinline__ bool gemm_job(const Params& p, int ph, int j, GemmJob& J) {
    unsigned char* ws = p.ws;
    const bf16_t* XB = (const bf16_t*)(ws + WS_XB); const float* XF = (const float*)XB;
    unsigned char* big = ws + WS_BIG;
    const int layer = ph >= PH_B_GEMM ? 1 : 0;
    const bf16_t* Win = (const bf16_t*)(ws + WS_WFIN) + (size_t)layer * 2 * DFF * DM; const bf16_t* Wout = (const bf16_t*)(ws + WS_WFOUT) + (size_t)layer * DM * DFF;
    if (ph == PH_A_GEMM) {
        if (j == 0) { set_job(J, XB, (const bf16_t*)(ws + WS_WAIN), NTOK, AINP, DM, DM, 0, big + BIG_P, nullptr, AINP); return true; }
        return false;
    }
    if (ph == PH_A_CMP1) {
        if (j == 2) { set_job(J, (const bf16_t*)(ws + WS_MEMB), (const bf16_t*)(ws + WS_WMKV), BATCH * NMEM, 1024, DM, DM, 0, ws + WS_MKV, nullptr, 1024); J.coff = 32; return true; }
        if (j >= 3) return false;
        const bf16_t* P = (const bf16_t*)(big + BIG_P);
        set_job(J, P + (j ? P_VC : P_KC), (const bf16_t*)(ws + (j ? WS_WC1V : WS_WC1K)), 4096, 256, 2048, 16 * AINP, 1, (float*)(ws + WS_CMPH) + (size_t)j * 4096 * 256, (const float*)(ws + WS_CBIAS) + j * 256, 256);
        J.g.kstepA = AINP * 2; J.coff = j * 16; return true;
    }
    if (ph == PH_A_OUT) { if (j) return false; set_job(J, (const bf16_t*)(big + BIG_O0), (const bf16_t*)(ws + WS_WAOUT), NTOK, DM, DM, DM, 2, p.out, p.in[I_X], DM); return true; }
    if (ph == PH_B_OUT) { if (j) return false; set_job(J, (const bf16_t*)(big + BIG_O1), (const bf16_t*)(ws + WS_WBOUT), NTOK, DM, DM, DM, 4, p.out, XF, DM); return true; }
    if (ph == PH_B_GEMM) {
        if (j == 0) { set_job(J, XB, (const bf16_t*)(ws + WS_WSKV), NTOK, KVP, DM, DM, 0, big + BIG_KV, nullptr, KVP); return true; }
        return false;
    }
    const int f = layer ? ph - PH_B_F0 : ph - PH_A_F0;
    if (j) return false;
    if (f == 0) { set_job(J, XB, Win, NTOK, 2 * DFF, DM, DM, 3, big + BIG_H, p.in[I_FCW] + (size_t)layer * 3 * DFF, DFF); J.aux2 = p.in[I_FCB] + (size_t)layer * DFF; return true; }
    if (f == 2) { set_job(J, (const bf16_t*)(big + BIG_H), Wout, NTOK, DM, DFF, DFF, 4, p.out, XF, DM); return true; }
    return false;
}
__device__ __forceinline__ bool is_gemm_phase(int ph) {
    return ph == PH_A_GEMM || ph == PH_A_CMP1 || ph == PH_A_OUT || ph == PH_B_OUT || ph == PH_B_GEMM || ph == PH_A_F0 || ph == PH_A_F1 || ph == PH_B_F0 || ph == PH_B_F1;
}
template <int JJ>
__device__ __forceinline__ void run_gemm_job(const Params& p, LAS unsigned char* lds, int ph) {
    GemmJob J;
    if (!gemm_job(p, ph, JJ, J)) return;
    pg8::StaticOrder S; S.init(J.g.M, J.g.N, (int)gridDim.x, (int)blockIdx.x - J.coff);
    if (J.epi == 0) { pg8::EpiBf16 E{(bf16_t*)J.O, J.ldc}; pg8::gemm_phase<pg8::EpiBf16>(lds, J.g, S, E); }
    else if (J.epi == 1) { pg8::EpiF32BiasGelu E{(float*)J.O, J.ldc, J.aux}; pg8::gemm_phase<pg8::EpiF32BiasGelu>(lds, J.g, S, E); }
    else if (J.epi == 3) { unsigned char* big = p.ws + WS_BIG; pg8::EpiConvGate E{(bf16_t*)J.O, J.aux, J.aux2, (float*)(big + BIG_TAILA), (float*)(big + BIG_HEADA), (float*)(big + BIG_HEADB)}; pg8::gemm_phase<pg8::EpiConvGate>(lds, J.g, S, E); }
    else if (J.epi == 2) { pg8::EpiResF32<true> E{J.aux, (float*)J.O, J.ldc, ALPHA}; pg8::gemm_phase<pg8::EpiResF32<true>>(lds, J.g, S, E); }
    else { pg8::EpiResF32<false> E{J.aux, (float*)J.O, J.ldc, ALPHA}; pg8::gemm_phase<pg8::EpiResF32<false>>(lds, J.g, S, E); }
}
__device__ __forceinline__ void run_gemm_phase(const Params& p, LAS unsigned char* lds, int ph) {
    run_gemm_job<0>(p, lds, ph); run_gemm_job<1>(p, lds, ph); run_gemm_job<2>(p, lds, ph);
}

__device__ __forceinline__ void run_phase(const Params& p, LAS unsigned char* lds, const Ctx& c, int ph) {
    unsigned char* ws = p.ws;
    bf16_t* XB = (bf16_t*)(ws + WS_XB);
    const int G = (int)gridDim.x, bid = (int)blockIdx.x;
    const int vid = (G % 8 == 0) ? (bid % 8) * (G / 8) + bid / 8 : bid;
    if (ph == PH_A_FIX || ph == PH_B_FIX) {
        const int layer = ph == PH_B_FIX ? 1 : 0;
        for (int pm = bid; pm < NTOK / 256; pm += G) ffn_fixup(c, ws + WS_BIG, p.in[I_FCW] + (size_t)layer * 3 * DFF, p.in[I_FCB] + (size_t)layer * DFF, pm);
        return;
    }
    if (ph == PH_A_CMP1 && G >= LATE_FIRST_WG + 32 && bid >= LATE_FIRST_WG) {
        Ctx c2 = c; c2.gtid = (bid - LATE_FIRST_WG) * NTHR + c.tid; c2.gsz = (G - LATE_FIRST_WG) * NTHR;
        prep_late(p, c2);
    }
    if (is_gemm_phase(ph)) { run_gemm_phase(p, lds, ph); return; }
    switch (ph) {
    case PH_PREP: phase_prep(p, c); break;
    case PH_A_CMP2: phase_cmp2(p, c); break;
    case PH_A_NSA1: {
        for (int u = vid; u < BATCH * 8; u += G) nsa1_unit(p, lds, u >> 3, u & 7);
    } break;
    case PH_A_NSA2: {
        for (int u = vid; u < BATCH * (NH / 2) * 4; u += G) { const int b = u / 24, r = u % 24, hp = r >> 2, s = (r + u / G) & 3;
#pragma nounroll
            for (int k = 0; k < 2; ++k) nsa2_unit(p, lds, b, 2 * hp, k ? s : 7 - s); }
    } break;
    case PH_B_ATT: {
        for (int u = vid; u < BATCH * NH * 2; u += G) { const int b = u / 24, r = u % 24, h = r >> 1, s = r & 1;
#pragma nounroll
            for (int k = 0; k < 2; ++k) moba_unit(p, lds, b, h, k ? s : 3 - s); }
    } break;
    case PH_A_LN1: case PH_B_LN1: case PH_A_LN2: case PH_B_LN2: {
        const int layer = ph >= PH_B_GEMM ? 1 : 0; const bool second = (ph == PH_A_LN2 || ph == PH_B_LN2); const bool fin = (ph == PH_B_LN2);
        phase_ln(c, p.out, p.in[second ? I_LN2G : I_LN1G] + layer * DM, p.in[second ? I_LN2B : I_LN1B] + layer * DM, fin ? p.out : nullptr, fin ? nullptr : XB);
    } break;
    case PH_B_KMEAN: phase_kmean(c, (const bf16_t*)(ws + WS_BIG + BIG_KV), (float*)(ws + WS_KMEAN)); break;
    default: break;
    }
    if (ph == PH_A_NSA1 || ph == PH_B_ATT) {
        const bool la = (ph == PH_A_NSA1);
        const bf16_t* Q = (const bf16_t*)(ws + WS_BIG + (la ? BIG_P : BIG_KV)) + (la ? 0 : KV_Q); bf16_t* O = (bf16_t*)(ws + WS_BIG + (la ? BIG_O0 : BIG_O1));
        for (int u = vid; u < BATCH * 4 * 4; u += G) mem_unit(p, lds, Q, la ? AINP : KVP, la ? P_QM : MAINW, O, la ? 0 : 512, u >> 4, (u >> 2) & 3, u & 3);
    }
}

template <int PH>
__device__ __forceinline__ void phase_seq(const Params& p, LAS unsigned char* lds, const Ctx& c, cg::grid_group& grid, const XcdBarrier& bar) {
    if constexpr (PH < PH_COUNT) {
        if (PH >= p.ph_lo && PH < p.ph_hi) {
            Ctx cc; { int t_ = threadIdx.x; asm volatile("" : "+v"(t_)); cc.tid = t_; cc.lane = t_ & 63; cc.wid = t_ >> 6; cc.gtid = blockIdx.x * NTHR + t_; cc.gsz = gridDim.x * NTHR; cc.gw = blockIdx.x * (NTHR / 64) + cc.wid; cc.ngw = gridDim.x * (NTHR / 64); }
            run_phase(p, lds, cc, PH); if (PH + 1 < p.ph_hi) { if (PH == 0) grid.sync(); else xcd_barrier(bar); } }
        phase_seq<PH + 1>(p, lds, c, grid, bar);
    }
}
__global__ void __launch_bounds__(NTHR) yoco_mega(Params p) {
    extern __shared__ __attribute__((aligned(16))) unsigned char lds_raw[];
    LAS unsigned char* lds = (LAS unsigned char*)lds_raw;
    cg::grid_group grid = cg::this_grid();
    Ctx c; c.tid = threadIdx.x; c.lane = c.tid & 63; c.wid = c.tid >> 6; c.gtid = blockIdx.x * NTHR + c.tid; c.gsz = gridDim.x * NTHR; c.gw = blockIdx.x * (NTHR / 64) + c.wid; c.ngw = gridDim.x * (NTHR / 64);
    if (c.tid < 130) ((LAS int*)(lds + att::L_BKT))[c.tid] = c.tid == 0 ? 0 : att::rel_bucket(c.tid - 1);
    if (c.tid < 2) ((LAS unsigned*)(lds + att::L_MISC))[c.tid] = 0u;
    __syncthreads();
    const XcdBarrier bar = xcd_barrier_post((unsigned*)(p.ws + WS_CTL), (volatile LAS unsigned*)(lds + att::L_MISC));
    phase_seq<0>(p, lds, c, grid, bar);
}

extern "C" void kernel_launch(void* const* d_in, const int* in_sizes, int n_in, void* d_out, int out_size, void* d_ws, size_t ws_size, hipStream_t stream) {
    static int grid = 0;
    if (grid == 0) {
        if (n_in != 24 || ws_size < WS_NEED) { fprintf(stderr, "kernel_launch: unexpected n_in %d / ws_size %zu (need %zu)\n", n_in, ws_size, (size_t)WS_NEED); grid = -1; return; }
        int dev = 0, cus = 0, per_cu = 0;
        hipGetDevice(&dev); hipDeviceGetAttribute(&cus, hipDeviceAttributeMultiprocessorCount, dev);
        if (hipFuncSetAttribute((const void*)yoco_mega, hipFuncAttributeMaxDynamicSharedMemorySize, LDS_BYTES) != hipSuccess) { fprintf(stderr, "kernel_launch: hipFuncSetAttribute failed\n"); grid = -1; return; }
        if (hipOccupancyMaxActiveBlocksPerMultiprocessor(&per_cu, (const void*)yoco_mega, NTHR, LDS_BYTES) != hipSuccess || per_cu < 1) { fprintf(stderr, "kernel_launch: occupancy query says %d\n", per_cu); per_cu = 1; }
        (void)hipGetLastError();
        grid = cus * per_cu;
        fprintf(stderr, "kernel_launch: grid %d (cus %d x %d)\n", grid, cus, per_cu);
    }
    if (grid < 0) return;
    if (hipMemsetAsync((char*)d_ws + WS_CTL, 0, CTL_BYTES, stream) != hipSuccess) { fprintf(stderr, "kernel_launch: memset failed\n"); return; }
    Params p{};
    for (int i = 0; i < 24; ++i) p.in[i] = (const float*)d_in[i];
    p.out = (float*)d_out; p.ws = (unsigned char*)d_ws; p.ph_lo = 0; p.ph_hi = PH_COUNT;
    void* args[] = {&p};
    hipError_t e = hipLaunchCooperativeKernel((const void*)yoco_mega, dim3(grid), dim3(NTHR), args, LDS_BYTES, stream);
    if (e != hipSuccess) fprintf(stderr, "kernel_launch: cooperative launch failed: %s (grid %d)\n", hipGetErrorString(e), grid);
}
```

```cpp
#include <hip/hip_runtime.h>
#include <hip/hip_cooperative_groups.h>
#include <cstdio>
#include <cstdint>
namespace cg = cooperative_groups;

#define LAS __attribute__((address_space(3)))
typedef unsigned short bf16_t;
typedef short bf16x8 __attribute__((ext_vector_type(8)));
typedef short s16x4 __attribute__((ext_vector_type(4)));
typedef float f32x4 __attribute__((ext_vector_type(4)));
typedef float f32x2 __attribute__((ext_vector_type(2)));
typedef float f32x16 __attribute__((ext_vector_type(16)));
typedef unsigned u32x4 __attribute__((ext_vector_type(4)));
typedef unsigned u32x2 __attribute__((ext_vector_type(2)));

__device__ __forceinline__ unsigned cvt_pk_bf16(float lo, float hi) { unsigned r; asm volatile("v_cvt_pk_bf16_f32 %0, %1, %2" : "=v"(r) : "v"(lo), "v"(hi)); return r; }
__device__ __forceinline__ float bf2f(unsigned short b) { return __uint_as_float(((unsigned)b) << 16); }
__device__ __forceinline__ float gelu_tanh(float x) {
    const float x2 = x * x;
    const float w = x * (-2.302208198f - 0.1029432397f * x2);
    return x * __builtin_amdgcn_rcpf(1.0f + __builtin_amdgcn_exp2f(w));
}

namespace pg8 {
constexpr int BM = 256, BK = 64, HALF = 128, HTB = HALF * BK * 2, STAGE_BYTES = 8 * HTB, NXCD = 8, WGM = 8;
__host__ __device__ __forceinline__ int lds_byte(int r, int c) { const int st = (r >> 4) * 2 + (c >> 5), rr = r & 15, cc = c & 31, ob = rr * 64 + cc * 2; return st * 1024 + (ob ^ (((ob >> 9) & 1) << 5)); }
__host__ __device__ __forceinline__ void stage_rc(int b, int& R, int& C) { const int st = b / 1024, sb = b % 1024, swz = sb ^ (((sb >> 9) & 1) << 5); R = (st >> 1) * 16 + swz / 64; C = (st & 1) * 32 + (swz % 64) / 2; }
__host__ __device__ __forceinline__ int perm32(int rho) { const int n = rho >> 4, i = rho & 15; return 8 * (i >> 2) + 4 * n + (i & 3); }

struct Unit { int pm, pn; };
struct Gemm { const bf16_t* A; const bf16_t* Bt; int M, N, K; int lda; int kstepA; };

struct StaticOrder {
    int nM, nN, nwg, G, c;
    __host__ __device__ void init(int M, int N, int G_, int c_) { nM = M / BM; nN = N / BM; nwg = nM * nN; G = G_; c = c_; }
    __host__ __device__ bool next(int i, Unit& u) const {
        if (c < 0) return false;
        const long L = (long)i * G + c; if (L >= nwg) return false;
        int wgid = (int)L; { const int q = nwg / NXCD, r = nwg % NXCD, xcd = wgid % NXCD, off = wgid / NXCD; wgid = (xcd < r ? xcd * (q + 1) : r * (q + 1) + (xcd - r) * q) + off; }
        const int nig = WGM * nN, gid = wgid / nig, fm = gid * WGM, gsz = (nM - fm) < WGM ? (nM - fm) : WGM;
        u.pm = fm + ((wgid % nig) % gsz); u.pn = (wgid % nig) / gsz; return true;
    }
};

struct EpiBf16 {
    static constexpr bool PERM = true;
    bf16_t* O; int ldc;
    __device__ __forceinline__ void operator()(const f32x4 (&acc)[2][2][4][2], const Unit& u, int wr, int wc, int fr, int fq) const {
        const int row0 = u.pm * BM + wr * 64 + fr; const int col0 = u.pn * BM + wc * 32 + 8 * fq;
#pragma unroll
        for (int ai = 0; ai < 2; ++ai)
#pragma unroll
            for (int m = 0; m < 4; ++m) { bf16_t* rowp = O + (size_t)(row0 + ai * HALF + m * 16) * ldc + col0;
#pragma unroll
                for (int bj = 0; bj < 2; ++bj) { const f32x4 v0 = acc[ai][bj][m][0], v1 = acc[ai][bj][m][1];
                    u32x4 w; w.x = cvt_pk_bf16(v0[0], v0[1]); w.y = cvt_pk_bf16(v0[2], v0[3]); w.z = cvt_pk_bf16(v1[0], v1[1]); w.w = cvt_pk_bf16(v1[2], v1[3]);
                    *(u32x4*)(rowp + bj * HALF) = w; } }
    }
};
struct EpiF32BiasGelu {
    static constexpr bool PERM = false;
    float* O; int ldc; const float* bias;
    __device__ __forceinline__ void operator()(const f32x4 (&acc)[2][2][4][2], const Unit& u, int wr, int wc, int fr, int fq) const {
        const int row0 = u.pm * BM + wr * 64 + fr; const int col0 = u.pn * BM + wc * 32 + 4 * fq;
#pragma unroll
        for (int bj = 0; bj < 2; ++bj)
#pragma unroll
            for (int n = 0; n < 2; ++n) { const f32x4 bv = *(const f32x4*)(bias + col0 + bj * HALF + n * 16);
#pragma unroll
                for (int ai = 0; ai < 2; ++ai)
#pragma unroll
                    for (int m = 0; m < 4; ++m) { f32x4 v = acc[ai][bj][m][n] + bv; v[0] = gelu_tanh(v[0]); v[1] = gelu_tanh(v[1]); v[2] = gelu_tanh(v[2]); v[3] = gelu_tanh(v[3]);
                        *(f32x4*)(O + (size_t)(row0 + ai * HALF + m * 16) * ldc + col0 + bj * HALF + n * 16) = v; } }
    }
};
template <int CTRL> __device__ __forceinline__ float dppf(float old, float src) {
    return __int_as_float(__builtin_amdgcn_update_dpp(__float_as_int(old), __float_as_int(src), CTRL, 0xf, 0xf, false));
}
struct EpiConvGate {
    static constexpr bool PERM = true;
    bf16_t* H; const float* cw; const float* cb; float* TAILA; float* HEADA; float* HEADB;
    __device__ __forceinline__ void operator()(const f32x4 (&acc)[2][2][4][2], const Unit& u, int wr, int wc, int fr, int fq) const {
        constexpr int DFF_ = 2816;
        const int cf0 = u.pn * 128 + wc * 32 + 8 * fq;
        f32x4 w0[2], w1[2], w2[2], cv[2];
#pragma unroll
        for (int n = 0; n < 2; ++n) { w0[n] = *(const f32x4*)(cw + cf0 + 4 * n); w1[n] = *(const f32x4*)(cw + DFF_ + cf0 + 4 * n); w2[n] = *(const f32x4*)(cw + 2 * DFF_ + cf0 + 4 * n); cv[n] = *(const f32x4*)(cb + cf0 + 4 * n); }
#pragma unroll
        for (int ai = 0; ai < 2; ++ai) {
            const int G = u.pm * 4 + ai * 2 + wr;
#pragma unroll
            for (int m = 0; m < 4; ++m) {
                const int row = u.pm * BM + ai * HALF + wr * 64 + m * 16 + fr;
                f32x4 hv[2];
#pragma unroll
                for (int n = 0; n < 2; ++n) {
                    const f32x4 a = acc[ai][0][m][n], b = acc[ai][1][m][n];
                    const f32x4 pv = acc[ai][0][m > 0 ? m - 1 : 0][n];
#pragma unroll
                    for (int j = 0; j < 4; ++j) {
                        const float am1 = dppf<0x111>(dppf<0x121>(0.f, pv[j]), a[j]);
                        const float am2 = dppf<0x112>(dppf<0x122>(0.f, pv[j]), a[j]);
                        const float pre = w0[n][j] * am2 + w1[n][j] * am1 + w2[n][j] * a[j] + cv[n][j];
                        hv[n][j] = gelu_tanh(pre) * b[j];
                    }
                }
                if (m > 0 || fr >= 2) {
                    u32x4 w; w.x = cvt_pk_bf16(hv[0][0], hv[0][1]); w.y = cvt_pk_bf16(hv[0][2], hv[0][3]); w.z = cvt_pk_bf16(hv[1][0], hv[1][1]); w.w = cvt_pk_bf16(hv[1][2], hv[1][3]);
                    *(u32x4*)(H + (size_t)row * DFF_ + cf0) = w;
                } else {
                    float* ha = HEADA + ((size_t)G * 2 + fr) * DFF_ + cf0; float* hb = HEADB + ((size_t)G * 2 + fr) * DFF_ + cf0;
                    *(f32x4*)ha = acc[ai][0][0][0]; *(f32x4*)(ha + 4) = acc[ai][0][0][1]; *(f32x4*)hb = acc[ai][1][0][0]; *(f32x4*)(hb + 4) = acc[ai][1][0][1];
                }
                if (m == 3 && fr >= 14) { float* ta = TAILA + ((size_t)G * 2 + (fr - 14)) * DFF_ + cf0; *(f32x4*)ta = acc[ai][0][3][0]; *(f32x4*)(ta + 4) = acc[ai][0][3][1]; }
            }
        }
    }
};
template <bool BASE_F32>
struct EpiResF32 {
    static constexpr bool PERM = false;
    const void* basev; float* O; int ldc; float alpha;
    __device__ __forceinline__ void operator()(const f32x4 (&acc)[2][2][4][2], const Unit& u, int wr, int wc, int fr, int fq) const {
        const int row0 = u.pm * BM + wr * 64 + fr; const int col0 = u.pn * BM + wc * 32 + 4 * fq;
#pragma unroll
        for (int ai = 0; ai < 2; ++ai)
#pragma unroll
            for (int m = 0; m < 4; ++m) { const size_t off = (size_t)(row0 + ai * HALF + m * 16) * ldc + col0;
#pragma unroll
                for (int bj = 0; bj < 2; ++bj)
#pragma unroll
                    for (int n = 0; n < 2; ++n) { f32x4 bs;
                        if (BASE_F32) bs = *(const f32x4*)((const float*)basev + off + bj * HALF + n * 16);
                        else { const u32x2 w = *(const u32x2*)((const bf16_t*)basev + off + bj * HALF + n * 16); bs[0] = __uint_as_float(w.x << 16); bs[1] = __uint_as_float(w.x & 0xffff0000u); bs[2] = __uint_as_float(w.y << 16); bs[3] = __uint_as_float(w.y & 0xffff0000u); }
                        *(f32x4*)(O + off + bj * HALF + n * 16) = bs * alpha + acc[ai][bj][m][n]; } }
    }
};

template <class Epi>
__device__ __forceinline__ void gemm_phase(LAS unsigned char* lds, const Gemm g, const StaticOrder& S, const Epi& E) {
    const int tid = threadIdx.x, wid = __builtin_amdgcn_readfirstlane(tid >> 6), lane = tid & 63, wr = wid >> 2, wc = wid & 3, fr = lane & 15, fq = lane >> 4;
    const int K = g.K, nt = K / BK;
    unsigned voffA[2], voffB[2];
#pragma unroll
    for (int i = 0; i < 2; ++i) { int R, C; stage_rc(tid * 16 + i * 8192, R, C); const int Rb = Epi::PERM ? ((R & ~31) + perm32(R & 31)) : R;
        voffA[i] = (unsigned)(R * g.lda + C) * 2u; voffB[i] = (unsigned)(Rb * K + C) * 2u; }
    const size_t kstepA = (size_t)g.kstepA, kstepB = (size_t)(BK * 2);
    const size_t hstepA = (size_t)HALF * g.lda * 2, hstepB = (size_t)HALF * K * 2;
    const size_t tstepA = 2 * hstepA, tstepB = 2 * hstepB;
    const unsigned ldsw = (unsigned)wid * 1024u;
    const int aoff = lds_byte(wr * 64 + fr, fq * 8), boff = lds_byte(wc * 32 + fr, fq * 8);
#define PG8_SA(b, h) (((b) * 2 + (h)) * HTB)
#define PG8_SB(b, h) ((4 + (b) * 2 + (h)) * HTB)
#define PG8_STAGE(bufoff, gbase, voff) do { _Pragma("unroll") for (int _i = 0; _i < 2; ++_i) \
        __builtin_amdgcn_global_load_lds((const unsigned*)((const char*)(gbase) + (voff)[_i]), (LAS unsigned*)(lds + (bufoff) + ldsw + _i * 8192), 16, 0, 0); } while (0)
#define PG8_LDA(dst, b, h) do { _Pragma("unroll") for (int m = 0; m < 4; ++m) _Pragma("unroll") for (int k = 0; k < 2; ++k) dst[m][k] = *(const LAS bf16x8*)(lds + PG8_SA(b, h) + aoff + m * 2048 + k * 1024); } while (0)
#define PG8_LDB(dst, b, h) do { _Pragma("unroll") for (int n = 0; n < 2; ++n) _Pragma("unroll") for (int k = 0; k < 2; ++k) dst[n][k] = *(const LAS bf16x8*)(lds + PG8_SB(b, h) + boff + n * 2048 + k * 1024); } while (0)
#define PG8_MMA(ai, bj, At, Bt) do { __builtin_amdgcn_s_setprio(1); _Pragma("unroll") for (int m = 0; m < 4; ++m) _Pragma("unroll") for (int n = 0; n < 2; ++n) _Pragma("unroll") for (int k = 0; k < 2; ++k) \
        acc[ai][bj][m][n] = __builtin_amdgcn_mfma_f32_16x16x32_bf16(Bt[n][k], At[m][k], acc[ai][bj][m][n], 0, 0, 0); __builtin_amdgcn_s_setprio(0); } while (0)
#define PG8_WAIT_V(n) asm volatile("s_waitcnt vmcnt(" #n ")" ::: "memory")
#define PG8_WAIT_L(n) asm volatile("s_waitcnt lgkmcnt(" #n ")" ::: "memory")
#define PG8_BAR __builtin_amdgcn_s_barrier()
#define PG8_SCHED __builtin_amdgcn_sched_barrier(0)
    Unit cur, nxt; int ui = 0;
    if (!S.next(0, cur)) return;
    f32x4 acc[2][2][4][2];
#pragma unroll
    for (int a = 0; a < 2; ++a)
#pragma unroll
        for (int b = 0; b < 2; ++b)
#pragma unroll
            for (int m = 0; m < 4; ++m)
#pragma unroll
                for (int n = 0; n < 2; ++n) acc[a][b][m][n] = (f32x4){0.f, 0.f, 0.f, 0.f};
    bf16x8 At[4][2], B0[2][2], B1[2][2];
    const char* cA = (const char*)g.A + (size_t)cur.pm * tstepA; const char* cB = (const char*)g.Bt + (size_t)cur.pn * tstepB;
    PG8_STAGE(PG8_SB(0, 0), cB, voffB); PG8_STAGE(PG8_SB(0, 1), cB + hstepB, voffB); PG8_STAGE(PG8_SA(0, 0), cA, voffA); PG8_STAGE(PG8_SA(0, 1), cA + hstepA, voffA);
    if (wr == 1) PG8_BAR;
    PG8_WAIT_V(2); PG8_BAR;
    PG8_STAGE(PG8_SB(1, 0), cB + kstepB, voffB); PG8_STAGE(PG8_SA(1, 0), cA + kstepA, voffA); PG8_STAGE(PG8_SB(1, 1), cB + hstepB + kstepB, voffB);
    PG8_WAIT_V(6); PG8_BAR;
    for (;;) {
        const bool has_next = S.next(ui + 1, nxt);
        const char* nA = has_next ? (const char*)g.A + (size_t)nxt.pm * tstepA : cA; const char* nB = has_next ? (const char*)g.Bt + (size_t)nxt.pn * tstepB : cB;
        for (int t = 0; t < nt; t += 2) {
            const bool last = (t == nt - 2);
            const char* a1 = cA + (size_t)(t + 1) * kstepA;
            const char* a2 = last ? nA : cA + (size_t)(t + 2) * kstepA; const char* b2 = last ? nB : cB + (size_t)(t + 2) * kstepB;
            const char* a3 = a2 + kstepA; const char* b3 = b2 + kstepB;
            PG8_LDB(B0, 0, 0); PG8_LDB(B1, 0, 1); PG8_SCHED; PG8_LDA(At, 0, 0); PG8_STAGE(PG8_SA(1, 1), a1 + hstepA, voffA);
            PG8_WAIT_V(8); PG8_WAIT_L(0); PG8_BAR; PG8_MMA(0, 0, At, B0); PG8_MMA(0, 1, At, B1); PG8_BAR; PG8_SCHED;
            PG8_LDA(At, 0, 1); PG8_STAGE(PG8_SB(0, 0), b2, voffB); PG8_STAGE(PG8_SB(0, 1), b2 + hstepB, voffB); PG8_STAGE(PG8_SA(0, 0), a2, voffA);
            PG8_WAIT_V(8); PG8_WAIT_L(0); PG8_BAR; PG8_MMA(1, 0, At, B0); PG8_MMA(1, 1, At, B1); PG8_BAR; PG8_SCHED;
            PG8_LDB(B0, 1, 0); PG8_LDB(B1, 1, 1); PG8_SCHED; PG8_LDA(At, 1, 0); PG8_STAGE(PG8_SA(0, 1), a2 + hstepA, voffA);
            PG8_WAIT_V(8); PG8_WAIT_L(0); PG8_BAR; PG8_MMA(0, 0, At, B0); PG8_MMA(0, 1, At, B1); PG8_BAR; PG8_SCHED;
            PG8_LDA(At, 1, 1); PG8_STAGE(PG8_SB(1, 0), b3, voffB); PG8_STAGE(PG8_SB(1, 1), b3 + hstepB, voffB); PG8_STAGE(PG8_SA(1, 0), a3, voffA);
            PG8_WAIT_V(8); PG8_WAIT_L(0); PG8_BAR; PG8_MMA(1, 0, At, B0); PG8_MMA(1, 1, At, B1); PG8_BAR; PG8_SCHED;
        }
        if (wr == 0) PG8_BAR;
        E(acc, cur, wr, wc, fr, fq);
        if (!has_next) break;
#pragma unroll
        for (int a = 0; a < 2; ++a)
#pragma unroll
            for (int b = 0; b < 2; ++b)
#pragma unroll
                for (int m = 0; m < 4; ++m)
#pragma unroll
                    for (int n = 0; n < 2; ++n) acc[a][b][m][n] = (f32x4){0.f, 0.f, 0.f, 0.f};
        cur = nxt; cA = nA; cB = nB; ++ui;
        if (wr == 1) PG8_BAR;
    }
    PG8_WAIT_V(0);
    PG8_BAR;
#undef PG8_SA
#undef PG8_SB
#undef PG8_STAGE
#undef PG8_LDA
#undef PG8_LDB
#undef PG8_MMA
#undef PG8_WAIT_V
#undef PG8_WAIT_L
#undef PG8_BAR
#undef PG8_SCHED
}
}

constexpr int BATCH = 32, SEQ = 2048, DM = 1024, NTOK = BATCH * SEQ, NMEM = 256, NH = 12, HD = 64, MAINW = 768;
constexpr int AIN = 1444, AINP = 1536, DFF = 2816, NCMP = 127;
constexpr int HALF_TOK = NTOK / 2;
constexpr float ALPHA = 1.4142135623730951f;
constexpr float LN_EPS = 1e-5f;
constexpr int P_Q = 0, P_KC = 768, P_VC = 832, P_KS = 896, P_VS = 960, P_KW = 1024, P_VW = 1088, P_QM = 1152, P_G = 1408;
constexpr size_t MiB = 1u << 20;
constexpr size_t WS_WAIN = 0 * MiB, WS_WAMKV = 3 * MiB, WS_WAOUT = 4 * MiB, WS_WSKV = 6 * MiB, WS_WBIN = 9 * MiB, WS_WBMKV = 11 * MiB, WS_WBOUT = 12 * MiB;
constexpr size_t WS_WFIN = 14 * MiB  , WS_WFOUT = 36 * MiB  , WS_WC1K = 47 * MiB, WS_WC1V = 48 * MiB, WS_WMKV = 49 * MiB  ;
constexpr size_t WS_CTL = 51 * MiB, CTL_BYTES = 16384;
constexpr size_t WS_MEMB = 52 * MiB, WS_MKV = 68 * MiB  , WS_CMPH = 84 * MiB, WS_KCMP = 92 * MiB, WS_VCMP = 93 * MiB, WS_CBIAS = 94 * MiB, WS_SEL = 94 * MiB + 65536, WS_KMEAN = 95 * MiB;
constexpr size_t WS_XB = 96 * MiB, WS_BIG = 226 * MiB;
constexpr size_t BIG_P = 0, BIG_O0 = 193 * MiB, BIG_H = 0, BIG_TAILA = 352 * MiB, BIG_HEADA = 374 * MiB, BIG_HEADB = 396 * MiB, BIG_KV = 0  , BIG_O1 = 321 * MiB;
constexpr int KVP = 2560, KV_Q = 1536;
static_assert(WS_WBIN == WS_WSKV + (size_t)1536 * 1024 * 2, "layer-1 weight copies must be adjacent");
constexpr size_t WS_NEED = WS_BIG + 449 * MiB;

constexpr int LDS_BYTES = 147456;
constexpr int NTHR = 512;

struct Params {
    const float* in[24];
    float* out;
    unsigned char* ws;
    int ph_lo, ph_hi;
};
enum { I_X = 0, I_MEM, I_RELB, I_AWIN, I_PEK, I_W1K, I_W2K, I_PEV, I_W1V, I_W2V, I_AWMKV, I_AWOUT, I_SWKV, I_BWIN, I_BWMKV, I_BWOUT, I_LN1G, I_LN1B, I_LN2G, I_LN2B, I_FWIN, I_FCW, I_FCB, I_FWOUT };

namespace att {
constexpr int ROWB = 144, TILEB = 64 * ROWB, VROWB = 192, VTILEB = 64 * VROWB;
constexpr float NEG = -1e30f;
constexpr float LOG2E = 1.4426950408889634f;
constexpr float SC2 = 0.125f * LOG2E;
typedef short v4i16_t __attribute__((ext_vector_type(4)));

__device__ __forceinline__ f32x16 zero16() { f32x16 z;
#pragma unroll
    for (int i = 0; i < 16; ++i) z[i] = 0.f; return z; }

__device__ __forceinline__ void qk_tile(f32x16& p0, f32x16& p1, const LAS unsigned char* Kt, const bf16x8 (&qr)[4], int r32, int hi, float cinit = 0.f) {
    const LAS unsigned char* kb = Kt + r32 * ROWB + hi * 16;
#pragma unroll
    for (int i = 0; i < 16; ++i) { p0[i] = cinit; p1[i] = cinit; }
#pragma unroll
    for (int d0 = 0; d0 < 4; ++d0) {
        const bf16x8 k0 = *(const LAS bf16x8*)(kb + d0 * 32);
        const bf16x8 k1 = *(const LAS bf16x8*)(kb + 32 * ROWB + d0 * 32);
        p0 = __builtin_amdgcn_mfma_f32_32x32x16_bf16(k0, qr[d0], p0, 0, 0, 0);
        p1 = __builtin_amdgcn_mfma_f32_32x32x16_bf16(k1, qr[d0], p1, 0, 0, 0);
    }
}
__device__ __forceinline__ s16x4 vtr(const LAS unsigned char* p) { return __builtin_bit_cast(s16x4, __builtin_amdgcn_ds_read_tr16_b64_v4i16((LAS v4i16_t*)p)); }
__device__ __forceinline__ void pv_tile(f32x16& o0, f32x16& o1, const LAS unsigned char* Vt, const f32x16& p0, const f32x16& p1, int lane) {
    const int hi = lane >> 5, g1 = (lane >> 4) & 1, i = lane & 15, q_ = i >> 2, p_ = i & 3;
    const LAS unsigned char* vb = Vt + (4 * hi + q_) * VROWB + (16 * g1 + 4 * p_) * 2;
#pragma unroll
    for (int s = 0; s < 4; ++s) {
        u32x4 w;
        if (s < 2) { const int b = 8 * (s & 1); w.x = cvt_pk_bf16(p0[b + 0], p0[b + 1]); w.y = cvt_pk_bf16(p0[b + 2], p0[b + 3]); w.z = cvt_pk_bf16(p0[b + 4], p0[b + 5]); w.w = cvt_pk_bf16(p0[b + 6], p0[b + 7]); }
        else       { const int b = 8 * (s & 1); w.x = cvt_pk_bf16(p1[b + 0], p1[b + 1]); w.y = cvt_pk_bf16(p1[b + 2], p1[b + 3]); w.z = cvt_pk_bf16(p1[b + 4], p1[b + 5]); w.w = cvt_pk_bf16(p1[b + 6], p1[b + 7]); }
        const bf16x8 pf = __builtin_bit_cast(bf16x8, w);
#pragma unroll
        for (int dh = 0; dh < 2; ++dh) {
            const s16x4 lo = vtr(vb + (16 * s) * VROWB + dh * 64);
            const s16x4 h4 = vtr(vb + (16 * s + 8) * VROWB + dh * 64);
            const bf16x8 vf = (bf16x8){lo[0], lo[1], lo[2], lo[3], h4[0], h4[1], h4[2], h4[3]};
            if (dh == 0) o0 = __builtin_amdgcn_mfma_f32_32x32x16_bf16(vf, pf, o0, 0, 0, 0);
            else         o1 = __builtin_amdgcn_mfma_f32_32x32x16_bf16(vf, pf, o1, 0, 0, 0);
        }
    }
}
struct Acc { float m, l; f32x16 o0, o1; };
__device__ __forceinline__ void acc_init(Acc& A) { A.m = NEG; A.l = 0.f; A.o0 = zero16(); A.o1 = zero16(); }
constexpr float THR_RAW = 8.0f / SC2;
__device__ __forceinline__ void sm_update(Acc& A, f32x16& p0, f32x16& p1) {
    float m0 = fmaxf(p0[0], p1[0]), m1 = fmaxf(p0[1], p1[1]);
#pragma unroll
    for (int r = 2; r < 16; r += 2) { m0 = fmaxf(fmaxf(m0, p0[r]), p1[r]); m1 = fmaxf(fmaxf(m1, p0[r + 1]), p1[r + 1]); }
    float mx = fmaxf(m0, m1);
    mx = fmaxf(mx, __shfl_xor(mx, 32));
    if (__any(mx > A.m + THR_RAW)) {
        const float mn = fmaxf(A.m, mx);
        const float alpha = __builtin_amdgcn_exp2f((A.m - (mn < -5e29f ? 0.f : mn)) * SC2);
        A.l *= alpha; A.m = mn;
#pragma unroll
        for (int r = 0; r < 16; ++r) { A.o0[r] *= alpha; A.o1[r] *= alpha; }
    }
    const float msc = (A.m < -5e29f ? 0.f : A.m) * SC2;
    float rs0 = 0.f, rs1 = 0.f;
#pragma unroll
    for (int r = 0; r < 16; ++r) {
        const float e0 = __builtin_amdgcn_exp2f(p0[r] * SC2 - msc);
        const float e1 = __builtin_amdgcn_exp2f(p1[r] * SC2 - msc);
        p0[r] = e0; p1[r] = e1; rs0 += e0; rs1 += e1;
    }
    A.l += rs0 + rs1;
}
__device__ __forceinline__ float rowmax32(const f32x16& p0, const f32x16& p1) {
    float m0 = fmaxf(p0[0], p1[0]), m1 = fmaxf(p0[1], p1[1]), m2 = fmaxf(p0[2], p1[2]), m3 = fmaxf(p0[3], p1[3]);
#pragma unroll
    for (int r = 4; r < 16; r += 4) { m0 = fmaxf(fmaxf(m0, p0[r]), p1[r]); m1 = fmaxf(fmaxf(m1, p0[r + 1]), p1[r + 1]); m2 = fmaxf(fmaxf(m2, p0[r + 2]), p1[r + 2]); m3 = fmaxf(fmaxf(m3, p0[r + 3]), p1[r + 3]); }
    return fmaxf(fmaxf(m0, m1), fmaxf(m2, m3));
}
__device__ __forceinline__ void sm_update2(Acc& A, Acc& B, f32x16& a0, f32x16& a1, f32x16& b0, f32x16& b1) {
    float mxa = rowmax32(a0, a1), mxb = rowmax32(b0, b1);
    mxa = fmaxf(mxa, __shfl_xor(mxa, 32)); mxb = fmaxf(mxb, __shfl_xor(mxb, 32));
    if (__any((mxa > A.m + THR_RAW) || (mxb > B.m + THR_RAW))) {
        const float mna = fmaxf(A.m, mxa), mnb = fmaxf(B.m, mxb);
        const float ala = __builtin_amdgcn_exp2f((A.m - (mna < -5e29f ? 0.f : mna)) * SC2), alb = __builtin_amdgcn_exp2f((B.m - (mnb < -5e29f ? 0.f : mnb)) * SC2);
        A.l *= ala; A.m = mna; B.l *= alb; B.m = mnb;
#pragma unroll
        for (int r = 0; r < 16; ++r) { A.o0[r] *= ala; B.o0[r] *= alb; A.o1[r] *= ala; B.o1[r] *= alb; }
    }
    const float msa = (A.m < -5e29f ? 0.f : A.m) * SC2, msb = (B.m < -5e29f ? 0.f : B.m) * SC2;
    float ra0 = 0.f, ra1 = 0.f, rb0 = 0.f, rb1 = 0.f;
#pragma unroll
    for (int r = 0; r < 16; ++r) {
        const float ea0 = __builtin_amdgcn_exp2f(a0[r] * SC2 - msa), eb0 = __builtin_amdgcn_exp2f(b0[r] * SC2 - msb);
        const float ea1 = __builtin_amdgcn_exp2f(a1[r] * SC2 - msa), eb1 = __builtin_amdgcn_exp2f(b1[r] * SC2 - msb);
        a0[r] = ea0; b0[r] = eb0; a1[r] = ea1; b1[r] = eb1; ra0 += ea0; rb0 += eb0; ra1 += ea1; rb1 += eb1;
    }
    A.l += ra0 + ra1; B.l += rb0 + rb1;
}
__device__ __forceinline__ float acc_inv(const Acc& A) { const float lt = A.l + __shfl_xor(A.l, 32); return 1.0f / fmaxf(lt, 1e-30f); }

__device__ __forceinline__ void apply_general(f32x16& p0, f32x16& p1, int dist0, const LAS float* tab, bool allow, int W) {
    const unsigned We = allow ? (unsigned)W : 0u;
#pragma unroll
    for (int r = 0; r < 16; ++r) {
        const int d_0 = dist0 - ((r & 3) + 8 * (r >> 2)), d_1 = d_0 - 32;
        const int i0 = ((unsigned)d_0 < We) ? min(d_0, 128) + 1 : 0, i1 = ((unsigned)d_1 < We) ? min(d_1, 128) + 1 : 0;
        p0[r] += tab[i0];
        p1[r] += tab[i1];
        if ((r & 3) == 3) __builtin_amdgcn_sched_barrier(0);
    }
}
__device__ __forceinline__ int rel_bucket(int n) {
    if (n < 16) return n;
    const float v = logf((float)n / 16.0f) / 2.0794415416798357f * 16.0f;
    int l = 16 + (int)v; return l < 31 ? l : 31;
}
__device__ __forceinline__ u32x4 tile_ld(const bf16_t* base, long ld, int row0, int rmin, int rmax, int tid) {
    int r = row0 + (tid >> 3); r = r < rmin ? rmin : (r > rmax ? rmax : r);
    return *(const u32x4*)(base + (long)r * ld + (tid & 7) * 8);
}
__device__ __forceinline__ void tile_st(LAS unsigned char* buf, u32x4 v, int tid) { *(LAS u32x4*)(buf + (tid >> 3) * ROWB + (tid & 7) * 16) = v; }
__device__ __forceinline__ void tile_stv(LAS unsigned char* buf, u32x4 v, int tid) { *(LAS u32x4*)(buf + (tid >> 3) * VROWB + (tid & 7) * 16) = v; }
__device__ __forceinline__ void load_q(bf16x8 (&qr)[4], const bf16_t* qrow, int hi) {
#pragma unroll
    for (int d0 = 0; d0 < 4; ++d0) qr[d0] = *(const bf16x8*)(qrow + d0 * 16 + hi * 8);
}
__device__ __forceinline__ void store_o(bf16_t* orow, const f32x16& o0, const f32x16& o1, int hi) {
#pragma unroll
    for (int g = 0; g < 4; ++g) {
        u32x2 w0, w1; w0.x = cvt_pk_bf16(o0[4 * g], o0[4 * g + 1]); w0.y = cvt_pk_bf16(o0[4 * g + 2], o0[4 * g + 3]);
        w1.x = cvt_pk_bf16(o1[4 * g], o1[4 * g + 1]); w1.y = cvt_pk_bf16(o1[4 * g + 2], o1[4 * g + 3]);
        *(u32x2*)(orow + 8 * g + 4 * hi) = w0; *(u32x2*)(orow + 32 + 8 * g + 4 * hi) = w1;
    }
}
__device__ __forceinline__ void add_prev_o(const bf16_t* orow, f32x16& o0, f32x16& o1, int hi) {
#pragma unroll
    for (int g = 0; g < 4; ++g) {
        const u32x2 w0 = *(const u32x2*)(orow + 8 * g + 4 * hi), w1 = *(const u32x2*)(orow + 32 + 8 * g + 4 * hi);
        o0[4 * g] += __uint_as_float(w0.x << 16); o0[4 * g + 1] += __uint_as_float(w0.x & 0xffff0000u); o0[4 * g + 2] += __uint_as_float(w0.y << 16); o0[4 * g + 3] += __uint_as_float(w0.y & 0xffff0000u);
        o1[4 * g] += __uint_as_float(w1.x << 16); o1[4 * g + 1] += __uint_as_float(w1.x & 0xffff0000u); o1[4 * g + 2] += __uint_as_float(w1.y << 16); o1[4 * g + 3] += __uint_as_float(w1.y & 0xffff0000u);
    }
}
__device__ __forceinline__ float sigmoidf(float x) { return 1.0f / (1.0f + __expf(-x)); }

constexpr int L_K0 = 0, L_K1 = TILEB, L_V0 = 2 * TILEB, L_V1 = 2 * TILEB + VTILEB, L_TAB = 2 * TILEB + 2 * VTILEB  , L_SIMP = 53248  , L_Q = 53248  , L_BKT = 131072  , L_MISC = 131072 + 1024  ;

__device__ __forceinline__ const LAS unsigned char* park_q(LAS unsigned char* lds, const bf16_t* q0, const bf16_t* q1, int wid, int lane, int hi) {
    LAS unsigned char* qp = lds + L_Q + wid * 8192 + lane * 16;
#pragma unroll
    for (int d0 = 0; d0 < 4; ++d0) { *(LAS bf16x8*)(qp + d0 * 1024) = *(const bf16x8*)(q0 + d0 * 16 + hi * 8); *(LAS bf16x8*)(qp + 4096 + d0 * 1024) = *(const bf16x8*)(q1 + d0 * 16 + hi * 8); }
    return qp;
}
__device__ __forceinline__ void fill_tab(LAS unsigned char* lds, const float* relb, int h0, int nh, int tid) {
    LAS float* tab = (LAS float*)(lds + L_TAB);
    const LAS int* bkt = (const LAS int*)(lds + L_BKT);
    for (int i = tid; i < nh * 130; i += NTHR) { const int hh = i / 130, d = i % 130; tab[hh * 132 + d] = d == 0 ? NEG : relb[bkt[d] * NH + h0 + hh] * 8.0f; }
}

template <int MODE>
struct TileInfo { bool want, near, allow; float cinit; };
template <int MODE>
__device__ __forceinline__ TileInfo<MODE> classify(int kt, int tw, unsigned selmask, int blkshift, int W, float b129) {
    TileInfo<MODE> ti; const int kbase = kt * 64;
    if (MODE == 0) { ti.want = true; ti.near = false; ti.allow = true; ti.cinit = 0.f; }
    else if (MODE == 1) { ti.allow = (selmask >> (kt >> blkshift)) & 1u; ti.want = (kbase <= tw + 31) && __any(ti.allow); ti.near = !(tw - (kbase + 63) >= 128); ti.cinit = ti.near ? 0.f : (ti.allow ? b129 : NEG); }
    else { ti.allow = true; ti.want = (kbase <= tw + 31) && (kbase + 63 >= tw - (W - 1)); ti.near = !((tw - (kbase + 63) >= 128) && (tw + 31 - kbase < W)); ti.cinit = ti.near ? 0.f : b129; }
    return ti;
}
template <int MODE, bool QREG>
__device__ __forceinline__ void seg2(Acc (&A)[2], LAS unsigned char* lds, const bf16_t* Kg, const bf16_t* Vg, long ld, int rmax, int lo, int hi_t,
                                     const LAS unsigned char* qp  , int t0  , int tw0, unsigned sel0, unsigned sel1, int blkshift, int W, const LAS float* tab, int tid) {
    const int lane = tid & 63, r32 = lane & 31, hi = lane >> 5;
    if (lo >= hi_t) return;
    {
        const u32x4 k0 = tile_ld(Kg, ld, lo * 64, 0, rmax, tid), v0 = tile_ld(Vg, ld, lo * 64, 0, rmax, tid);
        __syncthreads();
        tile_st(lds + L_K0, k0, tid); tile_stv(lds + L_V0, v0, tid);
        __syncthreads();
    }
    const float b129 = (MODE == 0) ? 0.f : tab[129];
    const int g1 = (lane >> 4) & 1, i16 = lane & 15, q_ = i16 >> 2, p_ = i16 & 3;
    bf16x8 qra[4], qrb[4];
    if (QREG) {
#pragma unroll
        for (int d0 = 0; d0 < 4; ++d0) { qra[d0] = *(const LAS bf16x8*)(qp + d0 * 1024); qrb[d0] = *(const LAS bf16x8*)(qp + 4096 + d0 * 1024); }
    }
    int cur = 0;
    for (int kt = lo; kt < hi_t; ++kt) {
        const bool more1 = kt + 1 < hi_t;
        u32x4 kreg, vreg;
        if (more1) { kreg = tile_ld(Kg, ld, (kt + 1) * 64, 0, rmax, tid); vreg = tile_ld(Vg, ld, (kt + 1) * 64, 0, rmax, tid); }
        TileInfo<MODE> ta = classify<MODE>(kt, tw0, sel0, blkshift, W, b129), tb = classify<MODE>(kt, tw0 + 32, sel1, blkshift, W, b129);
        if (ta.want || tb.want) {
            if (!ta.want) { ta.cinit = NEG; ta.near = false; }
            if (!tb.want) { tb.cinit = NEG; tb.near = false; }
            const LAS unsigned char* Kt = lds + (cur ? L_K1 : L_K0); const LAS unsigned char* Vt = lds + (cur ? L_V1 : L_V0);
            f32x16 a0, a1, b0, b1;
#pragma unroll
            for (int i = 0; i < 16; ++i) { a0[i] = ta.cinit; a1[i] = ta.cinit; b0[i] = tb.cinit; b1[i] = tb.cinit; }
            const LAS unsigned char* kb = Kt + r32 * ROWB + hi * 16;
#pragma unroll
            for (int d0 = 0; d0 < 4; ++d0) {
                const bf16x8 k0 = *(const LAS bf16x8*)(kb + d0 * 32);
                const bf16x8 k1 = *(const LAS bf16x8*)(kb + 32 * ROWB + d0 * 32);
                const bf16x8 qa = QREG ? qra[d0] : *(const LAS bf16x8*)(qp + d0 * 1024), qb_ = QREG ? qrb[d0] : *(const LAS bf16x8*)(qp + 4096 + d0 * 1024);
                a0 = __builtin_amdgcn_mfma_f32_32x32x16_bf16(k0, qa, a0, 0, 0, 0);
                b0 = __builtin_amdgcn_mfma_f32_32x32x16_bf16(k0, qb_, b0, 0, 0, 0);
                a1 = __builtin_amdgcn_mfma_f32_32x32x16_bf16(k1, qa, a1, 0, 0, 0);
                b1 = __builtin_amdgcn_mfma_f32_32x32x16_bf16(k1, qb_, b1, 0, 0, 0);
            }
            if (MODE != 0) {
                if (ta.near) apply_general(a0, a1, t0 - kt * 64 - 4 * hi, tab, ta.allow, W);
                if (tb.near) apply_general(b0, b1, t0 + 32 - kt * 64 - 4 * hi, tab, tb.allow, W);
            }
            sm_update2(A[0], A[1], a0, a1, b0, b1);
            const LAS unsigned char* vb = Vt + (4 * hi + q_) * VROWB + (16 * g1 + 4 * p_) * 2;
#pragma unroll
            for (int s = 0; s < 4; ++s) {
                const int bs = 8 * (s & 1);
                u32x4 wa, wb;
                if (s < 2) { wa.x = cvt_pk_bf16(a0[bs + 0], a0[bs + 1]); wa.y = cvt_pk_bf16(a0[bs + 2], a0[bs + 3]); wa.z = cvt_pk_bf16(a0[bs + 4], a0[bs + 5]); wa.w = cvt_pk_bf16(a0[bs + 6], a0[bs + 7]);
                             wb.x = cvt_pk_bf16(b0[bs + 0], b0[bs + 1]); wb.y = cvt_pk_bf16(b0[bs + 2], b0[bs + 3]); wb.z = cvt_pk_bf16(b0[bs + 4], b0[bs + 5]); wb.w = cvt_pk_bf16(b0[bs + 6], b0[bs + 7]); }
                else       { wa.x = cvt_pk_bf16(a1[bs + 0], a1[bs + 1]); wa.y = cvt_pk_bf16(a1[bs + 2], a1[bs + 3]); wa.z = cvt_pk_bf16(a1[bs + 4], a1[bs + 5]); wa.w = cvt_pk_bf16(a1[bs + 6], a1[bs + 7]);
                             wb.x = cvt_pk_bf16(b1[bs + 0], b1[bs + 1]); wb.y = cvt_pk_bf16(b1[bs + 2], b1[bs + 3]); wb.z = cvt_pk_bf16(b1[bs + 4], b1[bs + 5]); wb.w = cvt_pk_bf16(b1[bs + 6], b1[bs + 7]); }
                const bf16x8 pfa = __builtin_bit_cast(bf16x8, wa), pfb = __builtin_bit_cast(bf16x8, wb);
#pragma unroll
                for (int dh = 0; dh < 2; ++dh) {
                    const s16x4 lo4 = vtr(vb + (16 * s) * VROWB + dh * 64);
                    const s16x4 h4 = vtr(vb + (16 * s + 8) * VROWB + dh * 64);
                    const bf16x8 vf = (bf16x8){lo4[0], lo4[1], lo4[2], lo4[3], h4[0], h4[1], h4[2], h4[3]};
                    if (dh == 0) { A[0].o0 = __builtin_amdgcn_mfma_f32_32x32x16_bf16(vf, pfa, A[0].o0, 0, 0, 0); A[1].o0 = __builtin_amdgcn_mfma_f32_32x32x16_bf16(vf, pfb, A[1].o0, 0, 0, 0); }
                    else         { A[0].o1 = __builtin_amdgcn_mfma_f32_32x32x16_bf16(vf, pfa, A[0].o1, 0, 0, 0); A[1].o1 = __builtin_amdgcn_mfma_f32_32x32x16_bf16(vf, pfb, A[1].o1, 0, 0, 0); }
                }
            }
        }
        if (more1) { tile_st(lds + (cur ? L_K0 : L_K1), kreg, tid); tile_stv(lds + (cur ? L_V0 : L_V1), vreg, tid); }
        __syncthreads();
        cur ^= 1;
    }
}
}

struct Ctx { int tid, lane, wid, gtid, gsz, gw, ngw; };

template <int MAP>
__device__ __forceinline__ void xpose_w(const Ctx& c, const float* W, int K, int N, bf16_t* WT, int Ndst, int dst_off = 0) {
    const int nk = K >> 6; const long total = (long)Ndst * nk;
    for (long i = c.gtid; i < total; i += c.gsz) {
        const int n = (int)(i % Ndst), kc = (int)(i / Ndst);
        int src = n;
        if (MAP == 1) { if (n >= 1152 && n < 1408) src = 1188 + (n - 1152); else if (n >= 1408 && n < 1444) src = 1152 + (n - 1408); else if (n >= 1444) src = -1; }
        else if (MAP == 2) { const int tl = n >> 8, wi = n & 255; src = wi < 128 ? tl * 128 + wi : 2816 + tl * 128 + (wi - 128); }
        else if (n >= N) src = -1;
        bf16_t* dst = WT + (size_t)(dst_off + n) * K + kc * 64;
        if (src < 0) {
#pragma unroll
            for (int q = 0; q < 8; ++q) *(u32x4*)(dst + q * 8) = (u32x4){0u, 0u, 0u, 0u};
        } else {
            const float* s = W + (size_t)(kc * 64) * N + src;
            float v[64];
#pragma unroll
            for (int k = 0; k < 64; ++k) v[k] = s[(size_t)k * N];
#pragma unroll
            for (int q = 0; q < 8; ++q) {
                u32x4 w; w.x = cvt_pk_bf16(v[8 * q], v[8 * q + 1]); w.y = cvt_pk_bf16(v[8 * q + 2], v[8 * q + 3]); w.z = cvt_pk_bf16(v[8 * q + 4], v[8 * q + 5]); w.w = cvt_pk_bf16(v[8 * q + 6], v[8 * q + 7]);
                *(u32x4*)(dst + q * 8) = w;
            }
        }
    }
}
__device__ __forceinline__ void cvt_rows(const Ctx& c, const float* X, bf16_t* XB, long nelem) {
    const long n8 = nelem >> 3;
    for (long i0 = c.gtid; i0 < n8; i0 += 4l * c.gsz) {
        f32x4 a[4], b[4];
#pragma unroll
        for (int u = 0; u < 4; ++u) { const long i = i0 + (long)u * c.gsz; if (i < n8) { a[u] = __builtin_nontemporal_load((const f32x4*)(X + i * 8)); b[u] = __builtin_nontemporal_load((const f32x4*)(X + i * 8 + 4)); } }
#pragma unroll
        for (int u = 0; u < 4; ++u) { const long i = i0 + (long)u * c.gsz; if (i < n8) {
            u32x4 w; w.x = cvt_pk_bf16(a[u][0], a[u][1]); w.y = cvt_pk_bf16(a[u][2], a[u][3]); w.z = cvt_pk_bf16(b[u][0], b[u][1]); w.w = cvt_pk_bf16(b[u][2], b[u][3]);
            *(u32x4*)(XB + i * 8) = w; } }
    }
}
__device__ __forceinline__ void prep_late(const Params& p, const Ctx& c) {
    unsigned char* ws = p.ws;
    xpose_w<0>(c, p.in[I_AWOUT], DM, DM, (bf16_t*)(ws + WS_WAOUT), DM);
    xpose_w<0>(c, p.in[I_SWKV], DM, 1536, (bf16_t*)(ws + WS_WSKV), 1536);
    xpose_w<0>(c, p.in[I_BWIN], DM, DM, (bf16_t*)(ws + WS_WBIN), DM);
    xpose_w<0>(c, p.in[I_BWOUT], DM, DM, (bf16_t*)(ws + WS_WBOUT), DM);
    for (int l = 0; l < 2; ++l) {
        xpose_w<2>(c, p.in[I_FWIN] + (size_t)l * DM * 2 * DFF, DM, 2 * DFF, (bf16_t*)(ws + WS_WFIN) + (size_t)l * 2 * DFF * DM, 2 * DFF);
        xpose_w<0>(c, p.in[I_FWOUT] + (size_t)l * DFF * DM, DFF, DM, (bf16_t*)(ws + WS_WFOUT) + (size_t)l * DM * DFF, DM);
    }
}
constexpr int LATE_FIRST_WG = 160;
__device__ __forceinline__ void phase_prep(const Params& p, const Ctx& c) {
    unsigned char* ws = p.ws;
    xpose_w<1>(c, p.in[I_AWIN], DM, AIN, (bf16_t*)(ws + WS_WAIN), AINP);
    xpose_w<0>(c, p.in[I_AWMKV], DM, 512, (bf16_t*)(ws + WS_WMKV), 512, 0);
    xpose_w<0>(c, p.in[I_BWMKV], DM, 512, (bf16_t*)(ws + WS_WMKV), 512, 512);
    xpose_w<0>(c, p.in[I_W1K], 2048, 256, (bf16_t*)(ws + WS_WC1K), 256);
    xpose_w<0>(c, p.in[I_W1V], 2048, 256, (bf16_t*)(ws + WS_WC1V), 256);
    if ((int)gridDim.x < LATE_FIRST_WG + 32) prep_late(p, c);
    cvt_rows(c, p.in[I_X], (bf16_t*)(ws + WS_XB), (long)NTOK * DM);
    cvt_rows(c, p.in[I_MEM], (bf16_t*)(ws + WS_MEMB), (long)BATCH * NMEM * DM);
    for (int o = c.gw; o < 512; o += c.ngw) {
        const int which = o >> 8, j = o & 255;
        const float* pe = p.in[which ? I_PEV : I_PEK]; const float* w1 = p.in[which ? I_W1V : I_W1K];
        float s = 0.f;
#pragma unroll 8
        for (int k = c.lane; k < 2048; k += 64) s += pe[k] * w1[(size_t)k * 256 + j];
#pragma unroll
        for (int sh = 1; sh < 64; sh <<= 1) s += __shfl_xor(s, sh);
        if (c.lane == 0) ((float*)(ws + WS_CBIAS))[which * 256 + j] = s;
    }
}
__device__ __forceinline__ void phase_cmp2(const Params& p, const Ctx& c) {
    unsigned char* ws = p.ws;
    for (int i = c.gtid; i < 2 * 4096 * 64; i += c.gsz) {
        const int which = i >> 18, m = (i >> 6) & 4095, d = i & 63;
        const float* hid = (const float*)(ws + WS_CMPH) + ((size_t)which * 4096 + m) * 256; const float* w2 = p.in[which ? I_W2V : I_W2K];
        float s = 0.f;
#pragma unroll 8
        for (int j = 0; j < 256; ++j) s += hid[j] * w2[j * 64 + d];
        if ((m & 127) == 127) s = 0.f;
        unsigned u = __float_as_uint(s); u = (u + 0x7fffu + ((u >> 16) & 1u)) >> 16;
        ((bf16_t*)(ws + (which ? WS_VCMP : WS_KCMP)))[(size_t)m * 64 + d] = (bf16_t)u;
    }
}
__device__ __forceinline__ void phase_ln(const Ctx& c, const float* y, const float* g, const float* bta, float* xf, bf16_t* xb) {
    for (int row0 = c.gw; row0 < NTOK; row0 += 2 * c.ngw) {
        const int row1 = row0 + c.ngw; const bool has1 = row1 < NTOK;
        const float* y0 = y + (size_t)row0 * DM + c.lane * 4; const float* y1 = y + (size_t)(has1 ? row1 : row0) * DM + c.lane * 4;
        f32x4 v0[4], v1[4]; float s0 = 0.f, s1 = 0.f;
#pragma unroll
        for (int j = 0; j < 4; ++j) { v0[j] = *(const f32x4*)(y0 + 256 * j); v1[j] = *(const f32x4*)(y1 + 256 * j); }
#pragma unroll
        for (int j = 0; j < 4; ++j) { s0 += (v0[j][0] + v0[j][1]) + (v0[j][2] + v0[j][3]); s1 += (v1[j][0] + v1[j][1]) + (v1[j][2] + v1[j][3]); }
#pragma unroll
        for (int o = 1; o < 64; o <<= 1) { s0 += __shfl_xor(s0, o); s1 += __shfl_xor(s1, o); }
        const float m0 = s0 * (1.0f / DM), m1 = s1 * (1.0f / DM); float q0 = 0.f, q1 = 0.f;
#pragma unroll
        for (int j = 0; j < 4; ++j) { v0[j] = v0[j] - m0; v1[j] = v1[j] - m1;
            q0 += (v0[j][0] * v0[j][0] + v0[j][1] * v0[j][1]) + (v0[j][2] * v0[j][2] + v0[j][3] * v0[j][3]);
            q1 += (v1[j][0] * v1[j][0] + v1[j][1] * v1[j][1]) + (v1[j][2] * v1[j][2] + v1[j][3] * v1[j][3]); }
#pragma unroll
        for (int o = 1; o < 64; o <<= 1) { q0 += __shfl_xor(q0, o); q1 += __shfl_xor(q1, o); }
        const float r0 = 1.0f / sqrtf(q0 * (1.0f / DM) + LN_EPS), r1 = 1.0f / sqrtf(q1 * (1.0f / DM) + LN_EPS);
#pragma unroll
        for (int j = 0; j < 4; ++j) {
            const f32x4 gg = *(const f32x4*)(g + c.lane * 4 + 256 * j), bb = *(const f32x4*)(bta + c.lane * 4 + 256 * j);
            const f32x4 o0 = v0[j] * r0 * gg + bb, o1 = v1[j] * r1 * gg + bb;
            if (xf) { *(f32x4*)(xf + (size_t)row0 * DM + c.lane * 4 + 256 * j) = o0; if (has1) *(f32x4*)(xf + (size_t)row1 * DM + c.lane * 4 + 256 * j) = o1; }
            if (xb) { u32x2 w; w.x = cvt_pk_bf16(o0[0], o0[1]); w.y = cvt_pk_bf16(o0[2], o0[3]); *(u32x2*)(xb + (size_t)row0 * DM + c.lane * 4 + 256 * j) = w;
                if (has1) { u32x2 w1; w1.x = cvt_pk_bf16(o1[0], o1[1]); w1.y = cvt_pk_bf16(o1[2], o1[3]); *(u32x2*)(xb + (size_t)row1 * DM + c.lane * 4 + 256 * j) = w1; } }
        }
    }
}
__device__ __forceinline__ void unpack8(const u32x4 w, float (&f)[8]) {
    f[0] = __uint_as_float(w.x << 16); f[1] = __uint_as_float(w.x & 0xffff0000u); f[2] = __uint_as_float(w.y << 16); f[3] = __uint_as_float(w.y & 0xffff0000u);
    f[4] = __uint_as_float(w.z << 16); f[5] = __uint_as_float(w.z & 0xffff0000u); f[6] = __uint_as_float(w.w << 16); f[7] = __uint_as_float(w.w & 0xffff0000u);
}
__device__ __forceinline__ void ffn_fixup(const Ctx& c, unsigned char* big, const float* cw, const float* cbias, int pm) {
    const float* TAILA = (const float*)(big + BIG_TAILA); const float* HEADA = (const float*)(big + BIG_HEADA); const float* HEADB = (const float*)(big + BIG_HEADB); bf16_t* H = (bf16_t*)(big + BIG_H);
    constexpr int NCH = DFF / 8;
    for (int it = c.tid; it < 4 * 2 * NCH; it += NTHR) {
        const int ch = it % NCH, gi = it / NCH, i = gi & 1, G = pm * 4 + (gi >> 1), col = ch * 8;
        const bool first = ((G * 64) & (SEQ - 1)) == 0;
        float p0[8], p1[8], a0[8], a1[8], b[8], h[8];
#pragma unroll
        for (int j = 0; j < 8; ++j) { p0[j] = 0.f; p1[j] = 0.f; }
        if (!first) {
            const float* t0 = TAILA + ((size_t)(G - 1) * 2) * DFF + col;
#pragma unroll
            for (int j = 0; j < 8; ++j) { p0[j] = t0[j]; p1[j] = t0[DFF + j]; }
        }
        const float* ha = HEADA + ((size_t)G * 2) * DFF + col; const float* hb = HEADB + ((size_t)G * 2 + i) * DFF + col;
#pragma unroll
        for (int j = 0; j < 8; ++j) { a0[j] = ha[j]; a1[j] = ha[DFF + j]; b[j] = hb[j]; }
#pragma unroll
        for (int j = 0; j < 8; ++j) {
            const float am2 = i ? p1[j] : p0[j], am1 = i ? a0[j] : p1[j], a = i ? a1[j] : a0[j];
            const float pre = cw[col + j] * am2 + cw[DFF + col + j] * am1 + cw[2 * DFF + col + j] * a + cbias[col + j];
            h[j] = gelu_tanh(pre) * b[j];
        }
        u32x4 w; w.x = cvt_pk_bf16(h[0], h[1]); w.y = cvt_pk_bf16(h[2], h[3]); w.z = cvt_pk_bf16(h[4], h[5]); w.w = cvt_pk_bf16(h[6], h[7]);
        *(u32x4*)(H + (size_t)(G * 64 + i) * DFF + col) = w;
    }
}
__device__ __forceinline__ void phase_kmean(const Ctx& c, const bf16_t* KV, float* KM) {
    for (int it = c.gw; it < BATCH * 8 * 12; it += c.ngw) {
        const int cg_ = it % 12, bn = it / 12, ch = c.lane & 7, rs = c.lane >> 3;
        float s[8];
#pragma unroll
        for (int j = 0; j < 8; ++j) s[j] = 0.f;
        const bf16_t* src = KV + (size_t)bn * 256 * KVP + cg_ * 64 + ch * 8;
#pragma unroll 4
        for (int r = rs; r < 256; r += 8) { float v[8]; unpack8(*(const u32x4*)(src + (size_t)r * KVP), v);
#pragma unroll
            for (int j = 0; j < 8; ++j) s[j] += v[j]; }
#pragma unroll
        for (int j = 0; j < 8; ++j) { s[j] += __shfl_xor(s[j], 8); s[j] += __shfl_xor(s[j], 16); s[j] += __shfl_xor(s[j], 32); }
        if (rs == 0) {
#pragma unroll
            for (int j = 0; j < 8; ++j) KM[(size_t)bn * 768 + cg_ * 64 + ch * 8 + j] = s[j] * (1.0f / 256.0f);
        }
    }
}

__device__ __forceinline__ void nsa1_unit(const Params& p, LAS unsigned char* lds, int b, int qb) {
    using namespace att;
    int tid_ = threadIdx.x; asm volatile("" : "+v"(tid_));
    const int tid = tid_, lane = tid & 63, r32 = lane & 31, hi = lane >> 5, wid = tid >> 6;
    unsigned char* ws = p.ws;
    const bf16_t* P = (const bf16_t*)(ws + WS_BIG + BIG_P); bf16_t* O = (bf16_t*)(ws + WS_BIG + BIG_O0);
    const bf16_t* KC = (const bf16_t*)(ws + WS_KCMP) + (size_t)b * 128 * 64; const bf16_t* VC = (const bf16_t*)(ws + WS_VCMP) + (size_t)b * 128 * 64;
    __syncthreads();
    tile_st(lds + L_K0, tile_ld(KC, 64, 0, 0, 127, tid), tid); tile_st(lds + L_K1, tile_ld(KC, 64, 64, 0, 127, tid), tid);
    tile_stv(lds + L_V0, tile_ld(VC, 64, 0, 0, 127, tid), tid); tile_stv(lds + L_V1, tile_ld(VC, 64, 64, 0, 127, tid), tid);
    fill_tab(lds, p.in[I_RELB], 0, NH, tid);
    __syncthreads();
    const int t = qb * 256 + wid * 32 + r32; const size_t row = (size_t)b * SEQ + t;
    LAS float* simp = (LAS float*)(lds + L_SIMP) + (wid * 32 + r32) * 33;
#pragma unroll
    for (int i = 0; i < 16; ++i) simp[2 * i + hi] = 0.f;
#pragma nounroll
    for (int h = 0; h < NH; ++h) {
        bf16x8 qr[4]; load_q(qr, P + row * AINP + P_Q + h * 64, hi);
        f32x16 pp[4];
        qk_tile(pp[0], pp[1], lds + L_K0, qr, r32, hi); qk_tile(pp[2], pp[3], lds + L_K1, qr, r32, hi);
        const LAS float* tab = (const LAS float*)(lds + L_TAB) + h * 132;
        float mx = NEG;
        const int tws = __builtin_amdgcn_readfirstlane(t - r32);
#pragma unroll
        for (int a = 0; a < 4; ++a) {
            if (tws >= 512 * a + 655) { const float bb = tab[129];
#pragma unroll
                for (int r = 0; r < 16; ++r) { const float s = pp[a][r] + bb; pp[a][r] = s; mx = fmaxf(mx, s); } }
            else if (tws < 512 * a) {
#pragma unroll
                for (int r = 0; r < 16; ++r) pp[a][r] = NEG; }
            else {
#pragma unroll
                for (int r = 0; r < 16; ++r) { const int n = (r & 3) + 8 * (r >> 2) + 4 * hi + 32 * a; const int d = t - 30 - 16 * n;
                    const float s = pp[a][r] + tab[min(max(d, 0), 129)]; pp[a][r] = s; mx = fmaxf(mx, s); } }
        }
        mx = fmaxf(mx, __shfl_xor(mx, 32));
        const bool dead = mx < -5e29f;
        const float msc = (dead ? 0.f : mx) * SC2;
        float sum = 0.f;
#pragma unroll
        for (int a = 0; a < 4; ++a)
#pragma unroll
            for (int r = 0; r < 16; ++r) { const float e = __builtin_amdgcn_exp2f(pp[a][r] * SC2 - msc); pp[a][r] = e; sum += e; }
        sum += __shfl_xor(sum, 32);
        const float inv = dead ? 0.f : 1.0f / fmaxf(sum, 1e-30f);
#pragma unroll
        for (int a = 0; a < 4; ++a)
#pragma unroll
            for (int r = 0; r < 16; ++r) pp[a][r] *= inv;
#pragma unroll
        for (int a = 0; a < 4; ++a)
#pragma unroll
            for (int g = 0; g < 4; ++g) {
                const float gs = (pp[a][4 * g] + pp[a][4 * g + 1]) + (pp[a][4 * g + 2] + pp[a][4 * g + 3]);
                const float lastv = pp[a][4 * g + 3];
                const float shifted = (g >= 1) ? pp[a][4 * (g - 1) + 3] : ((a >= 1) ? pp[(a >= 1) ? a - 1 : 0][15] : 0.f);
                const float snd = hi ? shifted : lastv;
                const float rcv = __shfl_xor(snd, 32);
                simp[8 * a + 2 * g + hi] += gs + rcv;
            }
        f32x16 o0 = zero16(), o1 = zero16();
        pv_tile(o0, o1, lds + L_V0, pp[0], pp[1], lane); pv_tile(o0, o1, lds + L_V1, pp[2], pp[3], lane);
        const float gate = sigmoidf(bf2f(P[row * AINP + P_G + h * 3 + 0]));
#pragma unroll
        for (int r = 0; r < 16; ++r) { o0[r] *= gate; o1[r] *= gate; }
        store_o(O + row * DM + h * 64, o0, o1, hi);
    }
    __syncthreads();
    const int cur = t >> 6; unsigned mask;
    if (cur < 16) mask = (2u << cur) - 1u;
    else {
        mask = 1u | (1u << cur) | (1u << (cur - 1));
        unsigned cand = ((1u << (cur - 1)) - 1u) & ~1u;
#pragma nounroll
        for (int k = 0; k < 13; ++k) {
            float best = -3e38f; int bi = 0;
#pragma nounroll
            for (int s = 1; s <= 29; ++s) { const float v = simp[s]; const bool take = ((cand >> s) & 1u) && (v > best); best = take ? v : best; bi = take ? s : bi; }
            mask |= 1u << bi; cand &= ~(1u << bi);
        }
    }
    if (hi == 0) ((unsigned*)(ws + WS_SEL))[row] = mask;
}
__device__ __forceinline__ void nsa2_unit(const Params& p, LAS unsigned char* lds, int b, int h0, int qb) {
    using namespace att;
    int tid_ = threadIdx.x; asm volatile("" : "+v"(tid_));
    const int tid = tid_, lane = tid & 63, r32 = lane & 31, hi = lane >> 5, wid = tid >> 6;
    unsigned char* ws = p.ws;
    const bf16_t* P = (const bf16_t*)(ws + WS_BIG + BIG_P); bf16_t* O = (bf16_t*)(ws + WS_BIG + BIG_O0);
    __syncthreads();
    fill_tab(lds, p.in[I_RELB], h0, 2, tid);
    const int h = h0 + (wid >> 2);
    const LAS float* tab = (const LAS float*)(lds + L_TAB) + (wid >> 2) * 132;
    const int tw0 = qb * 256 + (wid & 3) * 64, t0 = tw0 + r32; const size_t row0 = (size_t)b * SEQ + t0, row1 = row0 + 32;
    const LAS unsigned char* qp = park_q(lds, P + row0 * AINP + P_Q + h * 64, P + row1 * AINP + P_Q + h * 64, wid, lane, hi);
    const unsigned sel0 = ((const unsigned*)(ws + WS_SEL))[row0], sel1 = ((const unsigned*)(ws + WS_SEL))[row1];
    const bf16_t* Pb = P + (size_t)b * SEQ * AINP;
    Acc A[2]; acc_init(A[0]); acc_init(A[1]);
    seg2<1, false>(A, lds, Pb + P_KS, Pb + P_VS, AINP, SEQ - 1, 0, qb * 4 + 4, qp, t0, tw0, sel0, sel1, 0, 1 << 30, tab, tid);
#pragma unroll
    for (int s = 0; s < 2; ++s) {
        const size_t row = s ? row1 : row0;
        const float gs = sigmoidf(bf2f(P[row * AINP + P_G + h * 3 + 1])) * acc_inv(A[s]);
#pragma unroll
        for (int r = 0; r < 16; ++r) { A[s].o0[r] *= gs; A[s].o1[r] *= gs; }
        bf16_t* orow = O + row * DM + h * 64;
        add_prev_o(orow, A[s].o0, A[s].o1, hi); store_o(orow, A[s].o0, A[s].o1, hi);
        acc_init(A[s]);
    }
    const int wlo = qb * 4 - 8 < 0 ? 0 : qb * 4 - 8;
    seg2<2, false>(A, lds, Pb + P_KW, Pb + P_VW, AINP, SEQ - 1, wlo, qb * 4 + 4, qp, t0, tw0, 0u, 0u, 0, 512, tab, tid);
#pragma unroll
    for (int s = 0; s < 2; ++s) {
        const size_t row = s ? row1 : row0;
        const float gw = sigmoidf(bf2f(P[row * AINP + P_G + h * 3 + 2])) * acc_inv(A[s]);
#pragma unroll
        for (int r = 0; r < 16; ++r) { A[s].o0[r] *= gw; A[s].o1[r] *= gw; }
        bf16_t* orow = O + row * DM + h * 64;
        add_prev_o(orow, A[s].o0, A[s].o1, hi); store_o(orow, A[s].o0, A[s].o1, hi);
    }
}
__device__ __forceinline__ unsigned moba_select(const float* KM, const bf16x8 (&qr)[4], int b, int h, int qb, int hi) {
    float gt[7];
#pragma unroll
    for (int n = 0; n < 7; ++n) {
        float s = 0.f;
        if (n < qb) {
            const float* km = KM + ((size_t)(b * 8 + n) * NH + h) * 64 + hi * 8;
#pragma unroll
            for (int d0 = 0; d0 < 4; ++d0) { const f32x4 k0 = *(const f32x4*)(km + d0 * 16), k1 = *(const f32x4*)(km + d0 * 16 + 4);
                s += bf2f((unsigned short)qr[d0][0]) * k0[0] + bf2f((unsigned short)qr[d0][1]) * k0[1] + bf2f((unsigned short)qr[d0][2]) * k0[2] + bf2f((unsigned short)qr[d0][3]) * k0[3]
                   + bf2f((unsigned short)qr[d0][4]) * k1[0] + bf2f((unsigned short)qr[d0][5]) * k1[1] + bf2f((unsigned short)qr[d0][6]) * k1[2] + bf2f((unsigned short)qr[d0][7]) * k1[3]; }
        }
        s += __shfl_xor(s, 32);
        gt[n] = s;
    }
    unsigned sel = 1u << qb, cand = (1u << qb) - 1u;
#pragma nounroll
    for (int k = 0; k < 3; ++k) {
        float best = -3e38f; int bi = -1;
#pragma unroll
        for (int n = 0; n < 7; ++n) { const bool take = ((cand >> n) & 1u) && (gt[n] > best); best = take ? gt[n] : best; bi = take ? n : bi; }
        if (bi >= 0) { sel |= 1u << bi; cand &= ~(1u << bi); }
    }
    return sel;
}
__device__ __forceinline__ void moba_unit(const Params& p, LAS unsigned char* lds, int b, int h, int qp) {
    using namespace att;
    int tid_ = threadIdx.x; asm volatile("" : "+v"(tid_));
    const int tid = tid_, lane = tid & 63, r32 = lane & 31, hi = lane >> 5, wid = tid >> 6;
    unsigned char* ws = p.ws;
    const bf16_t* KV = (const bf16_t*)(ws + WS_BIG + BIG_KV); const bf16_t* Q = KV + KV_Q; bf16_t* O = (bf16_t*)(ws + WS_BIG + BIG_O1);
    const float* KM = (const float*)(ws + WS_KMEAN);
    __syncthreads();
    fill_tab(lds, p.in[I_RELB], h, 1, tid);
    const LAS float* tab = (const LAS float*)(lds + L_TAB);
    const int qb = 2 * qp + (wid >> 2);
    const int tw0 = qb * 256 + (wid & 3) * 64, t0 = tw0 + r32; const size_t row0 = (size_t)b * SEQ + t0, row1 = row0 + 32;
    unsigned sel0, sel1;
    { bf16x8 qr[4]; load_q(qr, Q + row0 * KVP + h * 64, hi); sel0 = moba_select(KM, qr, b, h, qb, hi); }
    { bf16x8 qr[4]; load_q(qr, Q + row1 * KVP + h * 64, hi); sel1 = moba_select(KM, qr, b, h, qb, hi); }
    const LAS unsigned char* qp_ = park_q(lds, Q + row0 * KVP + h * 64, Q + row1 * KVP + h * 64, wid, lane, hi);
    const bf16_t* Kb = KV + (size_t)b * SEQ * KVP + h * 64;
    Acc A[2]; acc_init(A[0]); acc_init(A[1]);
    seg2<1, true>(A, lds, Kb, Kb + MAINW, KVP, SEQ - 1, 0, qp * 8 + 8, qp_, t0, tw0, sel0, sel1, 2, 1 << 30, tab, tid);
#pragma unroll
    for (int s = 0; s < 2; ++s) {
        const float inv = acc_inv(A[s]);
#pragma unroll
        for (int r = 0; r < 16; ++r) { A[s].o0[r] *= inv; A[s].o1[r] *= inv; }
        store_o(O + (s ? row1 : row0) * DM + h * 64, A[s].o0, A[s].o1, hi);
    }
}
__device__ __forceinline__ void mem_unit(const Params& p, LAS unsigned char* lds, const bf16_t* Q, int ldq, int qcol, bf16_t* O, int kvcol, int b, int mh, int qq) {
    using namespace att;
    int tid_ = threadIdx.x; asm volatile("" : "+v"(tid_));
    const int tid = tid_, lane = tid & 63, r32 = lane & 31, hi = lane >> 5, wid = tid >> 6;
    const bf16_t* MKV = (const bf16_t*)(p.ws + WS_MKV) + (size_t)b * NMEM * 1024 + kvcol + mh * 64;
    const int tw0 = qq * 512 + wid * 64, t0 = tw0 + r32; const size_t row0 = (size_t)b * SEQ + t0, row1 = row0 + 32;
    __syncthreads();
    const LAS unsigned char* qp = park_q(lds, Q + row0 * ldq + qcol + mh * 64, Q + row1 * ldq + qcol + mh * 64, wid, lane, hi);
    Acc A[2]; acc_init(A[0]); acc_init(A[1]);
    seg2<0, true>(A, lds, MKV, MKV + 256, 1024, NMEM - 1, 0, 4, qp, t0, tw0, 0u, 0u, 0, 1 << 30, (const LAS float*)(lds + L_TAB), tid);
#pragma unroll
    for (int s = 0; s < 2; ++s) {
        const float inv = acc_inv(A[s]);
#pragma unroll
        for (int r = 0; r < 16; ++r) { A[s].o0[r] *= inv; A[s].o1[r] *= inv; }
        store_o(O + (s ? row1 : row0) * DM + MAINW + mh * 64, A[s].o0, A[s].o1, hi);
    }
}

#define XB_TMO      128
#define XB_XCNT(j)  (256  + 64 * (j))
#define XB_XSUB(j)  (1280 + 64 * (j))
#define XB_XGEN(j)  (2304 + 64 * (j))
#define XB_TOP      3328
#define XB_TOPGEN   3392
#define XCD_BAR_WORDS 3456
#define XB_SPIN_CAP (1u << 18)
__device__ __forceinline__ unsigned xb_ld(unsigned* p)              { return __hip_atomic_load(p, __ATOMIC_RELAXED, __HIP_MEMORY_SCOPE_AGENT); }
__device__ __forceinline__ unsigned xb_add(unsigned* p, unsigned v) { return __hip_atomic_fetch_add(p, v, __ATOMIC_RELAXED, __HIP_MEMORY_SCOPE_AGENT); }
__device__ __forceinline__ unsigned xb_xcc_id() { return (unsigned)__builtin_amdgcn_s_getreg((3 << 11) | 20) & 0xFu; }
#define XB_SPIN(cond, bar) do { unsigned _sp = 0; while (cond) { __builtin_amdgcn_s_sleep(1); \
    if ((++_sp & 255u) == 0u) { if (xb_ld(&(bar)[XB_TMO])) break; if (_sp > XB_SPIN_CAP) { atomicAdd(&(bar)[XB_TMO], 1u); break; } } } } while (0)
struct XcdBarrier { unsigned* bar; unsigned x; volatile LAS unsigned* st; };
__device__ __forceinline__ XcdBarrier xcd_barrier_post(unsigned* bar, volatile LAS unsigned* st) {
    XcdBarrier b; b.bar = bar; b.x = xb_xcc_id(); b.st = st;
    if (threadIdx.x == 0) (void)xb_add(&bar[XB_XCNT(b.x)], 1u);
    return b;
}
__device__ __forceinline__ void xcd_barrier_complete(unsigned* bar, unsigned x, unsigned& nloc, unsigned& nx) {
    const unsigned G = gridDim.x * gridDim.y * gridDim.z;
    unsigned sum, cnt, mine, sp = 0u;
    for (;;) {
        sum = 0u; cnt = 0u; mine = 0u;
#pragma unroll
        for (unsigned j = 0; j < 16; ++j) { const unsigned c = xb_ld(&bar[XB_XCNT(j)]); sum += c; cnt += (c > 0u) ? 1u : 0u; mine = (j == x) ? c : mine; }
        if (sum == G) break;
        __builtin_amdgcn_s_sleep(1);
        if ((++sp & 255u) == 0u) { if (xb_ld(&bar[XB_TMO])) break; if (sp > XB_SPIN_CAP) { atomicAdd(&bar[XB_TMO], 1u); break; } }
    }
    nloc = mine > 0u ? mine : 1u; nx = cnt > 0u ? cnt : 1u;
}
__device__ __forceinline__ void xcd_barrier(const XcdBarrier& b) {
    asm volatile("s_waitcnt vmcnt(0)" ::: "memory");
    __syncthreads();
    if (threadIdx.x == 0) {
        unsigned* bar = b.bar;
        __builtin_amdgcn_s_waitcnt(0);
        unsigned nloc = b.st[0], nx = b.st[1];
        if (nloc == 0u) { xcd_barrier_complete(bar, b.x, nloc, nx); b.st[0] = nloc; b.st[1] = nx; }
        const unsigned old = xb_add(&bar[XB_XSUB(b.x)], 1u);
        const unsigned gen = old / nloc;
        if (old + 1u == (gen + 1u) * nloc) {
            __builtin_amdgcn_fence(__ATOMIC_RELEASE, "agent");
            asm volatile("s_waitcnt vmcnt(0)" ::: "memory");
            const unsigned og = xb_add(&bar[XB_TOP], 1u);
            const unsigned tg = og / nx;
            if (og + 1u == (tg + 1u) * nx) xb_add(&bar[XB_TOPGEN], 1u);
            else XB_SPIN(xb_ld(&bar[XB_TOPGEN]) == tg, bar);
            __builtin_amdgcn_fence(__ATOMIC_ACQUIRE, "agent");
            xb_add(&bar[XB_XGEN(b.x)], 1u);
            asm volatile("s_waitcnt vmcnt(0)" ::: "memory");
        } else {
            XB_SPIN(xb_ld(&bar[XB_XGEN(b.x)]) == gen, bar);
            __builtin_amdgcn_fence(__ATOMIC_ACQUIRE, "agent");
            asm volatile("s_waitcnt vmcnt(0)" ::: "memory");
        }
    }
    __syncthreads();
}

enum { PH_PREP = 0, PH_A_GEMM, PH_A_CMP1, PH_A_CMP2, PH_A_NSA1, PH_A_NSA2, PH_A_OUT, PH_A_LN1, PH_A_F0, PH_A_FIX, PH_A_F1, PH_A_LN2,
       PH_B_GEMM, PH_B_KMEAN, PH_B_ATT, PH_B_OUT, PH_B_LN1, PH_B_F0, PH_B_FIX, PH_B_F1, PH_B_LN2, PH_COUNT };

struct GemmJob { pg8::Gemm g; int epi; void* O; const float* aux; const float* aux2; int ldc; int coff; };
__device__ __forceinline__ void set_job(GemmJob& J, const bf16_t* A, const bf16_t* Bt, int M, int N, int K, int lda, int epi, void* O, const float* aux, int ldc) {
    J.g.A = A; J.g.Bt = Bt; J.g.M = M; J.g.N = N; J.g.K = K; J.g.lda = lda; J.g.kstepA = 128; J.epi = epi; J.O = O; J.aux = aux; J.aux2 = nullptr; J.ldc = ldc; J.coff = 0;
}
__device__ __forceinline__ bool gemm_job(const Params& p, int ph, int j, GemmJob& J) {
    unsigned char* ws = p.ws;
    const bf16_t* XB = (const bf16_t*)(ws + WS_XB); const float* XF = (const float*)XB;
    unsigned char* big = ws + WS_BIG;
    const int layer = ph >= PH_B_GEMM ? 1 : 0;
    const bf16_t* Win = (const bf16_t*)(ws + WS_WFIN) + (size_t)layer * 2 * DFF * DM; const bf16_t* Wout = (const bf16_t*)(ws + WS_WFOUT) + (size_t)layer * DM * DFF;
    if (ph == PH_A_GEMM) {
        if (j == 0) { set_job(J, XB, (const bf16_t*)(ws + WS_WAIN), NTOK, AINP, DM, DM, 0, big + BIG_P, nullptr, AINP); return true; }
        return false;
    }
    if (ph == PH_A_CMP1) {
        if (j == 2) { set_job(J, (const bf16_t*)(ws + WS_MEMB), (const bf16_t*)(ws + WS_WMKV), BATCH * NMEM, 1024, DM, DM, 0, ws + WS_MKV, nullptr, 1024); J.coff = 32; return true; }
        if (j >= 3) return false;
        const bf16_t* P = (const bf16_t*)(big + BIG_P);
        set_job(J, P + (j ? P_VC : P_KC), (const bf16_t*)(ws + (j ? WS_WC1V : WS_WC1K)), 4096, 256, 2048, 16 * AINP, 1, (float*)(ws + WS_CMPH) + (size_t)j * 4096 * 256, (const float*)(ws + WS_CBIAS) + j * 256, 256);
        J.g.kstepA = AINP * 2; J.coff = j * 16; return true;
    }
    if (ph == PH_A_OUT) { if (j) return false; set_job(J, (const bf16_t*)(big + BIG_O0), (const bf16_t*)(ws + WS_WAOUT), NTOK, DM, DM, DM, 2, p.out, p.in[I_X], DM); return true; }
    if (ph == PH_B_OUT) { if (j) return false; set_job(J, (const bf16_t*)(big + BIG_O1), (const bf16_t*)(ws + WS_WBOUT), NTOK, DM, DM, DM, 4, p.out, XF, DM); return true; }
    if (ph == PH_B_GEMM) {
        if (j == 0) { set_job(J, XB, (const bf16_t*)(ws + WS_WSKV), NTOK, KVP, DM, DM, 0, big + BIG_KV, nullptr, KVP); return true; }
        return false;
    }
    const int f = layer ? ph - PH_B_F0 : ph - PH_A_F0;
    if (j) return false;
    if (f == 0) { set_job(J, XB, Win, NTOK, 2 * DFF, DM, DM, 3, big + BIG_H, p.in[I_FCW] + (size_t)layer * 3 * DFF, DFF); J.aux2 = p.in[I_FCB] + (size_t)layer * DFF; return true; }
    if (f == 2) { set_job(J, (const bf16_t*)(big + BIG_H), Wout, NTOK, DM, DFF, DFF, 4, p.out, XF, DM); return true; }
    return false;
}
__device__ __forceinline__ bool is_gemm_phase(int ph) {
    return ph == PH_A_GEMM || ph == PH_A_CMP1 || ph == PH_A_OUT || ph == PH_B_OUT || ph == PH_B_GEMM || ph == PH_A_F0 || ph == PH_A_F1 || ph == PH_B_F0 || ph == PH_B_F1;
}
template <int JJ>
__device__ __forceinline__ void run_gemm_job(const Params& p, LAS unsigned char* lds, int ph) {
    GemmJob J;
    if (!gemm_job(p, ph, JJ, J)) return;
    pg8::StaticOrder S; S.init(J.g.M, J.g.N, (int)gridDim.x, (int)blockIdx.x - J.coff);
    if (J.epi == 0) { pg8::EpiBf16 E{(bf16_t*)J.O, J.ldc}; pg8::gemm_phase<pg8::EpiBf16>(lds, J.g, S, E); }
    else if (J.epi == 1) { pg8::EpiF32BiasGelu E{(float*)J.O, J.ldc, J.aux}; pg8::gemm_phase<pg8::EpiF32BiasGelu>(lds, J.g, S, E); }
    else if (J.epi == 3) { unsigned char* big = p.ws + WS_BIG; pg8::EpiConvGate E{(bf16_t*)J.O, J.aux, J.aux2, (float*)(big + BIG_TAILA), (float*)(big + BIG_HEADA), (float*)(big + BIG_HEADB)}; pg8::gemm_phase<pg8::EpiConvGate>(lds, J.g, S, E); }
    else if (J.epi == 2) { pg8::EpiResF32<true> E{J.aux, (float*)J.O, J.ldc, ALPHA}; pg8::gemm_phase<pg8::EpiResF32<true>>(lds, J.g, S, E); }
    else { pg8::EpiResF32<false> E{J.aux, (float*)J.O, J.ldc, ALPHA}; pg8::gemm_phase<pg8::EpiResF32<false>>(lds, J.g, S, E); }
}
__device__ __forceinline__ void run_gemm_phase(const Params& p, LAS unsigned char* lds, int ph) {
    run_gemm_job<0>(p, lds, ph); run_gemm_job<1>(p, lds, ph); run_gemm_job<2>(p, lds, ph);
}

__device__ __forceinline__ void run_phase(const Params& p, LAS unsigned char* lds, const Ctx& c, int ph) {
    unsigned char* ws = p.ws;
    bf16_t* XB = (bf16_t*)(ws + WS_XB);
    const int G = (int)gridDim.x, bid = (int)blockIdx.x;
    const int vid = (G % 8 == 0) ? (bid % 8) * (G / 8) + bid / 8 : bid;
    if (ph == PH_A_FIX || ph == PH_B_FIX) {
        const int layer = ph == PH_B_FIX ? 1 : 0;
        for (int pm = bid; pm < NTOK / 256; pm += G) ffn_fixup(c, ws + WS_BIG, p.in[I_FCW] + (size_t)layer * 3 * DFF, p.in[I_FCB] + (size_t)layer * DFF, pm);
        return;
    }
    if (ph == PH_A_CMP1 && G >= LATE_FIRST_WG + 32 && bid >= LATE_FIRST_WG) {
        Ctx c2 = c; c2.gtid = (bid - LATE_FIRST_WG) * NTHR + c.tid; c2.gsz = (G - LATE_FIRST_WG) * NTHR;
        prep_late(p, c2);
    }
    if (is_gemm_phase(ph)) { run_gemm_phase(p, lds, ph); return; }
    switch (ph) {
    case PH_PREP: phase_prep(p, c); break;
    case PH_A_CMP2: phase_cmp2(p, c); break;
    case PH_A_NSA1: {
        for (int u = vid; u < BATCH * 8; u += G) nsa1_unit(p, lds, u >> 3, u & 7);
    } break;
    case PH_A_NSA2: {
        for (int u = vid; u < BATCH * (NH / 2) * 4; u += G) { const int b = u / 24, r = u % 24, hp = r >> 2, s = (r + u / G) & 3;
#pragma nounroll
            for (int k = 0; k < 2; ++k) nsa2_unit(p, lds, b, 2 * hp, k ? s : 7 - s); }
    } break;
    case PH_B_ATT: {
        for (int u = vid; u < BATCH * NH * 2; u += G) { const int b = u / 24, r = u % 24, h = r >> 1, s = r & 1;
#pragma nounroll
            for (int k = 0; k < 2; ++k) moba_unit(p, lds, b, h, k ? s : 3 - s); }
    } break;
    case PH_A_LN1: case PH_B_LN1: case PH_A_LN2: case PH_B_LN2: {
        const int layer = ph >= PH_B_GEMM ? 1 : 0; const bool second = (ph == PH_A_LN2 || ph == PH_B_LN2); const bool fin = (ph == PH_B_LN2);
        phase_ln(c, p.out, p.in[second ? I_LN2G : I_LN1G] + layer * DM, p.in[second ? I_LN2B : I_LN1B] + layer * DM, fin ? p.out : nullptr, fin ? nullptr : XB);
    } break;
    case PH_B_KMEAN: phase_kmean(c, (const bf16_t*)(ws + WS_BIG + BIG_KV), (float*)(ws + WS_KMEAN)); break;
    default: break;
    }
    if (ph == PH_A_NSA1 || ph == PH_B_ATT) {
        const bool la = (ph == PH_A_NSA1);
        const bf16_t* Q = (const bf16_t*)(ws + WS_BIG + (la ? BIG_P : BIG_KV)) + (la ? 0 : KV_Q); bf16_t* O = (bf16_t*)(ws + WS_BIG + (la ? BIG_O0 : BIG_O1));
        for (int u = vid; u < BATCH * 4 * 4; u += G) mem_unit(p, lds, Q, la ? AINP : KVP, la ? P_QM : MAINW, O, la ? 0 : 512, u >> 4, (u >> 2) & 3, u & 3);
    }
}

template <int PH>
__device__ __forceinline__ void phase_seq(const Params& p, LAS unsigned char* lds, const Ctx& c, cg::grid_group& grid, const XcdBarrier& bar) {
    if constexpr (PH < PH_COUNT) {
        if (PH >= p.ph_lo && PH < p.ph_hi) {
            Ctx cc; { int t_ = threadIdx.x; asm volatile("" : "+v"(t_)); cc.tid = t_; cc.lane = t_ & 63; cc.wid = t_ >> 6; cc.gtid = blockIdx.x * NTHR + t_; cc.gsz = gridDim.x * NTHR; cc.gw = blockIdx.x * (NTHR / 64) + cc.wid; cc.ngw = gridDim.x * (NTHR / 64); }
            run_phase(p, lds, cc, PH); if (PH + 1 < p.ph_hi) xcd_barrier(bar); }
        phase_seq<PH + 1>(p, lds, c, grid, bar);
    }
}
__global__ void __launch_bounds__(NTHR) yoco_mega(Params p) {
    extern __shared__ __attribute__((aligned(16))) unsigned char lds_raw[];
    LAS unsigned char* lds = (LAS unsigned char*)lds_raw;
    cg::grid_group grid = cg::this_grid();
    Ctx c; c.tid = threadIdx.x; c.lane = c.tid & 63; c.wid = c.tid >> 6; c.gtid = blockIdx.x * NTHR + c.tid; c.gsz = gridDim.x * NTHR; c.gw = blockIdx.x * (NTHR / 64) + c.wid; c.ngw = gridDim.x * (NTHR / 64);
    if (c.tid < 130) ((LAS int*)(lds + att::L_BKT))[c.tid] = c.tid == 0 ? 0 : att::rel_bucket(c.tid - 1);
    if (c.tid < 2) ((LAS unsigned*)(lds + att::L_MISC))[c.tid] = 0u;
    __syncthreads();
    if (p.ph_lo == -12345) grid.sync();
    const XcdBarrier bar = xcd_barrier_post((unsigned*)(p.ws + WS_CTL), (volatile LAS unsigned*)(lds + att::L_MISC));
    phase_seq<0>(p, lds, c, grid, bar);
}

extern "C" void kernel_launch(void* const* d_in, const int* in_sizes, int n_in, void* d_out, int out_size, void* d_ws, size_t ws_size, hipStream_t stream) {
    static int grid = 0;
    if (grid == 0) {
        if (n_in != 24 || ws_size < WS_NEED) { fprintf(stderr, "kernel_launch: unexpected n_in %d / ws_size %zu (need %zu)\n", n_in, ws_size, (size_t)WS_NEED); grid = -1; return; }
        int dev = 0, cus = 0, per_cu = 0;
        hipGetDevice(&dev); hipDeviceGetAttribute(&cus, hipDeviceAttributeMultiprocessorCount, dev);
        if (hipFuncSetAttribute((const void*)yoco_mega, hipFuncAttributeMaxDynamicSharedMemorySize, LDS_BYTES) != hipSuccess) { fprintf(stderr, "kernel_launch: hipFuncSetAttribute failed\n"); grid = -1; return; }
        if (hipOccupancyMaxActiveBlocksPerMultiprocessor(&per_cu, (const void*)yoco_mega, NTHR, LDS_BYTES) != hipSuccess || per_cu < 1) { fprintf(stderr, "kernel_launch: occupancy query says %d\n", per_cu); per_cu = 1; }
        (void)hipGetLastError();
        grid = cus * per_cu;
        fprintf(stderr, "kernel_launch: grid %d (cus %d x %d)\n", grid, cus, per_cu);
    }
    if (grid < 0) return;
    if (hipMemsetAsync((char*)d_ws + WS_CTL, 0, CTL_BYTES, stream) != hipSuccess) { fprintf(stderr, "kernel_launch: memset failed\n"); return; }
    Params p{};
    for (int i = 0; i < 24; ++i) p.in[i] = (const float*)d_in[i];
    p.out = (float*)d_out; p.ws = (unsigned char*)d_ws; p.ph_lo = 0; p.ph_hi = PH_COUNT;
    void* args[] = {&p};
    hipError_t e = hipLaunchCooperativeKernel((const void*)yoco_mega, dim3(grid), dim3(NTHR), args, LDS_BYTES, stream);
    if (e != hipSuccess) fprintf(stderr, "kernel_launch: cooperative launch failed: %s (grid %d)\n", hipGetErrorString(e), grid);
}
```
